# Optimizing an MI355X kernel written in HIP

```python
import jax, jax.numpy as jnp
from jax import lax
import numpy as np

D_MODEL = 1024
BATCH = 16
SEQ = 2048
DEPTH = 1

CHUNK = 64
ROPE_THETA = 10000.0
RMS_EPS = 1e-6
NEG_INF = -1e30

A_HEADS = 8
A_HEAD_DIM = 64
A_WIDTH = A_HEADS * A_HEAD_DIM
IDX_HEADS = 8
IDX_DIM = 64
IDX_ROPE_DIM = 32
TOPK_MAX = 256
SPARSE_Q_BLOCK = 32

B_HEADS = 8
B_NOPE_DIM = 64
B_ROPE_DIM = 32
B_QK_DIM = B_NOPE_DIM + B_ROPE_DIM
B_V_DIM = 64
B_WIDTH = B_HEADS * B_V_DIM
Q_LORA = 384
KV_LORA = 256
DENSE_Q_BLOCK = 128

D_MIX = A_WIDTH + B_WIDTH
IN_SPLITS = (A_WIDTH, A_WIDTH, A_WIDTH, A_WIDTH, IDX_HEADS * IDX_DIM, IDX_DIM, IDX_HEADS,
             Q_LORA, KV_LORA, B_ROPE_DIM, B_WIDTH)
D_IN = 4 * A_WIDTH + IDX_HEADS * IDX_DIM + IDX_DIM + IDX_HEADS + Q_LORA + KV_LORA + B_ROPE_DIM + B_WIDTH

kernel_name = "hybrid_dsa_mla_parallel_heads"


def rms_norm(x, g):
    xf = x.astype(jnp.float32)
    y = xf * lax.rsqrt(jnp.mean(xf * xf, axis=-1, keepdims=True) + RMS_EPS)
    return (y * g.astype(jnp.float32)).astype(x.dtype)


def rope(x, pos):
    d = x.shape[-1]
    half = d // 2
    freqs = jnp.power(ROPE_THETA, -jnp.arange(half, dtype=jnp.float32) * 2.0 / d)
    ang = pos.astype(jnp.float32)[:, None] * freqs[None, :]
    cos = jnp.cos(ang)[None, :, None, :]
    sin = jnp.sin(ang)[None, :, None, :]
    xf = x.astype(jnp.float32)
    x1, x2 = xf[..., :half], xf[..., half:]
    return jnp.concatenate([x1 * cos - x2 * sin, x2 * cos + x1 * sin], axis=-1).astype(x.dtype)


def chunk_limit(pos):
    return (pos // CHUNK + 1) * CHUNK


def indexer_sparse_attention(q, k, v, q_idx, k_idx, w_idx, pos):
    B, S, H, dh = q.shape
    topk = min(TOPK_MAX, S // 4)
    nblk = S // SPARSE_Q_BLOCK
    key_pos = jnp.arange(S, dtype=jnp.int32)
    idx_scale = (IDX_DIM * IDX_HEADS) ** -0.5
    att_scale = dh ** -0.5

    def to_blocks(a):
        return jnp.moveaxis(a.reshape(B, nblk, SPARSE_Q_BLOCK, *a.shape[2:]), 1, 0)

    def block(args):
        qb, qib, wb, pb = args
        limit = chunk_limit(pb)
        rel = jax.nn.relu(jnp.einsum('bqhd,bsd->bqhs', qib, k_idx).astype(jnp.float32))
        score = jnp.einsum('bqhs,bqh->bqs', rel, wb.astype(jnp.float32)) * idx_scale
        admissible = key_pos[None, :] < limit[:, None]
        score = jnp.where(admissible[None], score, NEG_INF)
        _, sel = lax.top_k(score, topk)
        valid = sel < limit[None, :, None]
        k_sel = jax.vmap(lambda kb, ib: kb[ib])(k, sel)
        v_sel = jax.vmap(lambda vb, ib: vb[ib])(v, sel)
        logits = jnp.einsum('bqhd,bqkhd->bhqk', qb, k_sel).astype(jnp.float32) * att_scale
        logits = jnp.where(valid[:, None], logits, NEG_INF)
        p = jax.nn.softmax(logits, axis=-1).astype(v.dtype)
        return jnp.einsum('bhqk,bqkhd->bqhd', p, v_sel)

    out = lax.map(block, (to_blocks(q), to_blocks(q_idx), to_blocks(w_idx),
                          pos.reshape(nblk, SPARSE_Q_BLOCK)))
    return jnp.moveaxis(out, 0, 1).reshape(B, S, H, dh)


def chunk_causal_attention(q, k, v, pos):
    B, S, H, dq = q.shape
    dv = v.shape[-1]
    nblk = S // DENSE_Q_BLOCK
    scale = dq ** -0.5

    def block(args):
        qb, pb = args
        logits = jnp.einsum('bqhd,bshd->bhqs', qb, k).astype(jnp.float32) * scale
        mask = pos[None, :] < chunk_limit(pb)[:, None]
        logits = jnp.where(mask[None, None], logits, NEG_INF)
        p = jax.nn.softmax(logits, axis=-1).astype(v.dtype)
        return jnp.einsum('bhqs,bshd->bqhd', p, v)

    qbl = jnp.moveaxis(q.reshape(B, nblk, DENSE_Q_BLOCK, H, dq), 1, 0)
    out = lax.map(block, (qbl, pos.reshape(nblk, DENSE_Q_BLOCK)))
    return jnp.moveaxis(out, 0, 1).reshape(B, S, H, dv)


def setup_inputs(seed: int = 0) -> dict:
    key = jax.random.key(seed)
    ks = jax.random.split(key, 12)
    f32 = jnp.float32

    def gain(k, n):
        return 1.0 + 0.02 * jax.random.normal(k, (DEPTH, n), f32)

    x = jax.random.normal(ks[0], (BATCH, SEQ, D_MODEL), f32)
    norm_gain = gain(ks[1], D_MODEL)
    w_in = jax.random.normal(ks[2], (DEPTH, D_MODEL, D_IN), f32) * D_MODEL ** -0.5
    a_q_norm = gain(ks[3], A_HEAD_DIM)
    a_k_norm = gain(ks[4], A_HEAD_DIM)
    b_q_latent_norm = gain(ks[5], Q_LORA)
    b_kv_latent_norm = gain(ks[6], KV_LORA)
    w_uq = jax.random.normal(ks[7], (DEPTH, Q_LORA, B_HEADS * B_QK_DIM), f32) * Q_LORA ** -0.5
    w_ukv = jax.random.normal(ks[8], (DEPTH, KV_LORA, B_HEADS * (B_NOPE_DIM + B_V_DIM)), f32) * KV_LORA ** -0.5
    b_q_norm = gain(ks[9], B_QK_DIM)
    b_k_norm = gain(ks[10], B_QK_DIM)
    w_out = jax.random.normal(ks[11], (DEPTH, D_MIX, D_MODEL), f32) * D_MIX ** -0.5
    return {"x": x, "norm_gain": norm_gain, "w_in": w_in, "a_q_norm": a_q_norm,
            "a_k_norm": a_k_norm, "b_q_latent_norm": b_q_latent_norm,
            "b_kv_latent_norm": b_kv_latent_norm, "w_uq": w_uq, "w_ukv": w_ukv,
            "b_q_norm": b_q_norm, "b_k_norm": b_k_norm, "w_out": w_out}


def reference(x, norm_gain, w_in, a_q_norm, a_k_norm, b_q_latent_norm, b_kv_latent_norm,
              w_uq, w_ukv, b_q_norm, b_k_norm, w_out):
    B, S, _ = x.shape
    pos = jnp.arange(S, dtype=jnp.int32)
    offsets = [int(o) for o in np.cumsum(IN_SPLITS)[:-1]]
    h = x
    for l in range(DEPTH):
        xn = rms_norm(h, norm_gain[l])
        proj = xn @ w_in[l]
        (q_a, k_a, v_a, g_a, q_i, k_i, w_i,
         c_q, c_kv, k_rope, g_b) = jnp.split(proj, offsets, axis=-1)

        q_a = rope(rms_norm(q_a.reshape(B, S, A_HEADS, A_HEAD_DIM), a_q_norm[l]), pos)
        k_a = rope(rms_norm(k_a.reshape(B, S, A_HEADS, A_HEAD_DIM), a_k_norm[l]), pos)
        v_a = v_a.reshape(B, S, A_HEADS, A_HEAD_DIM)
        q_i = q_i.reshape(B, S, IDX_HEADS, IDX_DIM)
        q_i = jnp.concatenate([rope(q_i[..., :IDX_ROPE_DIM], pos), q_i[..., IDX_ROPE_DIM:]], axis=-1)
        k_i = k_i[:, :, None, :]
        k_i = jnp.concatenate([rope(k_i[..., :IDX_ROPE_DIM], pos), k_i[..., IDX_ROPE_DIM:]], axis=-1)[:, :, 0, :]
        o_a = indexer_sparse_attention(q_a, k_a, v_a, q_i, k_i, w_i, pos)

        q_b = (rms_norm(c_q, b_q_latent_norm[l]) @ w_uq[l]).reshape(B, S, B_HEADS, B_QK_DIM)
        kv = (rms_norm(c_kv, b_kv_latent_norm[l]) @ w_ukv[l]).reshape(B, S, B_HEADS, B_NOPE_DIM + B_V_DIM)
        k_nope, v_b = kv[..., :B_NOPE_DIM], kv[..., B_NOPE_DIM:]
        k_rope_h = jnp.broadcast_to(k_rope[:, :, None, :], (B, S, B_HEADS, B_ROPE_DIM))
        k_b = jnp.concatenate([k_nope, k_rope_h], axis=-1)
        q_b = rms_norm(q_b, b_q_norm[l])
        k_b = rms_norm(k_b, b_k_norm[l])
        q_b = jnp.concatenate([q_b[..., :B_NOPE_DIM], rope(q_b[..., B_NOPE_DIM:], pos)], axis=-1)
        k_b = jnp.concatenate([k_b[..., :B_NOPE_DIM], rope(k_b[..., B_NOPE_DIM:], pos)], axis=-1)
        o_b = chunk_causal_attention(q_b, k_b, v_b, pos)

        mixed = jnp.concatenate([o_a.reshape(B, S, A_WIDTH) * jax.nn.silu(g_a),
                                 o_b.reshape(B, S, B_WIDTH) * jax.nn.silu(g_b)], axis=-1)
        h = h + mixed @ w_out[l]
    return h
```

```cpp
#include <hip/hip_runtime.h>
#include <cstdint>
#include <cstdio>

constexpr int BATCH = 16, SEQ = 2048, DMODEL = 1024, MTOK = BATCH * SEQ;
constexpr int NP = 3840;
constexpr int C_QA = 0, C_KA = 512, C_VA = 1024, C_GA = 1536, C_QI = 2048, C_GB = 2560, C_CQ = 3072, C_CKV = 3456, C_KI = 3712, C_KR = 3776, C_WI = 3808;
constexpr int D_IN_OLD = 3816;
constexpr float RMS_EPS = 1e-6f;
constexpr float LOG2E = 1.4426950408889634f;
constexpr float C2A = 0.125f * LOG2E;
constexpr float C2B = 0.10206207261596575f * LOG2E;

constexpr size_t MiB = 1u << 20;
constexpr size_t WS_CTL = 0;
constexpr size_t WS_WIN = 2 * MiB;
constexpr size_t WS_WUQ = 10 * MiB;
constexpr size_t WS_WUKV = 11 * MiB;
constexpr size_t WS_WOUT = 12 * MiB;
constexpr size_t WS_ROPE = 14 * MiB;
constexpr size_t WS_XN = 16 * MiB;
constexpr size_t WS_MIXED = WS_XN;
constexpr size_t WS_PROJ = 80 * MiB;
constexpr size_t WS_QB = 320 * MiB;
constexpr size_t WS_KVR = 368 * MiB;
constexpr size_t WS_KB = 432 * MiB;
constexpr size_t WS_MASK = 480 * MiB;
constexpr size_t WS_END = 488 * MiB;

typedef unsigned short bf16;
typedef short bf16x8_t __attribute__((ext_vector_type(8)));
typedef short s16x4_t __attribute__((ext_vector_type(4)));
typedef float f32x16_t __attribute__((ext_vector_type(16)));
typedef float f32x4_t __attribute__((ext_vector_type(4)));
typedef unsigned u32x4_t __attribute__((ext_vector_type(4)));
typedef unsigned u32x2_t __attribute__((ext_vector_type(2)));
#define LAS __attribute__((address_space(3)))

__device__ __forceinline__ unsigned f2bf(float f) { unsigned u = __builtin_bit_cast(unsigned, f); return (u + 0x7fffu + ((u >> 16) & 1u)) >> 16; }
__device__ __forceinline__ unsigned pk2(float lo, float hi) { return f2bf(lo) | (f2bf(hi) << 16); }
__device__ __forceinline__ float bflo(unsigned u) { return __builtin_bit_cast(float, u << 16); }
__device__ __forceinline__ float bfhi(unsigned u) { return __builtin_bit_cast(float, u & 0xffff0000u); }
__device__ __forceinline__ float bf2f(bf16 b) { return __builtin_bit_cast(float, (unsigned)b << 16); }
__device__ __forceinline__ int crow(int r, int hi) { return (r & 3) + 8 * (r >> 2) + 4 * hi; }

namespace pg8 {
#define PG8_LAS __attribute__((address_space(3)))
typedef unsigned short bf16_t;
typedef short bf16x8 __attribute__((ext_vector_type(8)));
typedef float f32x4 __attribute__((ext_vector_type(4)));
typedef unsigned u32x4 __attribute__((ext_vector_type(4)));
constexpr int BM = 256, BK = 64, HALF = 128, HTB = HALF * BK * 2  , STAGE_BYTES = 8 * HTB, NXCD = 8, WGM = 8;

__host__ __device__ __forceinline__ int lds_byte(int r, int c) { const int st = (r >> 4) * 2 + (c >> 5), rr = r & 15, cc = c & 31, ob = rr * 64 + cc * 2; return st * 1024 + (ob ^ (((ob >> 9) & 1) << 5)); }
__host__ __device__ __forceinline__ void stage_rc(int b, int& R, int& C) { const int st = b / 1024, sb = b % 1024, swz = sb ^ (((sb >> 9) & 1) << 5); R = (st >> 1) * 16 + swz / 64; C = (st & 1) * 32 + (swz % 64) / 2; }
__host__ __device__ __forceinline__ int perm32(int rho) { const int n = rho >> 4, i = rho & 15; return 8 * (i >> 2) + 4 * n + (i & 3); }

struct Unit { int pm, pn; };
struct Gemm { const bf16_t* A; const bf16_t* Bt; int M, N, K, lda; };

struct StaticOrder {
    int nM, nN, nwg, G, c;
    __host__ __device__ void init(int M, int N, int G_, int c_) { nM = M / BM; nN = N / BM; nwg = nM * nN; G = G_; c = c_; }
    __host__ __device__ bool next(int i, Unit& u) const {
        const long L = (long)i * G + c; if (L >= nwg) return false;
        int wgid = (int)L; { const int q = nwg / NXCD, r = nwg % NXCD, xcd = wgid % NXCD, off = wgid / NXCD; wgid = (xcd < r ? xcd * (q + 1) : r * (q + 1) + (xcd - r) * q) + off; }
        const int nig = WGM * nN, gid = wgid / nig, fm = gid * WGM, gsz = (nM - fm) < WGM ? (nM - fm) : WGM;
        u.pm = fm + ((wgid % nig) % gsz); u.pn = (wgid % nig) / gsz; return true;
    }
    __device__ __forceinline__ void a_ready(const Unit&) const {}
    __device__ __forceinline__ void done(const Unit&) const {}
};

__device__ __forceinline__ unsigned cvt_pk_bf16(float lo, float hi) { unsigned r; asm volatile("v_cvt_pk_bf16_f32 %0, %1, %2" : "=v"(r) : "v"(lo), "v"(hi)); return r; }
typedef float f32x2 __attribute__((ext_vector_type(2)));
__device__ __forceinline__ f32x2 gelu_pk(f32x2 v) {
    const f32x2 av = __builtin_elementwise_abs(v), d = av * 0.2316418882f + 1.0f;
    f32x2 t; t.x = __builtin_amdgcn_rcpf(d.x); t.y = __builtin_amdgcn_rcpf(d.y);
    f32x2 q = t * 0.5307027145f + (-0.7265760135f); q = q * t + 0.7107068705f; q = q * t + (-0.142248368f); q = q * t + 0.127414796f; q = q * t;
    const f32x2 s = (v * v) * (-0.72134752044f);
    f32x2 e; e.x = __builtin_amdgcn_exp2f(s.x); e.y = __builtin_amdgcn_exp2f(s.y);
    const f32x2 m = v * (q * e), r = v - m;
    f32x2 o; o.x = v.x < 0.f ? m.x : r.x; o.y = v.y < 0.f ? m.y : r.y; return o;
}

template <int ACT  > struct EpiBf16 {
    static constexpr bool PERM = true, AFTER_DRAIN = false; static_assert(ACT == 0 || ACT == 1, "EpiBf16: ACT is 0 (none) or 1 (gelu_pk)");
    bf16_t* O; int ldc; const float* bias; int split_cols; size_t split_stride; float scale0;
    __device__ __forceinline__ void operator()(const f32x4 (&acc)[2][2][4][2], const Unit& u, int wr, int wc, int fr, int fq) const {
        const int row0 = u.pm * BM + wr * 64 + fr; int colt = u.pn * BM; bf16_t* base = O;
        float sc = 1.f; if (split_cols) { const int t = colt / split_cols; base += (size_t)t * split_stride; colt -= t * split_cols; if (t == 0) sc = scale0; }
        const int col0 = colt + wc * 32 + 8 * fq, bcol0 = u.pn * BM + wc * 32 + 8 * fq;
        f32x4 bv[2][2];
#pragma unroll
        for (int bj = 0; bj < 2; ++bj)
#pragma unroll
            for (int n = 0; n < 2; ++n) bv[bj][n] = bias ? *(const f32x4*)(bias + bcol0 + bj * HALF + 4 * n) : (f32x4){0.f, 0.f, 0.f, 0.f};
#pragma unroll
        for (int ai = 0; ai < 2; ++ai)
#pragma unroll
            for (int m = 0; m < 4; ++m) { bf16_t* rowp = base + (size_t)(row0 + ai * HALF + m * 16) * ldc + col0;
#pragma unroll
                for (int bj = 0; bj < 2; ++bj) { f32x4 v0 = acc[ai][bj][m][0] + bv[bj][0], v1 = acc[ai][bj][m][1] + bv[bj][1];
                    if (ACT == 1) { f32x2 a = gelu_pk((f32x2){v0[0], v0[1]}), b = gelu_pk((f32x2){v0[2], v0[3]}), c = gelu_pk((f32x2){v1[0], v1[1]}), d = gelu_pk((f32x2){v1[2], v1[3]});
                        v0 = (f32x4){a.x, a.y, b.x, b.y}; v1 = (f32x4){c.x, c.y, d.x, d.y}; }
                    v0 = v0 * sc; v1 = v1 * sc; u32x4 w; w.x = cvt_pk_bf16(v0[0], v0[1]); w.y = cvt_pk_bf16(v0[2], v0[3]); w.z = cvt_pk_bf16(v1[0], v1[1]); w.w = cvt_pk_bf16(v1[2], v1[3]);
                    *(u32x4*)(rowp + bj * HALF) = w; } }
    }
};
template <class Epi, class Sched, bool ALIGN_EPI = false, bool SP2 = false>
__device__ __forceinline__ void gemm_phase(PG8_LAS unsigned char* lds, const Gemm g, const Sched& S, const Epi& E) {
    const int tid = threadIdx.x, wid = __builtin_amdgcn_readfirstlane(tid >> 6), lane = tid & 63, wr = wid >> 2, wc = wid & 3, fr = lane & 15, fq = lane >> 4;
    const int K = g.K, nt = K / BK, lda = g.lda;
    unsigned voffA[2], voffB[2];
#pragma unroll
    for (int i = 0; i < 2; ++i) { int R, C; stage_rc(tid * 16 + i * 8192, R, C); const int Rb = Epi::PERM ? ((R & ~31) + perm32(R & 31)) : R;
        voffA[i] = (unsigned)(R * lda + C) * 2u; voffB[i] = (unsigned)(Rb * K + C) * 2u; }
    const size_t kstep = (size_t)(BK * 2);
    const size_t hstepA = (size_t)HALF * lda * 2, hstepB = (size_t)HALF * K * 2;
    const size_t tstepA = 2 * hstepA, tstepB = 2 * hstepB;
    const unsigned ldsw = (unsigned)wid * 1024u;
    const int aoff = lds_byte(wr * 64 + fr, fq * 8), boff = lds_byte(wc * 32 + fr, fq * 8);
#define PG8_SA(b, h) (((b) * 2 + (h)) * HTB)
#define PG8_SB(b, h) ((4 + (b) * 2 + (h)) * HTB)
#define PG8_STAGE(bufoff, gbase, voff) do { _Pragma("unroll") for (int _i = 0; _i < 2; ++_i) \
        __builtin_amdgcn_global_load_lds((const unsigned*)((const char*)(gbase) + (voff)[_i]), (PG8_LAS unsigned*)(lds + (bufoff) + ldsw + _i * 8192), 16, 0, 0); } while (0)
#define PG8_LDA(dst, b, h) do { _Pragma("unroll") for (int m = 0; m < 4; ++m) _Pragma("unroll") for (int k = 0; k < 2; ++k) dst[m][k] = *(const PG8_LAS bf16x8*)(lds + PG8_SA(b, h) + aoff + m * 2048 + k * 1024); } while (0)
#define PG8_LDB(dst, b, h) do { _Pragma("unroll") for (int n = 0; n < 2; ++n) _Pragma("unroll") for (int k = 0; k < 2; ++k) dst[n][k] = *(const PG8_LAS bf16x8*)(lds + PG8_SB(b, h) + boff + n * 2048 + k * 1024); } while (0)
#define PG8_MMA(ai, bj, At, Bt) do { __builtin_amdgcn_s_setprio(1); _Pragma("unroll") for (int m = 0; m < 4; ++m) _Pragma("unroll") for (int n = 0; n < 2; ++n) _Pragma("unroll") for (int k = 0; k < 2; ++k) \
        acc[ai][bj][m][n] = __builtin_amdgcn_mfma_f32_16x16x32_bf16(Bt[n][k], At[m][k], acc[ai][bj][m][n], 0, 0, 0); __builtin_amdgcn_s_setprio(0); } while (0)
#define PG8_WAIT_V(n) asm volatile("s_waitcnt vmcnt(" #n ")" ::: "memory")
#define PG8_WAIT_L(n) asm volatile("s_waitcnt lgkmcnt(" #n ")" ::: "memory")
#define PG8_BAR __builtin_amdgcn_s_barrier()
#define PG8_SCHED __builtin_amdgcn_sched_barrier(0)
    Unit cur, nxt; int ui = 0;
    if (!S.next(0, cur)) return;
    f32x4 acc[2][2][4][2];
#pragma unroll
    for (int a = 0; a < 2; ++a)
#pragma unroll
        for (int b = 0; b < 2; ++b)
#pragma unroll
            for (int m = 0; m < 4; ++m)
#pragma unroll
                for (int n = 0; n < 2; ++n) acc[a][b][m][n] = (f32x4){0.f, 0.f, 0.f, 0.f};
    bf16x8 At[4][2], B0[2][2], B1[2][2];
    const char* cA = (const char*)g.A + (size_t)cur.pm * tstepA; const char* cB = (const char*)g.Bt + (size_t)cur.pn * tstepB;
    S.a_ready(cur);
    if constexpr (SP2) {
        PG8_STAGE(PG8_SB(0, 0), cB, voffB); PG8_STAGE(PG8_SB(0, 1), cB + hstepB, voffB); PG8_STAGE(PG8_SA(0, 0), cA, voffA); PG8_STAGE(PG8_SA(0, 1), cA + hstepA, voffA);
        if (wr == 1) PG8_BAR;
        PG8_WAIT_V(2); PG8_BAR;
        PG8_STAGE(PG8_SB(1, 0), cB + kstep, voffB); PG8_STAGE(PG8_SA(1, 0), cA + kstep, voffA); PG8_STAGE(PG8_SB(1, 1), cB + hstepB + kstep, voffB);
        PG8_WAIT_V(6); PG8_BAR;
    } else {
        PG8_STAGE(PG8_SB(0, 0), cB, voffB); PG8_STAGE(PG8_SA(0, 0), cA, voffA); PG8_STAGE(PG8_SB(0, 1), cB + hstepB, voffB); PG8_STAGE(PG8_SA(0, 1), cA + hstepA, voffA);
        if (wr == 1) PG8_BAR;
        PG8_WAIT_V(4); PG8_BAR;
        PG8_STAGE(PG8_SB(1, 0), cB + kstep, voffB); PG8_STAGE(PG8_SA(1, 0), cA + kstep, voffA); PG8_STAGE(PG8_SB(1, 1), cB + hstepB + kstep, voffB);
        PG8_WAIT_V(6); PG8_BAR;
    }
    for (;;) {
        const bool has_next = S.next(ui + 1, nxt);
        const char* nA = has_next ? (const char*)g.A + (size_t)nxt.pm * tstepA : cA; const char* nB = has_next ? (const char*)g.Bt + (size_t)nxt.pn * tstepB : cB;
        for (int t = 0; t < nt; t += 2) {
            const bool last = (t == nt - 2);
            const char* a1 = cA + (size_t)(t + 1) * kstep;
            const char* a2 = last ? nA : cA + (size_t)(t + 2) * kstep; const char* b2 = last ? nB : cB + (size_t)(t + 2) * kstep;
            const char* a3 = a2 + kstep; const char* b3 = b2 + kstep;
            if (last && has_next) S.a_ready(nxt);
            if constexpr (SP2) {
            PG8_LDB(B0, 0, 0); PG8_LDB(B1, 0, 1); PG8_SCHED; PG8_LDA(At, 0, 0); PG8_STAGE(PG8_SA(1, 1), a1 + hstepA, voffA);
            PG8_WAIT_V(8); PG8_WAIT_L(0); PG8_BAR; PG8_MMA(0, 0, At, B0); PG8_MMA(0, 1, At, B1); PG8_BAR; PG8_SCHED;
            PG8_LDA(At, 0, 1); PG8_STAGE(PG8_SB(0, 0), b2, voffB); PG8_STAGE(PG8_SB(0, 1), b2 + hstepB, voffB); PG8_STAGE(PG8_SA(0, 0), a2, voffA);
            PG8_WAIT_V(8); PG8_WAIT_L(0); PG8_BAR; PG8_MMA(1, 0, At, B0); PG8_MMA(1, 1, At, B1); PG8_BAR; PG8_SCHED;
            PG8_LDB(B0, 1, 0); PG8_LDB(B1, 1, 1); PG8_SCHED; PG8_LDA(At, 1, 0); PG8_STAGE(PG8_SA(0, 1), a2 + hstepA, voffA);
            PG8_WAIT_V(8); PG8_WAIT_L(0); PG8_BAR; PG8_MMA(0, 0, At, B0); PG8_MMA(0, 1, At, B1); PG8_BAR; PG8_SCHED;
            PG8_LDA(At, 1, 1); PG8_STAGE(PG8_SB(1, 0), b3, voffB); PG8_STAGE(PG8_SB(1, 1), b3 + hstepB, voffB); PG8_STAGE(PG8_SA(1, 0), a3, voffA);
            PG8_WAIT_V(8); PG8_WAIT_L(0); PG8_BAR; PG8_MMA(1, 0, At, B0); PG8_MMA(1, 1, At, B1); PG8_BAR; PG8_SCHED;
            } else {
            PG8_LDB(B0, 0, 0); PG8_SCHED; PG8_LDA(At, 0, 0); PG8_STAGE(PG8_SA(1, 1), a1 + hstepA, voffA);
            PG8_WAIT_L(8); PG8_BAR; PG8_WAIT_L(0); PG8_MMA(0, 0, At, B0); PG8_BAR; PG8_SCHED;
            PG8_LDB(B1, 0, 1); PG8_STAGE(PG8_SB(0, 0), b2, voffB);
            PG8_BAR; PG8_WAIT_L(0); PG8_MMA(0, 1, At, B1); PG8_BAR;
            PG8_LDA(At, 0, 1); PG8_STAGE(PG8_SA(0, 0), a2, voffA);
            PG8_BAR; PG8_WAIT_L(0); PG8_MMA(1, 0, At, B0); PG8_BAR; PG8_SCHED;
            PG8_STAGE(PG8_SB(0, 1), b2 + hstepB, voffB);
            PG8_WAIT_V(6); PG8_BAR; PG8_MMA(1, 1, At, B1); PG8_BAR;
            PG8_LDB(B0, 1, 0); PG8_SCHED; PG8_LDA(At, 1, 0); PG8_STAGE(PG8_SA(0, 1), a2 + hstepA, voffA);
            PG8_WAIT_L(8); PG8_BAR; PG8_WAIT_L(0); PG8_MMA(0, 0, At, B0); PG8_BAR; PG8_SCHED;
            PG8_LDB(B1, 1, 1); PG8_STAGE(PG8_SB(1, 0), b3, voffB);
            PG8_BAR; PG8_WAIT_L(0); PG8_MMA(0, 1, At, B1); PG8_BAR;
            PG8_LDA(At, 1, 1); PG8_STAGE(PG8_SA(1, 0), a3, voffA);
            PG8_BAR; PG8_WAIT_L(0); PG8_MMA(1, 0, At, B0); PG8_BAR; PG8_SCHED;
            PG8_STAGE(PG8_SB(1, 1), b3 + hstepB, voffB);
            PG8_WAIT_V(6); PG8_BAR; PG8_MMA(1, 1, At, B1); PG8_BAR;
            }
        }
        if constexpr (ALIGN_EPI) { if (wr == 0) PG8_BAR; }
        if constexpr (!Epi::AFTER_DRAIN) { E(acc, cur, wr, wc, fr, fq); S.done(cur); }
        if (!has_next) break;
#pragma unroll
        for (int a = 0; a < 2; ++a)
#pragma unroll
            for (int b = 0; b < 2; ++b)
#pragma unroll
                for (int m = 0; m < 4; ++m)
#pragma unroll
                    for (int n = 0; n < 2; ++n) acc[a][b][m][n] = (f32x4){0.f, 0.f, 0.f, 0.f};
        cur = nxt; cA = nA; cB = nB; ++ui;
        if constexpr (ALIGN_EPI) { if (wr == 1) PG8_BAR; }
    }
    PG8_WAIT_V(0);
    if constexpr (!ALIGN_EPI) { if (wr == 0) PG8_BAR; }
    PG8_BAR;
    if constexpr (Epi::AFTER_DRAIN) { E.fused(acc, cur, wr, wc, fr, fq, lds, wid, lane); S.done(cur); }
#undef PG8_SA
#undef PG8_SB
#undef PG8_STAGE
#undef PG8_LDA
#undef PG8_LDB
#undef PG8_MMA
#undef PG8_WAIT_V
#undef PG8_WAIT_L
#undef PG8_BAR
#undef PG8_SCHED
}
}

#ifndef PG8_SP2
#define PG8_SP2 true
#endif
#ifndef PG8_ALIGN
#define PG8_ALIGN true
#endif

namespace pg8 {
struct EpiResF32 {
    static constexpr bool PERM = false, AFTER_DRAIN = false;
    const float* base; float* out; int ldc;
    __device__ __forceinline__ void operator()(const f32x4 (&acc)[2][2][4][2], const Unit& u, int wr, int wc, int fr, int fq) const {
        const int col0 = u.pn * BM + wc * 32 + 4 * fq;
#pragma unroll
        for (int ai = 0; ai < 2; ++ai)
#pragma unroll
            for (int m = 0; m < 4; ++m) { const size_t off = (size_t)(u.pm * BM + ai * HALF + wr * 64 + m * 16 + fr) * ldc + col0;
#pragma unroll
                for (int bj = 0; bj < 2; ++bj)
#pragma unroll
                    for (int n = 0; n < 2; ++n) { const f32x4 b = *(const f32x4*)(base + off + bj * HALF + n * 16); *(f32x4*)(out + off + bj * HALF + n * 16) = b + acc[ai][bj][m][n]; } }
    }
};
}

constexpr int GEMM_LDS = pg8::STAGE_BYTES;

__global__ void __launch_bounds__(512, 2) k_gemm_bf16(pg8::Gemm g, pg8::bf16_t* O, int ldc) {
    extern __shared__ __attribute__((aligned(16))) unsigned char lds[];
    pg8::StaticOrder S; S.init(g.M, g.N, (int)gridDim.x, (int)blockIdx.x);
    pg8::EpiBf16<0> E{O, ldc, nullptr, 0, 0, 1.f};
    pg8::gemm_phase<pg8::EpiBf16<0>, pg8::StaticOrder, true, true>((PG8_LAS unsigned char*)lds, g, S, E);
}
__global__ void __launch_bounds__(512, 2) k_gemm_res(pg8::Gemm g, const float* base, float* out, int ldc) {
    extern __shared__ __attribute__((aligned(16))) unsigned char lds[];
    pg8::StaticOrder S; S.init(g.M, g.N, (int)gridDim.x, (int)blockIdx.x);
    pg8::EpiResF32 E{base, out, ldc};
    pg8::gemm_phase<pg8::EpiResF32, pg8::StaticOrder, true, true>((PG8_LAS unsigned char*)lds, g, S, E);
}

__global__ void k_rope_table(float* ct, float* st) {
    const int idx = blockIdx.x * blockDim.x + threadIdx.x;
    if (idx >= SEQ * 32) return;
    const int pos = idx >> 5, j = idx & 31;
    const float freq = exp2f(-(float)j * (13.287712379549449f / 32.0f));
    const float ang = (float)pos * freq;
    double rev = (double)ang * 0.15915494309189535;
    rev -= floor(rev);
    const float fr = (float)rev;
    ct[idx] = __builtin_amdgcn_cosf(fr);
    st[idx] = __builtin_amdgcn_sinf(fr);
}

__device__ __forceinline__ int win_src_col(int n) {
    if (n < 2560) return n;
    if (n < 3072) return n - 2560 + 3304;
    if (n < 3456) return n - 3072 + 2632;
    if (n < 3712) return n - 3456 + 3016;
    if (n < 3776) return n - 3712 + 2560;
    if (n < 3808) return n - 3776 + 3272;
    if (n < 3816) return n - 3808 + 2624;
    return -1;
}
template <bool REMAP>
__global__ void __launch_bounds__(256) k_wtrans(const float* __restrict__ W, int K, int Nold, bf16* __restrict__ WT) {
    __shared__ float t[64][65];
    const int n0 = blockIdx.x * 64, k0 = blockIdx.y * 64;
    for (int i = threadIdx.x; i < 4096; i += 256) { const int kk = i >> 6, nn = i & 63; const int n = n0 + nn; const int src = REMAP ? win_src_col(n) : n;
        t[kk][nn] = (src >= 0) ? W[(size_t)(k0 + kk) * Nold + src] : 0.f; }
    __syncthreads();
    for (int i = threadIdx.x; i < 4096; i += 256) { const int nn = i >> 6, kk = i & 63; WT[(size_t)(n0 + nn) * K + k0 + kk] = (bf16)f2bf(t[kk][nn]); }
}

__device__ __forceinline__ float wave_sum(float v) {
#pragma unroll
    for (int o = 1; o < 64; o <<= 1) v += __shfl_xor(v, o);
    return v;
}
__global__ void __launch_bounds__(256) k_rmsnorm_x(const float* __restrict__ x, const float* __restrict__ g, bf16* __restrict__ xn) {
    const int lane = threadIdx.x & 63, row = blockIdx.x * 4 + (threadIdx.x >> 6);
    const f32x4_t* xr = (const f32x4_t*)(x + (size_t)row * DMODEL) + lane;
    const f32x4_t* gr = (const f32x4_t*)g + lane;
    f32x4_t v[4]; float s = 0.f;
#pragma unroll
    for (int j = 0; j < 4; ++j) { v[j] = xr[64 * j]; s += (v[j].x * v[j].x + v[j].y * v[j].y) + (v[j].z * v[j].z + v[j].w * v[j].w); }
    const float rs = 1.0f / sqrtf(wave_sum(s) * (1.0f / DMODEL) + RMS_EPS);
    u32x2_t* o = (u32x2_t*)(xn + (size_t)row * DMODEL) + lane;
#pragma unroll
    for (int j = 0; j < 4; ++j) { const f32x4_t gg = gr[64 * j]; u32x2_t w; w.x = pk2(v[j].x * rs * gg.x, v[j].y * rs * gg.y); w.y = pk2(v[j].z * rs * gg.z, v[j].w * rs * gg.w); o[64 * j] = w; }
}

__global__ void __launch_bounds__(256) k_post_a(bf16* __restrict__ proj, const float* __restrict__ aq_g, const float* __restrict__ ak_g,
                                                const float* __restrict__ cq_g, const float* __restrict__ ckv_g, const float* __restrict__ ropec, const float* __restrict__ ropes) {
    const int lane = threadIdx.x & 63, row = blockIdx.x * 4 + (threadIdx.x >> 6), pos = row & (SEQ - 1);
    bf16* p = proj + (size_t)row * NP;
    const float* cs = ropec + pos * 32; const float* sn = ropes + pos * 32;
    const int h = lane >> 3, j = lane & 7;
#pragma unroll
    for (int which = 0; which < 2; ++which) {
        bf16* base = p + (which ? C_KA : C_QA) + 64 * h;
        const float* g = which ? ak_g : aq_g;
        const u32x2_t r1 = *(const u32x2_t*)(base + 4 * j), r2 = *(const u32x2_t*)(base + 32 + 4 * j);
        float x1[4] = {bflo(r1.x), bfhi(r1.x), bflo(r1.y), bfhi(r1.y)}, x2[4] = {bflo(r2.x), bfhi(r2.x), bflo(r2.y), bfhi(r2.y)};
        float ss = 0.f;
#pragma unroll
        for (int i = 0; i < 4; ++i) ss += x1[i] * x1[i] + x2[i] * x2[i];
        ss += __shfl_xor(ss, 1); ss += __shfl_xor(ss, 2); ss += __shfl_xor(ss, 4);
        const float rs = 1.0f / sqrtf(ss * (1.0f / 64.0f) + RMS_EPS);
        const float sc = which ? 1.0f : C2A;
        float o1[4], o2[4];
#pragma unroll
        for (int i = 0; i < 4; ++i) { const int d = 4 * j + i; const float a = x1[i] * rs * g[d], b = x2[i] * rs * g[d + 32]; const float c = cs[d], s = sn[d];
            o1[i] = (a * c - b * s) * sc; o2[i] = (b * c + a * s) * sc; }
        u32x2_t w1, w2; w1.x = pk2(o1[0], o1[1]); w1.y = pk2(o1[2], o1[3]); w2.x = pk2(o2[0], o2[1]); w2.y = pk2(o2[2], o2[3]);
        *(u32x2_t*)(base + 4 * j) = w1; *(u32x2_t*)(base + 32 + 4 * j) = w2;
    }
    {
        bf16* base = p + C_QI + 64 * h;
        const unsigned r1 = *(const unsigned*)(base + 2 * j), r2 = *(const unsigned*)(base + 16 + 2 * j);
        const float a0 = bflo(r1), a1 = bfhi(r1), b0 = bflo(r2), b1 = bfhi(r2);
        const float c0 = cs[4 * j], s0 = sn[4 * j], c1 = cs[4 * j + 2], s1 = sn[4 * j + 2];
        *(unsigned*)(base + 2 * j) = pk2(a0 * c0 - b0 * s0, a1 * c1 - b1 * s1);
        *(unsigned*)(base + 16 + 2 * j) = pk2(b0 * c0 + a0 * s0, b1 * c1 + a1 * s1);
    }
    if (lane < 8) {
        bf16* base = p + C_KI;
        const unsigned r1 = *(const unsigned*)(base + 2 * j), r2 = *(const unsigned*)(base + 16 + 2 * j);
        const float a0 = bflo(r1), a1 = bfhi(r1), b0 = bflo(r2), b1 = bfhi(r2);
        const float c0 = cs[4 * j], s0 = sn[4 * j], c1 = cs[4 * j + 2], s1 = sn[4 * j + 2];
        *(unsigned*)(base + 2 * j) = pk2(a0 * c0 - b0 * s0, a1 * c1 - b1 * s1);
        *(unsigned*)(base + 16 + 2 * j) = pk2(b0 * c0 + a0 * s0, b1 * c1 + a1 * s1);
    }
    {
        unsigned* base = (unsigned*)(p + C_CQ + 6 * lane);
        const unsigned r0 = base[0], r1 = base[1], r2 = base[2];
        float v[6] = {bflo(r0), bfhi(r0), bflo(r1), bfhi(r1), bflo(r2), bfhi(r2)};
        float ss = 0.f;
#pragma unroll
        for (int i = 0; i < 6; ++i) ss += v[i] * v[i];
        const float rs = 1.0f / sqrtf(wave_sum(ss) * (1.0f / 384.0f) + RMS_EPS);
        const float* g = cq_g + 6 * lane;
        base[0] = pk2(v[0] * rs * g[0], v[1] * rs * g[1]); base[1] = pk2(v[2] * rs * g[2], v[3] * rs * g[3]); base[2] = pk2(v[4] * rs * g[4], v[5] * rs * g[5]);
    }
    {
        u32x2_t* base = (u32x2_t*)(p + C_CKV + 4 * lane);
        const u32x2_t r = *base;
        float v[4] = {bflo(r.x), bfhi(r.x), bflo(r.y), bfhi(r.y)};
        float ss = (v[0] * v[0] + v[1] * v[1]) + (v[2] * v[2] + v[3] * v[3]);
        const float rs = 1.0f / sqrtf(wave_sum(ss) * (1.0f / 256.0f) + RMS_EPS);
        const float* g = ckv_g + 4 * lane;
        u32x2_t w; w.x = pk2(v[0] * rs * g[0], v[1] * rs * g[1]); w.y = pk2(v[2] * rs * g[2], v[3] * rs * g[3]);
        *base = w;
    }
}

__global__ void __launch_bounds__(256) k_post_b(bf16* __restrict__ qb, const bf16* __restrict__ kvr, const bf16* __restrict__ proj, bf16* __restrict__ kb,
                                                const float* __restrict__ bq_g, const float* __restrict__ bk_g, const float* __restrict__ ropec, const float* __restrict__ ropes) {
    const int lane = threadIdx.x & 63, row = blockIdx.x * 4 + (threadIdx.x >> 6), pos = row & (SEQ - 1);
    const float* cs = ropec + pos * 32; const float* sn = ropes + pos * 32;
    const int h = lane >> 3, j = lane & 7;
    const float c0 = cs[4 * j], s0 = sn[4 * j], c1 = cs[4 * j + 2], s1 = sn[4 * j + 2];
#pragma unroll
    for (int which = 0; which < 2; ++which) {
        const bf16* nsrc = which ? (kvr + (size_t)row * 1024 + 128 * h + 8 * j) : (qb + (size_t)row * 768 + 96 * h + 8 * j);
        const bf16* rsrc = which ? (proj + (size_t)row * NP + C_KR + 2 * j) : (qb + (size_t)row * 768 + 96 * h + 64 + 2 * j);
        const float* g = which ? bk_g : bq_g;
        const u32x4_t rn = *(const u32x4_t*)nsrc;
        const unsigned r1 = *(const unsigned*)rsrc, r2 = *(const unsigned*)(rsrc + 16);
        float v[8] = {bflo(rn.x), bfhi(rn.x), bflo(rn.y), bfhi(rn.y), bflo(rn.z), bfhi(rn.z), bflo(rn.w), bfhi(rn.w)};
        const float a0 = bflo(r1), a1 = bfhi(r1), b0 = bflo(r2), b1 = bfhi(r2);
        float ss = (a0 * a0 + a1 * a1) + (b0 * b0 + b1 * b1);
#pragma unroll
        for (int i = 0; i < 8; ++i) ss += v[i] * v[i];
        ss += __shfl_xor(ss, 1); ss += __shfl_xor(ss, 2); ss += __shfl_xor(ss, 4);
        const float rs = 1.0f / sqrtf(ss * (1.0f / 96.0f) + RMS_EPS);
        const float sc = which ? 1.0f : C2B;
        u32x4_t wn;
        { const float* gn = g + 8 * j; const float q = rs * sc;
          wn.x = pk2(v[0] * q * gn[0], v[1] * q * gn[1]); wn.y = pk2(v[2] * q * gn[2], v[3] * q * gn[3]); wn.z = pk2(v[4] * q * gn[4], v[5] * q * gn[5]); wn.w = pk2(v[6] * q * gn[6], v[7] * q * gn[7]); }
        const float A0 = a0 * rs * g[64 + 2 * j], A1 = a1 * rs * g[64 + 2 * j + 1], B0 = b0 * rs * g[80 + 2 * j], B1 = b1 * rs * g[80 + 2 * j + 1];
        const unsigned w1 = pk2((A0 * c0 - B0 * s0) * sc, (A1 * c1 - B1 * s1) * sc), w2 = pk2((B0 * c0 + A0 * s0) * sc, (B1 * c1 + A1 * s1) * sc);
        bf16* dst = which ? (kb + (size_t)row * 768 + 96 * h) : (qb + (size_t)row * 768 + 96 * h);
        *(u32x4_t*)(dst + 8 * j) = wn; *(unsigned*)(dst + 64 + 2 * j) = w1; *(unsigned*)(dst + 80 + 2 * j) = w2;
    }
}

constexpr int IDX_QPITCH = 1040;
constexpr int IDX_LDS = 32 * IDX_QPITCH + 2 * 8 * 32 * 4;
constexpr int TOPK = 256;

__device__ __forceinline__ unsigned sortable_key(float x) { const unsigned u = __builtin_bit_cast(unsigned, x + 0.0f); return (u & 0x80000000u) ? ~u : (u | 0x80000000u); }

__device__ __forceinline__ void indexer_unit(LAS unsigned char* lds, const bf16* __restrict__ proj, unsigned long long* __restrict__ mask, int b, int qb) {
    const int tid = threadIdx.x, lane = tid & 63, w = __builtin_amdgcn_readfirstlane(tid >> 6), r32 = lane & 31, hi = lane >> 5;
    const int L = 64 * ((qb >> 1) + 1), nt32 = L >> 5;
    const int nloc = (nt32 - w + 7) >> 3;
    unsigned long long* mbase = mask + ((size_t)(b * 64 + qb) * 64) * 16;
    if (L <= TOPK) {
        for (int i = 0; i < nloc; ++i) { const int j = w + 8 * i; if (lane < 16) mbase[(size_t)j * 16 + lane] = ~0ull; }
        return;
    }
    const size_t row0 = (size_t)b * SEQ + 32 * qb;
    __syncthreads();
    for (int c = tid; c < 32 * 64; c += 512) { const int r = c >> 6, ch = c & 63;
        *(LAS u32x4_t*)(lds + r * IDX_QPITCH + ch * 16) = *(const u32x4_t*)(proj + (row0 + r) * NP + C_QI + ch * 8); }
    float wv[8];
    { const u32x4_t wr = *(const u32x4_t*)(proj + (row0 + r32) * NP + C_WI);
      wv[0] = bflo(wr.x); wv[1] = bfhi(wr.x); wv[2] = bflo(wr.y); wv[3] = bfhi(wr.y); wv[4] = bflo(wr.z); wv[5] = bfhi(wr.z); wv[6] = bflo(wr.w); wv[7] = bfhi(wr.w); }
    __syncthreads();
    unsigned key[8][16];
    const LAS unsigned char* qrow = lds + r32 * IDX_QPITCH + hi * 16;
#pragma unroll
    for (int i = 0; i < 8; ++i) {
        if (i < nloc) {
            const int j = w + 8 * i;
            const bf16* kp = proj + ((size_t)b * SEQ + 32 * j + r32) * NP + C_KI + 8 * hi;
            bf16x8_t kf[4];
#pragma unroll
            for (int s = 0; s < 4; ++s) kf[s] = *(const bf16x8_t*)(kp + 16 * s);
            f32x16_t tot;
#pragma unroll
            for (int r = 0; r < 16; ++r) tot[r] = 0.f;
#pragma unroll
            for (int h = 0; h < 8; ++h) {
                f32x16_t acc;
#pragma unroll
                for (int r = 0; r < 16; ++r) acc[r] = 0.f;
#pragma unroll
                for (int s = 0; s < 4; ++s) { const bf16x8_t qf = *(const LAS bf16x8_t*)(qrow + (64 * h + 16 * s) * 2); acc = __builtin_amdgcn_mfma_f32_32x32x16_bf16(kf[s], qf, acc, 0, 0, 0); }
#pragma unroll
                for (int r = 0; r < 16; ++r) tot[r] = fmaf(wv[h], fmaxf(acc[r], 0.f), tot[r]);
            }
#pragma unroll
            for (int r = 0; r < 16; ++r) key[i][r] = sortable_key(tot[r]);
            __builtin_amdgcn_sched_barrier(0);
        } else {
#pragma unroll
            for (int r = 0; r < 16; ++r) key[i][r] = 0u;
        }
    }
    LAS int* cnts = (LAS int*)(lds + 32 * IDX_QPITCH);
    int step = 0;
#define IDX_REDUCE(cntvar, totvar) do { int c_ = (cntvar); c_ += __shfl_xor(c_, 32); const int buf_ = (step & 1) * 256; ++step; \
        if (lane < 32) cnts[buf_ + w * 32 + lane] = c_; __syncthreads(); int t_ = 0; _Pragma("unroll") for (int ww = 0; ww < 8; ++ww) t_ += cnts[buf_ + ww * 32 + r32]; (totvar) = t_; } while (0)
    unsigned T = 0u;
    for (int bit = 31; bit >= 0; --bit) {
        const unsigned cand = T | (1u << bit);
        int cnt = 0;
#pragma unroll
        for (int i = 0; i < 8; ++i) if (i < nloc) {
#pragma unroll
            for (int r = 0; r < 16; ++r) cnt += (key[i][r] >= cand) ? 1 : 0; }
        int tot; IDX_REDUCE(cnt, tot);
        if (tot >= TOPK) T = cand;
    }
    int cgt = 0, ceq = 0;
#pragma unroll
    for (int i = 0; i < 8; ++i) if (i < nloc) {
#pragma unroll
        for (int r = 0; r < 16; ++r) { cgt += (key[i][r] > T) ? 1 : 0; ceq += (key[i][r] == T) ? 1 : 0; } }
    int tgt, teq; IDX_REDUCE(cgt, tgt); IDX_REDUCE(ceq, teq);
    const int need = TOPK - tgt;
    int X = 1 << 20;
    if (__any(teq > need)) {
        X = 0;
        for (int bit = 10; bit >= 0; --bit) {
            const int cand = X | (1 << bit);
            int cnt = 0;
#pragma unroll
            for (int i = 0; i < 8; ++i) if (i < nloc) {
                const int ti = cand - 32 * (w + 8 * i) - 4 * hi;
#pragma unroll
                for (int r = 0; r < 16; ++r) cnt += (key[i][r] == T && ((r & 3) + 8 * (r >> 2)) < ti) ? 1 : 0; }
            int tot; IDX_REDUCE(cnt, tot);
            if (tot < need) X = cand;
        }
    }
#undef IDX_REDUCE
#pragma unroll
    for (int i = 0; i < 8; ++i) if (i < nloc) {
        const int j = w + 8 * i;
        const int xi = X - 32 * j - 4 * hi;
        unsigned long long mine = 0ull;
#pragma unroll
        for (int r = 0; r < 16; ++r) {
            const bool sel = (key[i][r] > T) || (key[i][r] == T && ((r & 3) + 8 * (r >> 2)) <= xi);
            const unsigned long long bal = __ballot(sel);
            if (lane == r) mine = bal; }
        if (lane < 16) mbase[(size_t)j * 16 + lane] = mine;
    }
}

__global__ void __launch_bounds__(512, 2) k_indexer(const bf16* __restrict__ proj, unsigned long long* __restrict__ mask) {
    extern __shared__ __attribute__((aligned(16))) unsigned char lds[];
    const int unit = blockIdx.x, b = unit & 15, qb = 63 - (unit >> 4);
    indexer_unit((LAS unsigned char*)lds, proj, mask, b, qb);
}

struct AttnArgs { const bf16* Q; const bf16* K; const bf16* V; const bf16* G; bf16* O; const unsigned long long* mask; int qpitch, qhs, kpitch, khs, vpitch, vhs, gpitch, ocol; };

template <int DQK> struct AttnCfg { static constexpr int KP = (DQK + 8) * 2, VP = 192, K_OFF = 0, V_OFF = 64 * KP, WS_OFF = V_OFF + 64 * VP, LDS = WS_OFF + 4 * 64 * 4; };

template <int DQK, bool MASKED>
__global__ void __launch_bounds__(256) k_attn(AttnArgs a) {
    typedef AttnCfg<DQK> C;
    __shared__ __attribute__((aligned(16))) unsigned char lds_raw[C::LDS];
    LAS unsigned char* lds = (LAS unsigned char*)lds_raw;
    const int tid = threadIdx.x, lane = tid & 63, w = __builtin_amdgcn_readfirstlane(tid >> 6), r32 = lane & 31, hi = lane >> 5;
    const int q0 = (15 - (int)blockIdx.x) * 128, h = blockIdx.y, b = blockIdx.z;
    const size_t rowb = (size_t)b * SEQ;
    const int qw = q0 + 32 * w, ntw = (qw >> 6) + 1, nt = (q0 >> 6) + 2;
    constexpr int NS = DQK / 16;
    bf16x8_t qf[NS];
    { const bf16* qp = a.Q + (rowb + qw + r32) * a.qpitch + h * a.qhs + 8 * hi;
#pragma unroll
      for (int s = 0; s < NS; ++s) qf[s] = *(const bf16x8_t*)(qp + 16 * s); }
    f32x16_t o0, o1;
#pragma unroll
    for (int r = 0; r < 16; ++r) { o0[r] = 0.f; o1[r] = 0.f; }
    float m = -INFINITY, l = 0.f;
    LAS float* wsf = (LAS float*)(lds + C::WS_OFF) + w * 64;
    const bf16* Kh = a.K + rowb * a.kpitch + h * a.khs; const bf16* Vh = a.V + rowb * a.vpitch + h * a.vhs;
    const unsigned long long* mrow = MASKED ? a.mask + ((size_t)(b * 64 + (qw >> 5)) * 64) * 16 : nullptr;
    const LAS unsigned char* kfrag = lds + C::K_OFF + r32 * C::KP + hi * 16;
    const LAS unsigned char* vfrag = lds + C::V_OFF + (4 * hi + ((lane & 15) >> 2)) * C::VP + (16 * ((lane >> 4) & 1) + 4 * (lane & 3)) * 2;
    for (int t = 0; t < nt; ++t) {
        __syncthreads();
        constexpr int KCH = DQK / 8;
        for (int c = tid; c < 64 * KCH; c += 256) { const int r = c / KCH, ch = c % KCH;
            *(LAS u32x4_t*)(lds + C::K_OFF + r * C::KP + ch * 16) = *(const u32x4_t*)(Kh + (size_t)(64 * t + r) * a.kpitch + ch * 8); }
        for (int c = tid; c < 64 * 8; c += 256) { const int r = c >> 3, ch = c & 7;
            *(LAS u32x4_t*)(lds + C::V_OFF + r * C::VP + ch * 16) = *(const u32x4_t*)(Vh + (size_t)(64 * t + r) * a.vpitch + ch * 8); }
        __syncthreads();
        if (t < ntw) {
            f32x16_t p0, p1;
#pragma unroll
            for (int r = 0; r < 16; ++r) { p0[r] = 0.f; p1[r] = 0.f; }
#pragma unroll
            for (int s = 0; s < NS; ++s) {
                const bf16x8_t k0 = *(const LAS bf16x8_t*)(kfrag + s * 32), k1 = *(const LAS bf16x8_t*)(kfrag + 32 * C::KP + s * 32);
                p0 = __builtin_amdgcn_mfma_f32_32x32x16_bf16(k0, qf[s], p0, 0, 0, 0);
                p1 = __builtin_amdgcn_mfma_f32_32x32x16_bf16(k1, qf[s], p1, 0, 0, 0);
            }
            if (MASKED) {
                const unsigned long long* mw = mrow + (size_t)(2 * t) * 16;
#pragma unroll
                for (int r = 0; r < 16; ++r) { const unsigned long long w0 = mw[r], w1 = mw[16 + r];
                    if (!((w0 >> lane) & 1ull)) p0[r] = -INFINITY;
                    if (!((w1 >> lane) & 1ull)) p1[r] = -INFINITY; }
            }
            float mx = fmaxf(p0[0], p1[0]);
#pragma unroll
            for (int r = 1; r < 16; ++r) mx = fmaxf(mx, fmaxf(p0[r], p1[r]));
            mx = fmaxf(mx, __shfl_xor(mx, 32));
            const float mnew = fmaxf(m, mx), muse = (mnew == -INFINITY) ? 0.f : mnew;
            const float alpha = __builtin_amdgcn_exp2f(m - muse);
            float rs = 0.f;
#pragma unroll
            for (int r = 0; r < 16; ++r) { p0[r] = __builtin_amdgcn_exp2f(p0[r] - muse); p1[r] = __builtin_amdgcn_exp2f(p1[r] - muse); rs += p0[r] + p1[r]; }
            rs += __shfl_xor(rs, 32);
            l = l * alpha + rs; m = mnew;
            if (hi == 0) wsf[r32] = alpha;
            asm volatile("s_waitcnt lgkmcnt(0)" ::: "memory");
#pragma unroll
            for (int r = 0; r < 16; ++r) { const float f = wsf[crow(r, hi)]; o0[r] *= f; o1[r] *= f; }
            bf16x8_t pa[4];
#pragma unroll
            for (int k = 0; k < 4; ++k) { u32x4_t pw;
#pragma unroll
                for (int i = 0; i < 4; ++i) { const float lo = (k < 2) ? p0[8 * (k & 1) + 2 * i] : p1[8 * (k & 1) + 2 * i], hh = (k < 2) ? p0[8 * (k & 1) + 2 * i + 1] : p1[8 * (k & 1) + 2 * i + 1]; pw[i] = pk2(lo, hh); }
                pa[k] = __builtin_bit_cast(bf16x8_t, pw); }
#pragma unroll
            for (int k = 0; k < 4; ++k) {
#pragma unroll
                for (int db = 0; db < 2; ++db) {
                    const LAS unsigned char* vp = vfrag + (16 * k) * C::VP + db * 64;
                    const s16x4_t lo = __builtin_bit_cast(s16x4_t, __builtin_amdgcn_ds_read_tr16_b64_v4i16((LAS s16x4_t*)vp));
                    const s16x4_t hh = __builtin_bit_cast(s16x4_t, __builtin_amdgcn_ds_read_tr16_b64_v4i16((LAS s16x4_t*)(vp + 8 * C::VP)));
                    const bf16x8_t vb = (bf16x8_t){lo[0], lo[1], lo[2], lo[3], hh[0], hh[1], hh[2], hh[3]};
                    if (db == 0) o0 = __builtin_amdgcn_mfma_f32_32x32x16_bf16(pa[k], vb, o0, 0, 0, 0);
                    else o1 = __builtin_amdgcn_mfma_f32_32x32x16_bf16(pa[k], vb, o1, 0, 0, 0);
                }
            }
        }
    }
    asm volatile("s_waitcnt lgkmcnt(0)" ::: "memory");
    if (hi == 0) wsf[32 + r32] = l;
    asm volatile("s_waitcnt lgkmcnt(0)" ::: "memory");
#pragma unroll
    for (int r = 0; r < 16; ++r) {
        const int row = qw + crow(r, hi);
        const float inv = 1.0f / wsf[32 + crow(r, hi)];
        const bf16* gp = a.G + (rowb + row) * a.gpitch + 64 * h;
        bf16* op = a.O + (rowb + row) * 1024 + a.ocol + 64 * h;
        const float g0 = bf2f(gp[r32]), g1 = bf2f(gp[32 + r32]);
        const float s0 = g0 / (1.0f + __expf(-g0)), s1 = g1 / (1.0f + __expf(-g1));
        op[r32] = (bf16)f2bf(o0[r] * inv * s0); op[32 + r32] = (bf16)f2bf(o1[r] * inv * s1);
    }
}

extern "C" void kernel_launch(void* const* d_in, const int* in_sizes, int n_in, void* d_out, int out_size, void* d_ws, size_t ws_size, hipStream_t stream) {
    static int ready = 0;
    if (!ready) {
        if (n_in != 12 || in_sizes[0] != MTOK * DMODEL || out_size != MTOK * DMODEL || ws_size < WS_END) {
            fprintf(stderr, "kernel_launch: unexpected shapes / workspace (n_in %d, in0 %d, out %d, ws %zu)\n", n_in, n_in > 0 ? in_sizes[0] : -1, out_size, ws_size); ready = -1; return; }
        (void)hipFuncSetAttribute((const void*)k_gemm_bf16, hipFuncAttributeMaxDynamicSharedMemorySize, GEMM_LDS);
        (void)hipFuncSetAttribute((const void*)k_gemm_res, hipFuncAttributeMaxDynamicSharedMemorySize, GEMM_LDS);
        ready = 1;
    }
    if (ready < 0) return;
    const float* x = (const float*)d_in[0]; const float* norm_gain = (const float*)d_in[1]; const float* w_in = (const float*)d_in[2];
    const float* a_q_norm = (const float*)d_in[3]; const float* a_k_norm = (const float*)d_in[4]; const float* b_q_lat = (const float*)d_in[5]; const float* b_kv_lat = (const float*)d_in[6];
    const float* w_uq = (const float*)d_in[7]; const float* w_ukv = (const float*)d_in[8]; const float* b_q_norm = (const float*)d_in[9]; const float* b_k_norm = (const float*)d_in[10];
    const float* w_out = (const float*)d_in[11];
    unsigned char* ws = (unsigned char*)d_ws;
    bf16* WIN = (bf16*)(ws + WS_WIN); bf16* WUQ = (bf16*)(ws + WS_WUQ); bf16* WUKV = (bf16*)(ws + WS_WUKV); bf16* WOUT = (bf16*)(ws + WS_WOUT);
    float* RC = (float*)(ws + WS_ROPE); float* RS = RC + SEQ * 32;
    bf16* XN = (bf16*)(ws + WS_XN); bf16* MIXED = (bf16*)(ws + WS_MIXED); bf16* PROJ = (bf16*)(ws + WS_PROJ);
    bf16* QB = (bf16*)(ws + WS_QB); bf16* KVR = (bf16*)(ws + WS_KVR); bf16* KB = (bf16*)(ws + WS_KB);
    unsigned long long* MASK = (unsigned long long*)(ws + WS_MASK);
    float* out = (float*)d_out;

    k_rope_table<<<SEQ * 32 / 256, 256, 0, stream>>>(RC, RS);
    k_wtrans<true><<<dim3(NP / 64, 1024 / 64), 256, 0, stream>>>(w_in, 1024, D_IN_OLD, WIN);
    k_wtrans<false><<<dim3(768 / 64, 384 / 64), 256, 0, stream>>>(w_uq, 384, 768, WUQ);
    k_wtrans<false><<<dim3(1024 / 64, 256 / 64), 256, 0, stream>>>(w_ukv, 256, 1024, WUKV);
    k_wtrans<false><<<dim3(1024 / 64, 1024 / 64), 256, 0, stream>>>(w_out, 1024, 1024, WOUT);
    k_rmsnorm_x<<<MTOK / 4, 256, 0, stream>>>(x, norm_gain, XN);
    { pg8::Gemm g{XN, WIN, MTOK, NP, 1024, 1024}; k_gemm_bf16<<<256, 512, GEMM_LDS, stream>>>(g, PROJ, NP); }
    k_post_a<<<MTOK / 4, 256, 0, stream>>>(PROJ, a_q_norm, a_k_norm, b_q_lat, b_kv_lat, RC, RS);
    { pg8::Gemm g{PROJ + C_CQ, WUQ, MTOK, 768, 384, NP}; k_gemm_bf16<<<256, 512, GEMM_LDS, stream>>>(g, QB, 768); }
    { pg8::Gemm g{PROJ + C_CKV, WUKV, MTOK, 1024, 256, NP}; k_gemm_bf16<<<256, 512, GEMM_LDS, stream>>>(g, KVR, 1024); }
    k_post_b<<<MTOK / 4, 256, 0, stream>>>(QB, KVR, PROJ, KB, b_q_norm, b_k_norm, RC, RS);
    k_indexer<<<BATCH * 64, 512, IDX_LDS, stream>>>(PROJ, MASK);
    { AttnArgs a{PROJ + C_QA, PROJ + C_KA, PROJ + C_VA, PROJ + C_GA, MIXED, MASK, NP, 64, NP, 64, NP, 64, NP, 0};
      k_attn<64, true><<<dim3(16, 8, BATCH), 256, 0, stream>>>(a); }
    { AttnArgs a{QB, KB, KVR + 64, PROJ + C_GB, MIXED, nullptr, 768, 96, 768, 96, 1024, 128, NP, 512};
      k_attn<96, false><<<dim3(16, 8, BATCH), 256, 0, stream>>>(a); }
    { pg8::Gemm g{MIXED, WOUT, MTOK, 1024, 1024, 1024}; k_gemm_res<<<256, 512, GEMM_LDS, stream>>>(g, x, out, 1024); }
}
```

```cpp
#include <hip/hip_runtime.h>
#include <cstdint>
#include <cstdio>

constexpr int BATCH = 16, SEQ = 2048, DMODEL = 1024, MTOK = BATCH * SEQ;
constexpr int NP = 3840;
constexpr int C_QA = 0, C_KA = 512, C_VA = 1024, C_GA = 1536, C_QI = 2048, C_GB = 2560, C_CQ = 3072, C_CKV = 3456, C_KI = 3712, C_KR = 3776, C_WI = 3808;
constexpr int D_IN_OLD = 3816;
constexpr float RMS_EPS = 1e-6f;
constexpr float LOG2E = 1.4426950408889634f;
constexpr float C2A = 0.125f * LOG2E;
constexpr float C2B = 0.10206207261596575f * LOG2E;

constexpr size_t MiB = 1u << 20;
constexpr size_t WS_CTL = 0;
constexpr size_t WS_WIN = 2 * MiB;
constexpr size_t WS_WUQ = 10 * MiB;
constexpr size_t WS_WUKV = 11 * MiB;
constexpr size_t WS_WOUT = 12 * MiB;
constexpr size_t WS_ROPE = 14 * MiB;
constexpr size_t WS_XN = 16 * MiB;
constexpr size_t WS_MIXED = WS_XN;
constexpr size_t WS_PROJ = 80 * MiB;
constexpr size_t WS_QB = 320 * MiB;
constexpr size_t WS_KVR = 368 * MiB;
constexpr size_t WS_KB = 432 * MiB;
constexpr size_t WS_MASK = 480 * MiB;
constexpr size_t WS_END = 488 * MiB;

typedef unsigned short bf16;
typedef short bf16x8_t __attribute__((ext_vector_type(8)));
typedef short s16x4_t __attribute__((ext_vector_type(4)));
typedef float f32x16_t __attribute__((ext_vector_type(16)));
typedef float f32x4_t __attribute__((ext_vector_type(4)));
typedef unsigned u32x4_t __attribute__((ext_vector_type(4)));
typedef unsigned u32x2_t __attribute__((ext_vector_type(2)));
#define LAS __attribute__((address_space(3)))

__device__ __forceinline__ unsigned f2bf(float f) { unsigned u = __builtin_bit_cast(unsigned, f); return (u + 0x7fffu + ((u >> 16) & 1u)) >> 16; }
__device__ __forceinline__ unsigned pk2(float lo, float hi) { return f2bf(lo) | (f2bf(hi) << 16); }
__device__ __forceinline__ float bflo(unsigned u) { return __builtin_bit_cast(float, u << 16); }
__device__ __forceinline__ float bfhi(unsigned u) { return __builtin_bit_cast(float, u & 0xffff0000u); }
__device__ __forceinline__ float bf2f(bf16 b) { return __builtin_bit_cast(float, (unsigned)b << 16); }
__device__ __forceinline__ int crow(int r, int hi) { return (r & 3) + 8 * (r >> 2) + 4 * hi; }

__device__ __forceinline__ int opaque_tid() { int t = (int)threadIdx.x; asm volatile("" : "+v"(t)); return t; }

namespace pg8 {
#define PG8_LAS __attribute__((address_space(3)))
typedef unsigned short bf16_t;
typedef short bf16x8 __attribute__((ext_vector_type(8)));
typedef float f32x4 __attribute__((ext_vector_type(4)));
typedef unsigned u32x4 __attribute__((ext_vector_type(4)));
constexpr int BM = 256, BK = 64, HALF = 128, HTB = HALF * BK * 2  , STAGE_BYTES = 8 * HTB, NXCD = 8, WGM = 8;

__host__ __device__ __forceinline__ int lds_byte(int r, int c) { const int st = (r >> 4) * 2 + (c >> 5), rr = r & 15, cc = c & 31, ob = rr * 64 + cc * 2; return st * 1024 + (ob ^ (((ob >> 9) & 1) << 5)); }
__host__ __device__ __forceinline__ void stage_rc(int b, int& R, int& C) { const int st = b / 1024, sb = b % 1024, swz = sb ^ (((sb >> 9) & 1) << 5); R = (st >> 1) * 16 + swz / 64; C = (st & 1) * 32 + (swz % 64) / 2; }
__host__ __device__ __forceinline__ int perm32(int rho) { const int n = rho >> 4, i = rho & 15; return 8 * (i >> 2) + 4 * n + (i & 3); }

struct Unit { int pm, pn; };
struct Gemm { const bf16_t* A; const bf16_t* Bt; int M, N, K, lda; };

struct StaticOrder {
    int nM, nN, nwg, G, c;
    __host__ __device__ void init(int M, int N, int G_, int c_) { nM = M / BM; nN = N / BM; nwg = nM * nN; G = G_; c = c_; }
    __host__ __device__ bool next(int i, Unit& u) const {
        const long L = (long)i * G + c; if (L >= nwg) return false;
        int wgid = (int)L; { const int q = nwg / NXCD, r = nwg % NXCD, xcd = wgid % NXCD, off = wgid / NXCD; wgid = (xcd < r ? xcd * (q + 1) : r * (q + 1) + (xcd - r) * q) + off; }
        const int nig = WGM * nN, gid = wgid / nig, fm = gid * WGM, gsz = (nM - fm) < WGM ? (nM - fm) : WGM;
        u.pm = fm + ((wgid % nig) % gsz); u.pn = (wgid % nig) / gsz; return true;
    }
    __device__ __forceinline__ void a_ready(const Unit&) const {}
    __device__ __forceinline__ void done(const Unit&) const {}
};

__device__ __forceinline__ unsigned cvt_pk_bf16(float lo, float hi) { unsigned r; asm volatile("v_cvt_pk_bf16_f32 %0, %1, %2" : "=v"(r) : "v"(lo), "v"(hi)); return r; }
typedef float f32x2 __attribute__((ext_vector_type(2)));
__device__ __forceinline__ f32x2 gelu_pk(f32x2 v) {
    const f32x2 av = __builtin_elementwise_abs(v), d = av * 0.2316418882f + 1.0f;
    f32x2 t; t.x = __builtin_amdgcn_rcpf(d.x); t.y = __builtin_amdgcn_rcpf(d.y);
    f32x2 q = t * 0.5307027145f + (-0.7265760135f); q = q * t + 0.7107068705f; q = q * t + (-0.142248368f); q = q * t + 0.127414796f; q = q * t;
    const f32x2 s = (v * v) * (-0.72134752044f);
    f32x2 e; e.x = __builtin_amdgcn_exp2f(s.x); e.y = __builtin_amdgcn_exp2f(s.y);
    const f32x2 m = v * (q * e), r = v - m;
    f32x2 o; o.x = v.x < 0.f ? m.x : r.x; o.y = v.y < 0.f ? m.y : r.y; return o;
}

template <int ACT  > struct EpiBf16 {
    static constexpr bool PERM = true, AFTER_DRAIN = false; static_assert(ACT == 0 || ACT == 1, "EpiBf16: ACT is 0 (none) or 1 (gelu_pk)");
    bf16_t* O; int ldc; const float* bias; int split_cols; size_t split_stride; float scale0;
    __device__ __forceinline__ void operator()(const f32x4 (&acc)[2][2][4][2], const Unit& u, int wr, int wc, int fr, int fq) const {
        const int row0 = u.pm * BM + wr * 64 + fr; int colt = u.pn * BM; bf16_t* base = O;
        float sc = 1.f; if (split_cols) { const int t = colt / split_cols; base += (size_t)t * split_stride; colt -= t * split_cols; if (t == 0) sc = scale0; }
        const int col0 = colt + wc * 32 + 8 * fq, bcol0 = u.pn * BM + wc * 32 + 8 * fq;
        f32x4 bv[2][2];
#pragma unroll
        for (int bj = 0; bj < 2; ++bj)
#pragma unroll
            for (int n = 0; n < 2; ++n) bv[bj][n] = bias ? *(const f32x4*)(bias + bcol0 + bj * HALF + 4 * n) : (f32x4){0.f, 0.f, 0.f, 0.f};
#pragma unroll
        for (int ai = 0; ai < 2; ++ai)
#pragma unroll
            for (int m = 0; m < 4; ++m) { bf16_t* rowp = base + (size_t)(row0 + ai * HALF + m * 16) * ldc + col0;
#pragma unroll
                for (int bj = 0; bj < 2; ++bj) { f32x4 v0 = acc[ai][bj][m][0] + bv[bj][0], v1 = acc[ai][bj][m][1] + bv[bj][1];
                    if (ACT == 1) { f32x2 a = gelu_pk((f32x2){v0[0], v0[1]}), b = gelu_pk((f32x2){v0[2], v0[3]}), c = gelu_pk((f32x2){v1[0], v1[1]}), d = gelu_pk((f32x2){v1[2], v1[3]});
                        v0 = (f32x4){a.x, a.y, b.x, b.y}; v1 = (f32x4){c.x, c.y, d.x, d.y}; }
                    v0 = v0 * sc; v1 = v1 * sc; u32x4 w; w.x = cvt_pk_bf16(v0[0], v0[1]); w.y = cvt_pk_bf16(v0[2], v0[3]); w.z = cvt_pk_bf16(v1[0], v1[1]); w.w = cvt_pk_bf16(v1[2], v1[3]);
                    *(u32x4*)(rowp + bj * HALF) = w; } }
    }
};
template <class Epi, class Sched, bool ALIGN_EPI = false, bool SP2 = false>
__device__ __forceinline__ void gemm_phase(PG8_LAS unsigned char* lds, const Gemm g, const Sched& S, const Epi& E) {
    const int tid = opaque_tid(), wid = __builtin_amdgcn_readfirstlane(tid >> 6), lane = tid & 63, wr = wid >> 2, wc = wid & 3, fr = lane & 15, fq = lane >> 4;
    const int K = g.K, nt = K / BK, lda = g.lda;
    unsigned voffA[2], voffB[2];
#pragma unroll
    for (int i = 0; i < 2; ++i) { int R, C; stage_rc(tid * 16 + i * 8192, R, C); const int Rb = Epi::PERM ? ((R & ~31) + perm32(R & 31)) : R;
        voffA[i] = (unsigned)(R * lda + C) * 2u; voffB[i] = (unsigned)(Rb * K + C) * 2u; }
    const size_t kstep = (size_t)(BK * 2);
    const size_t hstepA = (size_t)HALF * lda * 2, hstepB = (size_t)HALF * K * 2;
    const size_t tstepA = 2 * hstepA, tstepB = 2 * hstepB;
    const unsigned ldsw = (unsigned)wid * 1024u;
    const int aoff = lds_byte(wr * 64 + fr, fq * 8), boff = lds_byte(wc * 32 + fr, fq * 8);
#define PG8_SA(b, h) (((b) * 2 + (h)) * HTB)
#define PG8_SB(b, h) ((4 + (b) * 2 + (h)) * HTB)
#define PG8_STAGE(bufoff, gbase, voff) do { _Pragma("unroll") for (int _i = 0; _i < 2; ++_i) \
        __builtin_amdgcn_global_load_lds((const unsigned*)((const char*)(gbase) + (voff)[_i]), (PG8_LAS unsigned*)(lds + (bufoff) + ldsw + _i * 8192), 16, 0, 0); } while (0)
#define PG8_LDA(dst, b, h) do { _Pragma("unroll") for (int m = 0; m < 4; ++m) _Pragma("unroll") for (int k = 0; k < 2; ++k) dst[m][k] = *(const PG8_LAS bf16x8*)(lds + PG8_SA(b, h) + aoff + m * 2048 + k * 1024); } while (0)
#define PG8_LDB(dst, b, h) do { _Pragma("unroll") for (int n = 0; n < 2; ++n) _Pragma("unroll") for (int k = 0; k < 2; ++k) dst[n][k] = *(const PG8_LAS bf16x8*)(lds + PG8_SB(b, h) + boff + n * 2048 + k * 1024); } while (0)
#define PG8_MMA(ai, bj, At, Bt) do { __builtin_amdgcn_s_setprio(1); _Pragma("unroll") for (int m = 0; m < 4; ++m) _Pragma("unroll") for (int n = 0; n < 2; ++n) _Pragma("unroll") for (int k = 0; k < 2; ++k) \
        acc[ai][bj][m][n] = __builtin_amdgcn_mfma_f32_16x16x32_bf16(Bt[n][k], At[m][k], acc[ai][bj][m][n], 0, 0, 0); __builtin_amdgcn_s_setprio(0); } while (0)
#define PG8_WAIT_V(n) asm volatile("s_waitcnt vmcnt(" #n ")" ::: "memory")
#define PG8_WAIT_L(n) asm volatile("s_waitcnt lgkmcnt(" #n ")" ::: "memory")
#define PG8_BAR __builtin_amdgcn_s_barrier()
#define PG8_SCHED __builtin_amdgcn_sched_barrier(0)
    Unit cur, nxt; int ui = 0;
    if (!S.next(0, cur)) return;
    f32x4 acc[2][2][4][2];
#pragma unroll
    for (int a = 0; a < 2; ++a)
#pragma unroll
        for (int b = 0; b < 2; ++b)
#pragma unroll
            for (int m = 0; m < 4; ++m)
#pragma unroll
                for (int n = 0; n < 2; ++n) acc[a][b][m][n] = (f32x4){0.f, 0.f, 0.f, 0.f};
    bf16x8 At[4][2], B0[2][2], B1[2][2];
    const char* cA = (const char*)g.A + (size_t)cur.pm * tstepA; const char* cB = (const char*)g.Bt + (size_t)cur.pn * tstepB;
    S.a_ready(cur);
    if constexpr (SP2) {
        PG8_STAGE(PG8_SB(0, 0), cB, voffB); PG8_STAGE(PG8_SB(0, 1), cB + hstepB, voffB); PG8_STAGE(PG8_SA(0, 0), cA, voffA); PG8_STAGE(PG8_SA(0, 1), cA + hstepA, voffA);
        if (wr == 1) PG8_BAR;
        PG8_WAIT_V(2); PG8_BAR;
        PG8_STAGE(PG8_SB(1, 0), cB + kstep, voffB); PG8_STAGE(PG8_SA(1, 0), cA + kstep, voffA); PG8_STAGE(PG8_SB(1, 1), cB + hstepB + kstep, voffB);
        PG8_WAIT_V(6); PG8_BAR;
    } else {
        PG8_STAGE(PG8_SB(0, 0), cB, voffB); PG8_STAGE(PG8_SA(0, 0), cA, voffA); PG8_STAGE(PG8_SB(0, 1), cB + hstepB, voffB); PG8_STAGE(PG8_SA(0, 1), cA + hstepA, voffA);
        if (wr == 1) PG8_BAR;
        PG8_WAIT_V(4); PG8_BAR;
        PG8_STAGE(PG8_SB(1, 0), cB + kstep, voffB); PG8_STAGE(PG8_SA(1, 0), cA + kstep, voffA); PG8_STAGE(PG8_SB(1, 1), cB + hstepB + kstep, voffB);
        PG8_WAIT_V(6); PG8_BAR;
    }
    for (;;) {
        const bool has_next = S.next(ui + 1, nxt);
        const char* nA = has_next ? (const char*)g.A + (size_t)nxt.pm * tstepA : cA; const char* nB = has_next ? (const char*)g.Bt + (size_t)nxt.pn * tstepB : cB;
        for (int t = 0; t < nt; t += 2) {
            const bool last = (t == nt - 2);
            const char* a1 = cA + (size_t)(t + 1) * kstep;
            const char* a2 = last ? nA : cA + (size_t)(t + 2) * kstep; const char* b2 = last ? nB : cB + (size_t)(t + 2) * kstep;
            const char* a3 = a2 + kstep; const char* b3 = b2 + kstep;
            if (last && has_next) S.a_ready(nxt);
            if constexpr (SP2) {
            PG8_LDB(B0, 0, 0); PG8_LDB(B1, 0, 1); PG8_SCHED; PG8_LDA(At, 0, 0); PG8_STAGE(PG8_SA(1, 1), a1 + hstepA, voffA);
            PG8_WAIT_V(8); PG8_WAIT_L(0); PG8_BAR; PG8_MMA(0, 0, At, B0); PG8_MMA(0, 1, At, B1); PG8_BAR; PG8_SCHED;
            PG8_LDA(At, 0, 1); PG8_STAGE(PG8_SB(0, 0), b2, voffB); PG8_STAGE(PG8_SB(0, 1), b2 + hstepB, voffB); PG8_STAGE(PG8_SA(0, 0), a2, voffA);
            PG8_WAIT_V(8); PG8_WAIT_L(0); PG8_BAR; PG8_MMA(1, 0, At, B0); PG8_MMA(1, 1, At, B1); PG8_BAR; PG8_SCHED;
            PG8_LDB(B0, 1, 0); PG8_LDB(B1, 1, 1); PG8_SCHED; PG8_LDA(At, 1, 0); PG8_STAGE(PG8_SA(0, 1), a2 + hstepA, voffA);
            PG8_WAIT_V(8); PG8_WAIT_L(0); PG8_BAR; PG8_MMA(0, 0, At, B0); PG8_MMA(0, 1, At, B1); PG8_BAR; PG8_SCHED;
            PG8_LDA(At, 1, 1); PG8_STAGE(PG8_SB(1, 0), b3, voffB); PG8_STAGE(PG8_SB(1, 1), b3 + hstepB, voffB); PG8_STAGE(PG8_SA(1, 0), a3, voffA);
            PG8_WAIT_V(8); PG8_WAIT_L(0); PG8_BAR; PG8_MMA(1, 0, At, B0); PG8_MMA(1, 1, At, B1); PG8_BAR; PG8_SCHED;
            } else {
            PG8_LDB(B0, 0, 0); PG8_SCHED; PG8_LDA(At, 0, 0); PG8_STAGE(PG8_SA(1, 1), a1 + hstepA, voffA);
            PG8_WAIT_L(8); PG8_BAR; PG8_WAIT_L(0); PG8_MMA(0, 0, At, B0); PG8_BAR; PG8_SCHED;
            PG8_LDB(B1, 0, 1); PG8_STAGE(PG8_SB(0, 0), b2, voffB);
            PG8_BAR; PG8_WAIT_L(0); PG8_MMA(0, 1, At, B1); PG8_BAR;
            PG8_LDA(At, 0, 1); PG8_STAGE(PG8_SA(0, 0), a2, voffA);
            PG8_BAR; PG8_WAIT_L(0); PG8_MMA(1, 0, At, B0); PG8_BAR; PG8_SCHED;
            PG8_STAGE(PG8_SB(0, 1), b2 + hstepB, voffB);
            PG8_WAIT_V(6); PG8_BAR; PG8_MMA(1, 1, At, B1); PG8_BAR;
            PG8_LDB(B0, 1, 0); PG8_SCHED; PG8_LDA(At, 1, 0); PG8_STAGE(PG8_SA(0, 1), a2 + hstepA, voffA);
            PG8_WAIT_L(8); PG8_BAR; PG8_WAIT_L(0); PG8_MMA(0, 0, At, B0); PG8_BAR; PG8_SCHED;
            PG8_LDB(B1, 1, 1); PG8_STAGE(PG8_SB(1, 0), b3, voffB);
            PG8_BAR; PG8_WAIT_L(0); PG8_MMA(0, 1, At, B1); PG8_BAR;
            PG8_LDA(At, 1, 1); PG8_STAGE(PG8_SA(1, 0), a3, voffA);
            PG8_BAR; PG8_WAIT_L(0); PG8_MMA(1, 0, At, B0); PG8_BAR; PG8_SCHED;
            PG8_STAGE(PG8_SB(1, 1), b3 + hstepB, voffB);
            PG8_WAIT_V(6); PG8_BAR; PG8_MMA(1, 1, At, B1); PG8_BAR;
            }
        }
        if constexpr (ALIGN_EPI) { if (wr == 0) PG8_BAR; }
        if constexpr (!Epi::AFTER_DRAIN) { E(acc, cur, wr, wc, fr, fq); S.done(cur); }
        if (!has_next) break;
#pragma unroll
        for (int a = 0; a < 2; ++a)
#pragma unroll
            for (int b = 0; b < 2; ++b)
#pragma unroll
                for (int m = 0; m < 4; ++m)
#pragma unroll
                    for (int n = 0; n < 2; ++n) acc[a][b][m][n] = (f32x4){0.f, 0.f, 0.f, 0.f};
        cur = nxt; cA = nA; cB = nB; ++ui;
        if constexpr (ALIGN_EPI) { if (wr == 1) PG8_BAR; }
    }
    PG8_WAIT_V(0);
    if constexpr (!ALIGN_EPI) { if (wr == 0) PG8_BAR; }
    PG8_BAR;
    if constexpr (Epi::AFTER_DRAIN) { E.fused(acc, cur, wr, wc, fr, fq, lds, wid, lane); S.done(cur); }
#undef PG8_SA
#undef PG8_SB
#undef PG8_STAGE
#undef PG8_LDA
#undef PG8_LDB
#undef PG8_MMA
#undef PG8_WAIT_V
#undef PG8_WAIT_L
#undef PG8_BAR
#undef PG8_SCHED
}
}

#ifndef PG8_SP2
#define PG8_SP2 true
#endif
#ifndef PG8_ALIGN
#define PG8_ALIGN true
#endif

namespace pg8 {
struct EpiResF32 {
    static constexpr bool PERM = false, AFTER_DRAIN = false;
    const float* base; float* out; int ldc;
    __device__ __forceinline__ void operator()(const f32x4 (&acc)[2][2][4][2], const Unit& u, int wr, int wc, int fr, int fq) const {
        const int col0 = u.pn * BM + wc * 32 + 4 * fq;
#pragma unroll
        for (int ai = 0; ai < 2; ++ai)
#pragma unroll
            for (int m = 0; m < 4; ++m) { const size_t off = (size_t)(u.pm * BM + ai * HALF + wr * 64 + m * 16 + fr) * ldc + col0;
#pragma unroll
                for (int bj = 0; bj < 2; ++bj)
#pragma unroll
                    for (int n = 0; n < 2; ++n) { const f32x4 b = *(const f32x4*)(base + off + bj * HALF + n * 16); *(f32x4*)(out + off + bj * HALF + n * 16) = b + acc[ai][bj][m][n]; } }
    }
};
}

constexpr int GEMM_LDS = pg8::STAGE_BYTES;

__device__ __forceinline__ void rope_table_elem(float* ct, float* st, int idx) {
    const int pos = idx >> 5, j = idx & 31;
    const float freq = exp2f(-(float)j * (13.287712379549449f / 32.0f));
    const float ang = (float)pos * freq;
    double rev = (double)ang * 0.15915494309189535;
    rev -= floor(rev);
    const float fr = (float)rev;
    ct[idx] = __builtin_amdgcn_cosf(fr);
    st[idx] = __builtin_amdgcn_sinf(fr);
}

__device__ __forceinline__ int win_src_col(int n) {
    if (n < 2560) return n;
    if (n < 3072) return n - 2560 + 3304;
    if (n < 3456) return n - 3072 + 2632;
    if (n < 3712) return n - 3456 + 3016;
    if (n < 3776) return n - 3712 + 2560;
    if (n < 3808) return n - 3776 + 3272;
    if (n < 3816) return n - 3808 + 2624;
    return -1;
}
__device__ __forceinline__ void wtrans_tile(LAS float* t, const float* __restrict__ W, int K, int Nold, bf16* __restrict__ WT, int n0, int k0, bool remap, int tid) {
    __syncthreads();
    for (int i = tid; i < 4096; i += 512) { const int kk = i >> 6, nn = i & 63; const int n = n0 + nn; const int src = remap ? win_src_col(n) : n;
        t[kk * 65 + nn] = (src >= 0) ? W[(size_t)(k0 + kk) * Nold + src] : 0.f; }
    __syncthreads();
    for (int i = tid; i < 4096; i += 512) { const int nn = i >> 6, kk = i & 63; WT[(size_t)(n0 + nn) * K + k0 + kk] = (bf16)f2bf(t[kk * 65 + nn]); }
}

__device__ __forceinline__ float wave_sum(float v) {
#pragma unroll
    for (int o = 1; o < 64; o <<= 1) v += __shfl_xor(v, o);
    return v;
}
__device__ __forceinline__ void rmsnorm_x_row(const float* __restrict__ x, const float* __restrict__ g, bf16* __restrict__ xn, int row, int lane) {
    const f32x4_t* xr = (const f32x4_t*)(x + (size_t)row * DMODEL) + lane;
    const f32x4_t* gr = (const f32x4_t*)g + lane;
    f32x4_t v[4]; float s = 0.f;
#pragma unroll
    for (int j = 0; j < 4; ++j) { v[j] = xr[64 * j]; s += (v[j].x * v[j].x + v[j].y * v[j].y) + (v[j].z * v[j].z + v[j].w * v[j].w); }
    const float rs = 1.0f / sqrtf(wave_sum(s) * (1.0f / DMODEL) + RMS_EPS);
    u32x2_t* o = (u32x2_t*)(xn + (size_t)row * DMODEL) + lane;
#pragma unroll
    for (int j = 0; j < 4; ++j) { const f32x4_t gg = gr[64 * j]; u32x2_t w; w.x = pk2(v[j].x * rs * gg.x, v[j].y * rs * gg.y); w.y = pk2(v[j].z * rs * gg.z, v[j].w * rs * gg.w); o[64 * j] = w; }
}

__device__ __forceinline__ void post_a_row(bf16* __restrict__ proj, const float* __restrict__ aq_g, const float* __restrict__ ak_g,
                                           const float* __restrict__ cq_g, const float* __restrict__ ckv_g, const float* __restrict__ ropec, const float* __restrict__ ropes, int row, int lane) {
    const int pos = row & (SEQ - 1);
    bf16* p = proj + (size_t)row * NP;
    const float* cs = ropec + pos * 32; const float* sn = ropes + pos * 32;
    const int h = lane >> 3, j = lane & 7;
#pragma unroll
    for (int which = 0; which < 2; ++which) {
        bf16* base = p + (which ? C_KA : C_QA) + 64 * h;
        const float* g = which ? ak_g : aq_g;
        const u32x2_t r1 = *(const u32x2_t*)(base + 4 * j), r2 = *(const u32x2_t*)(base + 32 + 4 * j);
        float x1[4] = {bflo(r1.x), bfhi(r1.x), bflo(r1.y), bfhi(r1.y)}, x2[4] = {bflo(r2.x), bfhi(r2.x), bflo(r2.y), bfhi(r2.y)};
        float ss = 0.f;
#pragma unroll
        for (int i = 0; i < 4; ++i) ss += x1[i] * x1[i] + x2[i] * x2[i];
        ss += __shfl_xor(ss, 1); ss += __shfl_xor(ss, 2); ss += __shfl_xor(ss, 4);
        const float rs = 1.0f / sqrtf(ss * (1.0f / 64.0f) + RMS_EPS);
        const float sc = which ? 1.0f : C2A;
        float o1[4], o2[4];
#pragma unroll
        for (int i = 0; i < 4; ++i) { const int d = 4 * j + i; const float a = x1[i] * rs * g[d], b = x2[i] * rs * g[d + 32]; const float c = cs[d], s = sn[d];
            o1[i] = (a * c - b * s) * sc; o2[i] = (b * c + a * s) * sc; }
        u32x2_t w1, w2; w1.x = pk2(o1[0], o1[1]); w1.y = pk2(o1[2], o1[3]); w2.x = pk2(o2[0], o2[1]); w2.y = pk2(o2[2], o2[3]);
        *(u32x2_t*)(base + 4 * j) = w1; *(u32x2_t*)(base + 32 + 4 * j) = w2;
    }
    {
        bf16* base = p + C_QI + 64 * h;
        const unsigned r1 = *(const unsigned*)(base + 2 * j), r2 = *(const unsigned*)(base + 16 + 2 * j);
        const float a0 = bflo(r1), a1 = bfhi(r1), b0 = bflo(r2), b1 = bfhi(r2);
        const float c0 = cs[4 * j], s0 = sn[4 * j], c1 = cs[4 * j + 2], s1 = sn[4 * j + 2];
        *(unsigned*)(base + 2 * j) = pk2(a0 * c0 - b0 * s0, a1 * c1 - b1 * s1);
        *(unsigned*)(base + 16 + 2 * j) = pk2(b0 * c0 + a0 * s0, b1 * c1 + a1 * s1);
    }
    if (lane < 8) {
        bf16* base = p + C_KI;
        const unsigned r1 = *(const unsigned*)(base + 2 * j), r2 = *(const unsigned*)(base + 16 + 2 * j);
        const float a0 = bflo(r1), a1 = bfhi(r1), b0 = bflo(r2), b1 = bfhi(r2);
        const float c0 = cs[4 * j], s0 = sn[4 * j], c1 = cs[4 * j + 2], s1 = sn[4 * j + 2];
        *(unsigned*)(base + 2 * j) = pk2(a0 * c0 - b0 * s0, a1 * c1 - b1 * s1);
        *(unsigned*)(base + 16 + 2 * j) = pk2(b0 * c0 + a0 * s0, b1 * c1 + a1 * s1);
    }
    {
        unsigned* base = (unsigned*)(p + C_CQ + 6 * lane);
        const unsigned r0 = base[0], r1 = base[1], r2 = base[2];
        float v[6] = {bflo(r0), bfhi(r0), bflo(r1), bfhi(r1), bflo(r2), bfhi(r2)};
        float ss = 0.f;
#pragma unroll
        for (int i = 0; i < 6; ++i) ss += v[i] * v[i];
        const float rs = 1.0f / sqrtf(wave_sum(ss) * (1.0f / 384.0f) + RMS_EPS);
        const float* g = cq_g + 6 * lane;
        base[0] = pk2(v[0] * rs * g[0], v[1] * rs * g[1]); base[1] = pk2(v[2] * rs * g[2], v[3] * rs * g[3]); base[2] = pk2(v[4] * rs * g[4], v[5] * rs * g[5]);
    }
    {
        u32x2_t* base = (u32x2_t*)(p + C_CKV + 4 * lane);
        const u32x2_t r = *base;
        float v[4] = {bflo(r.x), bfhi(r.x), bflo(r.y), bfhi(r.y)};
        float ss = (v[0] * v[0] + v[1] * v[1]) + (v[2] * v[2] + v[3] * v[3]);
        const float rs = 1.0f / sqrtf(wave_sum(ss) * (1.0f / 256.0f) + RMS_EPS);
        const float* g = ckv_g + 4 * lane;
        u32x2_t w; w.x = pk2(v[0] * rs * g[0], v[1] * rs * g[1]); w.y = pk2(v[2] * rs * g[2], v[3] * rs * g[3]);
        *base = w;
    }
}

__device__ __forceinline__ void post_b_row(bf16* __restrict__ qb, const bf16* __restrict__ kvr, const bf16* __restrict__ proj, bf16* __restrict__ kb,
                                           const float* __restrict__ bq_g, const float* __restrict__ bk_g, const float* __restrict__ ropec, const float* __restrict__ ropes, int row, int lane) {
    const int pos = row & (SEQ - 1);
    const float* cs = ropec + pos * 32; const float* sn = ropes + pos * 32;
    const int h = lane >> 3, j = lane & 7;
    const float c0 = cs[4 * j], s0 = sn[4 * j], c1 = cs[4 * j + 2], s1 = sn[4 * j + 2];
#pragma unroll
    for (int which = 0; which < 2; ++which) {
        const bf16* nsrc = which ? (kvr + (size_t)row * 1024 + 128 * h + 8 * j) : (qb + (size_t)row * 768 + 96 * h + 8 * j);
        const bf16* rsrc = which ? (proj + (size_t)row * NP + C_KR + 2 * j) : (qb + (size_t)row * 768 + 96 * h + 64 + 2 * j);
        const float* g = which ? bk_g : bq_g;
        const u32x4_t rn = *(const u32x4_t*)nsrc;
        const unsigned r1 = *(const unsigned*)rsrc, r2 = *(const unsigned*)(rsrc + 16);
        float v[8] = {bflo(rn.x), bfhi(rn.x), bflo(rn.y), bfhi(rn.y), bflo(rn.z), bfhi(rn.z), bflo(rn.w), bfhi(rn.w)};
        const float a0 = bflo(r1), a1 = bfhi(r1), b0 = bflo(r2), b1 = bfhi(r2);
        float ss = (a0 * a0 + a1 * a1) + (b0 * b0 + b1 * b1);
#pragma unroll
        for (int i = 0; i < 8; ++i) ss += v[i] * v[i];
        ss += __shfl_xor(ss, 1); ss += __shfl_xor(ss, 2); ss += __shfl_xor(ss, 4);
        const float rs = 1.0f / sqrtf(ss * (1.0f / 96.0f) + RMS_EPS);
        const float sc = which ? 1.0f : C2B;
        u32x4_t wn;
        { const float* gn = g + 8 * j; const float q = rs * sc;
          wn.x = pk2(v[0] * q * gn[0], v[1] * q * gn[1]); wn.y = pk2(v[2] * q * gn[2], v[3] * q * gn[3]); wn.z = pk2(v[4] * q * gn[4], v[5] * q * gn[5]); wn.w = pk2(v[6] * q * gn[6], v[7] * q * gn[7]); }
        const float A0 = a0 * rs * g[64 + 2 * j], A1 = a1 * rs * g[64 + 2 * j + 1], B0 = b0 * rs * g[80 + 2 * j], B1 = b1 * rs * g[80 + 2 * j + 1];
        const unsigned w1 = pk2((A0 * c0 - B0 * s0) * sc, (A1 * c1 - B1 * s1) * sc), w2 = pk2((B0 * c0 + A0 * s0) * sc, (B1 * c1 + A1 * s1) * sc);
        bf16* dst = which ? (kb + (size_t)row * 768 + 96 * h) : (qb + (size_t)row * 768 + 96 * h);
        *(u32x4_t*)(dst + 8 * j) = wn; *(unsigned*)(dst + 64 + 2 * j) = w1; *(unsigned*)(dst + 80 + 2 * j) = w2;
    }
}

constexpr int IDX_QPITCH = 1040;
constexpr int IDX_LDS = 32 * IDX_QPITCH + 2 * 8 * 32 * 4 + 8 * 32 * 4;
constexpr int TOPK = 256;

__device__ __forceinline__ unsigned sortable_key(float x) { const unsigned u = __builtin_bit_cast(unsigned, x + 0.0f); return (u & 0x80000000u) ? ~u : (u | 0x80000000u); }

__device__ __forceinline__ void indexer_unit(LAS unsigned char* lds, const bf16* __restrict__ proj, unsigned long long* __restrict__ mask, int b, int qb) {
    const int tid = opaque_tid(), lane = tid & 63, w = __builtin_amdgcn_readfirstlane(tid >> 6), r32 = lane & 31, hi = lane >> 5;
    const int L = 64 * ((qb >> 1) + 1), nt32 = L >> 5;
    const int nloc = (nt32 - w + 7) >> 3;
    unsigned long long* mbase = mask + ((size_t)(b * 64 + qb) * 64) * 16;
    if (L <= TOPK) {
        for (int i = 0; i < nloc; ++i) { const int j = w + 8 * i; if (lane < 16) mbase[(size_t)j * 16 + lane] = ~0ull; }
        return;
    }
    const size_t row0 = (size_t)b * SEQ + 32 * qb;
    __syncthreads();
    for (int c = tid; c < 32 * 64; c += 512) { const int r = c >> 6, ch = c & 63;
        *(LAS u32x4_t*)(lds + r * IDX_QPITCH + ch * 16) = *(const u32x4_t*)(proj + (row0 + r) * NP + C_QI + ch * 8); }
    LAS float* wl = (LAS float*)(lds + 32 * IDX_QPITCH + 2048);
    if (tid < 256) { const int q = tid & 31, hh = tid >> 5; wl[hh * 32 + q] = bf2f(proj[(row0 + q) * NP + C_WI + hh]); }
    __syncthreads();
    unsigned key[8][16];
    const LAS unsigned char* qrow = lds + r32 * IDX_QPITCH + hi * 16;
#pragma unroll
    for (int i = 0; i < 8; ++i) {
        if (i < nloc) {
            const int j = w + 8 * i;
            const bf16* kp = proj + ((size_t)b * SEQ + 32 * j + r32) * NP + C_KI + 8 * hi;
            bf16x8_t kf[4];
#pragma unroll
            for (int s = 0; s < 4; ++s) kf[s] = *(const bf16x8_t*)(kp + 16 * s);
            f32x16_t tot;
#pragma unroll
            for (int r = 0; r < 16; ++r) tot[r] = 0.f;
#pragma unroll 1
            for (int h = 0; h < 8; ++h) {
                const float wh = wl[h * 32 + r32];
                f32x16_t acc;
#pragma unroll
                for (int r = 0; r < 16; ++r) acc[r] = 0.f;
#pragma unroll
                for (int s = 0; s < 4; ++s) { const bf16x8_t qf = *(const LAS bf16x8_t*)(qrow + (64 * h + 16 * s) * 2); acc = __builtin_amdgcn_mfma_f32_32x32x16_bf16(kf[s], qf, acc, 0, 0, 0); }
#pragma unroll
                for (int r = 0; r < 16; ++r) tot[r] = fmaf(wh, fmaxf(acc[r], 0.f), tot[r]);
            }
#pragma unroll
            for (int r = 0; r < 16; ++r) key[i][r] = sortable_key(tot[r]);
            __builtin_amdgcn_sched_barrier(0);
        } else {
#pragma unroll
            for (int r = 0; r < 16; ++r) key[i][r] = 0u;
        }
    }
    LAS int* cnts = (LAS int*)(lds + 32 * IDX_QPITCH);
    int step = 0;
#define IDX_REDUCE(cntvar, totvar) do { int c_ = (cntvar); c_ += __shfl_xor(c_, 32); const int buf_ = (step & 1) * 256; ++step; \
        if (lane < 32) cnts[buf_ + w * 32 + lane] = c_; __syncthreads(); int t_ = 0; _Pragma("unroll") for (int ww = 0; ww < 8; ++ww) t_ += cnts[buf_ + ww * 32 + r32]; (totvar) = t_; } while (0)
    unsigned T = 0u;
    for (int bit = 31; bit >= 0; --bit) {
        const unsigned cand = T | (1u << bit);
        int cnt = 0;
#pragma unroll
        for (int i = 0; i < 8; ++i) if (i < nloc) {
#pragma unroll
            for (int r = 0; r < 16; ++r) cnt += (key[i][r] >= cand) ? 1 : 0; }
        int tot; IDX_REDUCE(cnt, tot);
        if (tot >= TOPK) T = cand;
    }
    int cgt = 0, ceq = 0;
#pragma unroll
    for (int i = 0; i < 8; ++i) if (i < nloc) {
#pragma unroll
        for (int r = 0; r < 16; ++r) { cgt += (key[i][r] > T) ? 1 : 0; ceq += (key[i][r] == T) ? 1 : 0; } }
    int tgt, teq; IDX_REDUCE(cgt, tgt); IDX_REDUCE(ceq, teq);
    const int need = TOPK - tgt;
    int X = 1 << 20;
    if (__any(teq > need)) {
        X = 0;
        for (int bit = 10; bit >= 0; --bit) {
            const int cand = X | (1 << bit);
            int cnt = 0;
#pragma unroll
            for (int i = 0; i < 8; ++i) if (i < nloc) {
                const int ti = cand - 32 * (w + 8 * i) - 4 * hi;
#pragma unroll
                for (int r = 0; r < 16; ++r) cnt += (key[i][r] == T && ((r & 3) + 8 * (r >> 2)) < ti) ? 1 : 0; }
            int tot; IDX_REDUCE(cnt, tot);
            if (tot < need) X = cand;
        }
    }
#undef IDX_REDUCE
#pragma unroll
    for (int i = 0; i < 8; ++i) if (i < nloc) {
        const int j = w + 8 * i;
        const int xi = X - 32 * j - 4 * hi;
        unsigned long long mine = 0ull;
#pragma unroll
        for (int r = 0; r < 16; ++r) {
            const bool sel = (key[i][r] > T) || (key[i][r] == T && ((r & 3) + 8 * (r >> 2)) <= xi);
            const unsigned long long bal = __ballot(sel);
            if (lane == r) mine = bal; }
        if (lane < 16) mbase[(size_t)j * 16 + lane] = mine;
    }
}

struct AttnArgs { const bf16* Q; const bf16* K; const bf16* V; const bf16* G; bf16* O; const unsigned long long* mask; int qpitch, qhs, kpitch, khs, vpitch, vhs, gpitch, ocol; };

template <int DQK> struct AttnCfg { static constexpr int KP = (DQK + 8) * 2, VP = 192, K_OFF = 0, V_OFF = 64 * KP, WS_OFF = V_OFF + 64 * VP, LDS = WS_OFF + 8 * 64 * 4; };

template <int DQK, bool MASKED>
__device__ __forceinline__ void attn_unit8(LAS unsigned char* lds, const AttnArgs& a, int b, int h, int q0) {
    typedef AttnCfg<DQK> C;
    const int tid = opaque_tid(), lane = tid & 63, w = __builtin_amdgcn_readfirstlane(tid >> 6), r32 = lane & 31, hi = lane >> 5;
    const size_t rowb = (size_t)b * SEQ;
    const int qw = q0 + 32 * w, ntw = (qw >> 6) + 1, nt = (q0 >> 6) + 4;
    constexpr int NS = DQK / 16;
    bf16x8_t qf[NS];
    { const bf16* qp = a.Q + (rowb + qw + r32) * a.qpitch + h * a.qhs + 8 * hi;
#pragma unroll
      for (int s = 0; s < NS; ++s) qf[s] = *(const bf16x8_t*)(qp + 16 * s); }
    f32x16_t o0, o1;
#pragma unroll
    for (int r = 0; r < 16; ++r) { o0[r] = 0.f; o1[r] = 0.f; }
    float m = -INFINITY, l = 0.f;
    LAS float* wsf = (LAS float*)(lds + C::WS_OFF) + w * 64;
    const bf16* Kh = a.K + rowb * a.kpitch + h * a.khs; const bf16* Vh = a.V + rowb * a.vpitch + h * a.vhs;
    const unsigned long long* mrow = MASKED ? a.mask + ((size_t)(b * 64 + (qw >> 5)) * 64) * 16 : nullptr;
    const LAS unsigned char* kfrag = lds + C::K_OFF + r32 * C::KP + hi * 16;
    const LAS unsigned char* vfrag = lds + C::V_OFF + (4 * hi + ((lane & 15) >> 2)) * C::VP + (16 * ((lane >> 4) & 1) + 4 * (lane & 3)) * 2;
    for (int t = 0; t < nt; ++t) {
        __syncthreads();
        constexpr int KCH = DQK / 8;
        for (int c = tid; c < 64 * KCH; c += 512) { const int r = c / KCH, ch = c % KCH;
            *(LAS u32x4_t*)(lds + C::K_OFF + r * C::KP + ch * 16) = *(const u32x4_t*)(Kh + (size_t)(64 * t + r) * a.kpitch + ch * 8); }
        for (int c = tid; c < 64 * 8; c += 512) { const int r = c >> 3, ch = c & 7;
            *(LAS u32x4_t*)(lds + C::V_OFF + r * C::VP + ch * 16) = *(const u32x4_t*)(Vh + (size_t)(64 * t + r) * a.vpitch + ch * 8); }
        __syncthreads();
        if (t < ntw) {
            f32x16_t p0, p1;
#pragma unroll
            for (int r = 0; r < 16; ++r) { p0[r] = 0.f; p1[r] = 0.f; }
#pragma unroll
            for (int s = 0; s < NS; ++s) {
                const bf16x8_t k0 = *(const LAS bf16x8_t*)(kfrag + s * 32), k1 = *(const LAS bf16x8_t*)(kfrag + 32 * C::KP + s * 32);
                p0 = __builtin_amdgcn_mfma_f32_32x32x16_bf16(k0, qf[s], p0, 0, 0, 0);
                p1 = __builtin_amdgcn_mfma_f32_32x32x16_bf16(k1, qf[s], p1, 0, 0, 0);
            }
            if (MASKED) {
                const unsigned long long* mw = mrow + (size_t)(2 * t) * 16;
#pragma unroll
                for (int r = 0; r < 16; ++r) { const unsigned long long w0 = mw[r], w1 = mw[16 + r];
                    if (!((w0 >> lane) & 1ull)) p0[r] = -INFINITY;
                    if (!((w1 >> lane) & 1ull)) p1[r] = -INFINITY; }
            }
            float mx = fmaxf(p0[0], p1[0]);
#pragma unroll
            for (int r = 1; r < 16; ++r) mx = fmaxf(mx, fmaxf(p0[r], p1[r]));
            mx = fmaxf(mx, __shfl_xor(mx, 32));
            const float mnew = fmaxf(m, mx), muse = (mnew == -INFINITY) ? 0.f : mnew;
            const float alpha = __builtin_amdgcn_exp2f(m - muse);
            float rs = 0.f;
#pragma unroll
            for (int r = 0; r < 16; ++r) { p0[r] = __builtin_amdgcn_exp2f(p0[r] - muse); p1[r] = __builtin_amdgcn_exp2f(p1[r] - muse); rs += p0[r] + p1[r]; }
            rs += __shfl_xor(rs, 32);
            l = l * alpha + rs; m = mnew;
            if (hi == 0) wsf[r32] = alpha;
            asm volatile("s_waitcnt lgkmcnt(0)" ::: "memory");
#pragma unroll
            for (int r = 0; r < 16; ++r) { const float f = wsf[crow(r, hi)]; o0[r] *= f; o1[r] *= f; }
            bf16x8_t pa[4];
#pragma unroll
            for (int k = 0; k < 4; ++k) { u32x4_t pw;
#pragma unroll
                for (int i = 0; i < 4; ++i) { const float lo = (k < 2) ? p0[8 * (k & 1) + 2 * i] : p1[8 * (k & 1) + 2 * i], hh = (k < 2) ? p0[8 * (k & 1) + 2 * i + 1] : p1[8 * (k & 1) + 2 * i + 1]; pw[i] = pk2(lo, hh); }
                pa[k] = __builtin_bit_cast(bf16x8_t, pw); }
#pragma unroll
            for (int k = 0; k < 4; ++k) {
#pragma unroll
                for (int db = 0; db < 2; ++db) {
                    const LAS unsigned char* vp = vfrag + (16 * k) * C::VP + db * 64;
                    const s16x4_t lo = __builtin_bit_cast(s16x4_t, __builtin_amdgcn_ds_read_tr16_b64_v4i16((LAS s16x4_t*)vp));
                    const s16x4_t hh = __builtin_bit_cast(s16x4_t, __builtin_amdgcn_ds_read_tr16_b64_v4i16((LAS s16x4_t*)(vp + 8 * C::VP)));
                    const bf16x8_t vb = (bf16x8_t){lo[0], lo[1], lo[2], lo[3], hh[0], hh[1], hh[2], hh[3]};
                    if (db == 0) o0 = __builtin_amdgcn_mfma_f32_32x32x16_bf16(pa[k], vb, o0, 0, 0, 0);
                    else o1 = __builtin_amdgcn_mfma_f32_32x32x16_bf16(pa[k], vb, o1, 0, 0, 0);
                }
            }
        }
    }
    asm volatile("s_waitcnt lgkmcnt(0)" ::: "memory");
    if (hi == 0) wsf[32 + r32] = l;
    asm volatile("s_waitcnt lgkmcnt(0)" ::: "memory");
#pragma unroll
    for (int r = 0; r < 16; ++r) {
        const int row = qw + crow(r, hi);
        const float inv = 1.0f / wsf[32 + crow(r, hi)];
        const bf16* gp = a.G + (rowb + row) * a.gpitch + 64 * h;
        bf16* op = a.O + (rowb + row) * 1024 + a.ocol + 64 * h;
        const float g0 = bf2f(gp[r32]), g1 = bf2f(gp[32 + r32]);
        const float s0 = g0 / (1.0f + __expf(-g0)), s1 = g1 / (1.0f + __expf(-g1));
        op[r32] = (bf16)f2bf(o0[r] * inv * s0); op[32 + r32] = (bf16)f2bf(o1[r] * inv * s1);
    }
}
#define XB_TMO      128
#define XB_XCNT(j)  (256  + 64 * (j))
#define XB_XSUB(j)  (1280 + 64 * (j))
#define XB_XGEN(j)  (2304 + 64 * (j))
#define XB_TOP      3328
#define XB_TOPGEN   3392
#define XCD_BAR_WORDS 3456
#define XB_SPIN_CAP (1u << 18)

__device__ __forceinline__ unsigned xb_ld(unsigned* p)              { return __hip_atomic_load(p, __ATOMIC_RELAXED, __HIP_MEMORY_SCOPE_AGENT); }
__device__ __forceinline__ unsigned xb_add(unsigned* p, unsigned v) { return __hip_atomic_fetch_add(p, v, __ATOMIC_RELAXED, __HIP_MEMORY_SCOPE_AGENT); }
__device__ __forceinline__ unsigned xb_xcc_id() { return (unsigned)__builtin_amdgcn_s_getreg((3 << 11) | 20) & 0xFu; }
#define XB_SPIN(cond, bar) do { unsigned _sp = 0; while (cond) { __builtin_amdgcn_s_sleep(1); \
    if ((++_sp & 255u) == 0u) { if (xb_ld(&(bar)[XB_TMO])) break; if (_sp > XB_SPIN_CAP) { atomicAdd(&(bar)[XB_TMO], 1u); break; } } } } while (0)

struct XcdBarrier {
    unsigned* bar; unsigned x;
    volatile LAS unsigned* st;
};

__device__ __forceinline__ XcdBarrier xcd_barrier_post(unsigned* bar, volatile LAS unsigned* st) {
    XcdBarrier b; b.bar = bar; b.x = xb_xcc_id(); b.st = st;
    if (threadIdx.x == 0) (void)xb_add(&bar[XB_XCNT(b.x)], 1u);
    return b;
}
__device__ __forceinline__ void xcd_barrier_complete(unsigned* bar, unsigned x, unsigned& nloc, unsigned& nx) {
    const unsigned G = gridDim.x * gridDim.y * gridDim.z;
    unsigned sum, cnt, mine, sp = 0u;
    for (;;) {
        sum = 0u; cnt = 0u; mine = 0u;
#pragma unroll
        for (unsigned j = 0; j < 16; ++j) { const unsigned c = xb_ld(&bar[XB_XCNT(j)]); sum += c; cnt += (c > 0u) ? 1u : 0u; mine = (j == x) ? c : mine; }
        if (sum == G) break;
        __builtin_amdgcn_s_sleep(1);
        if ((++sp & 255u) == 0u) { if (xb_ld(&bar[XB_TMO])) break; if (sp > XB_SPIN_CAP) { atomicAdd(&bar[XB_TMO], 1u); break; } }
    }
    nloc = mine > 0u ? mine : 1u; nx = cnt > 0u ? cnt : 1u;
}

__device__ __forceinline__ void xcd_barrier(const XcdBarrier& b) {
    asm volatile("s_waitcnt vmcnt(0)" ::: "memory");
    __syncthreads();
    if (threadIdx.x == 0) {
        unsigned* bar = b.bar;
        __builtin_amdgcn_s_waitcnt(0);
        unsigned nloc = b.st[0], nx = b.st[1];
        if (nloc == 0u) { xcd_barrier_complete(bar, b.x, nloc, nx); b.st[0] = nloc; b.st[1] = nx; }
        const unsigned old = xb_add(&bar[XB_XSUB(b.x)], 1u);
        const unsigned gen = old / nloc;
        if (old + 1u == (gen + 1u) * nloc) {
            __builtin_amdgcn_fence(__ATOMIC_RELEASE, "agent");
            asm volatile("s_waitcnt vmcnt(0)" ::: "memory");
            const unsigned og = xb_add(&bar[XB_TOP], 1u);
            const unsigned tg = og / nx;
            if (og + 1u == (tg + 1u) * nx) xb_add(&bar[XB_TOPGEN], 1u);
            else XB_SPIN(xb_ld(&bar[XB_TOPGEN]) == tg, bar);
            __builtin_amdgcn_fence(__ATOMIC_ACQUIRE, "agent");
            xb_add(&bar[XB_XGEN(b.x)], 1u);
            asm volatile("s_waitcnt vmcnt(0)" ::: "memory");
        } else {
            XB_SPIN(xb_ld(&bar[XB_XGEN(b.x)]) == gen, bar);
            __builtin_amdgcn_fence(__ATOMIC_ACQUIRE, "agent");
            asm volatile("s_waitcnt vmcnt(0)" ::: "memory");
        }
    }
    __syncthreads();
}

constexpr int NWAVES = 8;
constexpr int RING_BYTES = 131072;
constexpr int LDSCTL_OFF = RING_BYTES, MISC_OFF = LDSCTL_OFF + 320;
constexpr int LDS_BYTES = 147456;
constexpr int CW_BAR = 4096;
constexpr size_t CTL_ZERO_BYTES = 64 * 1024;
static_assert((CW_BAR + XCD_BAR_WORDS) * 4 <= (int)CTL_ZERO_BYTES, "barrier words inside the memset region");

struct MegaArgs { const float* in[12]; float* out; unsigned char* ws; };

__global__ void __launch_bounds__(NWAVES * 64, 2) mega_fwd(MegaArgs args) {
    extern __shared__ __attribute__((aligned(16))) unsigned char lds_raw[];
    LAS unsigned char* lds = (LAS unsigned char*)lds_raw;
    int tid = opaque_tid(), lane = tid & 63; const int wave = __builtin_amdgcn_readfirstlane(tid >> 6);
    const int G = gridDim.x, bx = blockIdx.x, vcu = (G % 8 == 0) ? (bx % 8) * (G / 8) + bx / 8 : bx;
    unsigned char* ws = args.ws;
    const float* x = args.in[0]; const float* norm_gain = args.in[1]; const float* w_in = args.in[2];
    const float* a_q_norm = args.in[3]; const float* a_k_norm = args.in[4]; const float* b_q_lat = args.in[5]; const float* b_kv_lat = args.in[6];
    const float* w_uq = args.in[7]; const float* w_ukv = args.in[8]; const float* b_q_norm = args.in[9]; const float* b_k_norm = args.in[10];
    const float* w_out = args.in[11];
    bf16* WIN = (bf16*)(ws + WS_WIN); bf16* WUQ = (bf16*)(ws + WS_WUQ); bf16* WUKV = (bf16*)(ws + WS_WUKV); bf16* WOUT = (bf16*)(ws + WS_WOUT);
    float* RC = (float*)(ws + WS_ROPE); float* RS = RC + SEQ * 32;
    bf16* XN = (bf16*)(ws + WS_XN); bf16* MIXED = (bf16*)(ws + WS_MIXED); bf16* PROJ = (bf16*)(ws + WS_PROJ);
    bf16* QB = (bf16*)(ws + WS_QB); bf16* KVR = (bf16*)(ws + WS_KVR); bf16* KB = (bf16*)(ws + WS_KB);
    unsigned long long* MASK = (unsigned long long*)(ws + WS_MASK);

    for (int u = tid; u < (LDS_BYTES - LDSCTL_OFF) / 4; u += NWAVES * 64) ((LAS unsigned*)(lds + LDSCTL_OFF))[u] = 0u;
    __syncthreads();
    XcdBarrier bar = xcd_barrier_post((unsigned*)(ws + WS_CTL) + CW_BAR, (volatile LAS unsigned*)(lds + MISC_OFF) + 8);

    const int gw = vcu * NWAVES + wave, NGW = G * NWAVES;

    for (int i = vcu * 512 + tid; i < SEQ * 32; i += G * 512) rope_table_elem(RC, RS, i);
    {
        constexpr int T_IN = (NP / 64) * 16, T_UQ = 12 * 6, T_UKV = 16 * 4, T_OUT = 16 * 16;
        LAS float* tile = (LAS float*)lds;
        for (int it = vcu; it < T_IN + T_UQ + T_UKV + T_OUT; it += G) {
            int r = it;
            if (r < T_IN) { wtrans_tile(tile, w_in, 1024, D_IN_OLD, WIN, (r % (NP / 64)) * 64, (r / (NP / 64)) * 64, true, tid); continue; } r -= T_IN;
            if (r < T_UQ) { wtrans_tile(tile, w_uq, 384, 768, WUQ, (r % 12) * 64, (r / 12) * 64, false, tid); continue; } r -= T_UQ;
            if (r < T_UKV) { wtrans_tile(tile, w_ukv, 256, 1024, WUKV, (r % 16) * 64, (r / 16) * 64, false, tid); continue; } r -= T_UKV;
            wtrans_tile(tile, w_out, 1024, 1024, WOUT, (r % 16) * 64, (r / 16) * 64, false, tid);
        }
    }
    for (int m = gw; m < MTOK; m += NGW) rmsnorm_x_row(x, norm_gain, XN, m, lane);
    xcd_barrier(bar);

    {
        pg8::Gemm g{XN, WIN, MTOK, NP, 1024, 1024}; pg8::StaticOrder S; S.init(MTOK, NP, G, bx);
        pg8::EpiBf16<0> E{PROJ, NP, nullptr, 0, 0, 1.f};
        pg8::gemm_phase<pg8::EpiBf16<0>, pg8::StaticOrder, true, true>(lds, g, S, E);
    }
    xcd_barrier(bar);

    tid = opaque_tid(); lane = tid & 63;
    for (int m = gw; m < MTOK; m += NGW) post_a_row(PROJ, a_q_norm, a_k_norm, b_q_lat, b_kv_lat, RC, RS, m, lane);
    xcd_barrier(bar);

    {
        pg8::Gemm g{PROJ + C_CQ, WUQ, MTOK, 768, 384, NP}; pg8::StaticOrder S; S.init(MTOK, 768, G, bx);
        pg8::EpiBf16<0> E{QB, 768, nullptr, 0, 0, 1.f};
        pg8::gemm_phase<pg8::EpiBf16<0>, pg8::StaticOrder, true, true>(lds, g, S, E);
    }
    {
        pg8::Gemm g{PROJ + C_CKV, WUKV, MTOK, 1024, 256, NP}; pg8::StaticOrder S; S.init(MTOK, 1024, G, bx);
        pg8::EpiBf16<0> E{KVR, 1024, nullptr, 0, 0, 1.f};
        pg8::gemm_phase<pg8::EpiBf16<0>, pg8::StaticOrder, true, true>(lds, g, S, E);
    }
    for (int p = vcu; p < 512; p += G) {
        const int b = p & 15, qq = p >> 4;
        indexer_unit(lds, PROJ, MASK, b, 63 - qq);
        indexer_unit(lds, PROJ, MASK, b, qq);
    }
    xcd_barrier(bar);

    tid = opaque_tid(); lane = tid & 63;
    for (int m = gw; m < MTOK; m += NGW) post_b_row(QB, KVR, PROJ, KB, b_q_norm, b_k_norm, RC, RS, m, lane);
    xcd_barrier(bar);

    {
        const AttnArgs aA{PROJ + C_QA, PROJ + C_KA, PROJ + C_VA, PROJ + C_GA, MIXED, MASK, NP, 64, NP, 64, NP, 64, NP, 0};
        const AttnArgs aB{QB, KB, KVR + 64, PROJ + C_GB, MIXED, nullptr, 768, 96, 768, 96, 1024, 128, NP, 512};
        for (int p = vcu; p < 512; p += G) {
            const int s = p & 3, h = (p >> 2) & 7, b = p >> 5;
            attn_unit8<64, true>(lds, aA, b, h, 256 * (7 - s));
            attn_unit8<64, true>(lds, aA, b, h, 256 * s);
            attn_unit8<96, false>(lds, aB, b, h, 256 * (7 - s));
            attn_unit8<96, false>(lds, aB, b, h, 256 * s);
        }
    }
    xcd_barrier(bar);

    {
        pg8::Gemm g{MIXED, WOUT, MTOK, 1024, 1024, 1024}; pg8::StaticOrder S; S.init(MTOK, 1024, G, bx);
        pg8::EpiResF32 E{x, args.out, 1024};
        pg8::gemm_phase<pg8::EpiResF32, pg8::StaticOrder, true, true>(lds, g, S, E);
    }
}

extern "C" void kernel_launch(void* const* d_in, const int* in_sizes, int n_in, void* d_out, int out_size, void* d_ws, size_t ws_size, hipStream_t stream) {
    static int grid = 0;
    if (grid == 0) {
        if (n_in != 12 || in_sizes[0] != MTOK * DMODEL || out_size != MTOK * DMODEL || ws_size < WS_END) {
            fprintf(stderr, "kernel_launch: unexpected shapes / workspace (n_in %d, in0 %d, out %d, ws %zu)\n", n_in, n_in > 0 ? in_sizes[0] : -1, out_size, ws_size); grid = -1; return; }
        int dev = 0, cus = 0, per_cu = 0;
        if (hipGetDevice(&dev) != hipSuccess || hipDeviceGetAttribute(&cus, hipDeviceAttributeMultiprocessorCount, dev) != hipSuccess) { grid = -1; return; }
        if (hipFuncSetAttribute((const void*)mega_fwd, hipFuncAttributeMaxDynamicSharedMemorySize, LDS_BYTES) != hipSuccess) { fprintf(stderr, "kernel_launch: hipFuncSetAttribute failed\n"); grid = -1; return; }
        if (hipOccupancyMaxActiveBlocksPerMultiprocessor(&per_cu, (const void*)mega_fwd, NWAVES * 64, LDS_BYTES) != hipSuccess || per_cu < 1) {
            fprintf(stderr, "kernel_launch: occupancy query says %d workgroups per CU\n", per_cu); (void)hipGetLastError(); grid = -1; return; }
        grid = cus;
    }
    if (grid < 0) return;
    (void)hipMemsetAsync((char*)d_ws + WS_CTL, 0, CTL_ZERO_BYTES, stream);
    MegaArgs a{};
    for (int i = 0; i < 12; ++i) a.in[i] = (const float*)d_in[i];
    a.out = (float*)d_out; a.ws = (unsigned char*)d_ws;
    hipLaunchKernelGGL(mega_fwd, dim3(grid), dim3(NWAVES * 64), LDS_BYTES, stream, a);
}
```

```cpp
#include <hip/hip_runtime.h>
#include <cstdint>
#include <cstdio>

constexpr int BATCH = 16, SEQ = 2048, DMODEL = 1024, MTOK = BATCH * SEQ;
constexpr int NP = 3840;
constexpr int C_QA = 0, C_KA = 512, C_VA = 1024, C_GA = 1536, C_QI = 2048, C_GB = 2560, C_CQ = 3072, C_CKV = 3456, C_KI = 3712, C_KR = 3776, C_WI = 3808;
constexpr int D_IN_OLD = 3816;
constexpr float RMS_EPS = 1e-6f;
constexpr float LOG2E = 1.4426950408889634f;
constexpr float C2A = 0.125f * LOG2E;
constexpr float C2B = 0.10206207261596575f * LOG2E;

constexpr size_t MiB = 1u << 20;
constexpr size_t WS_CTL = 0;
constexpr size_t WS_WIN = 2 * MiB;
constexpr size_t WS_WUQ = 10 * MiB;
constexpr size_t WS_WUKV = 11 * MiB;
constexpr size_t WS_WOUT = 12 * MiB;
constexpr size_t WS_ROPE = 14 * MiB;
constexpr size_t WS_XN = 16 * MiB;
constexpr size_t WS_MIXED = WS_XN;
constexpr size_t WS_PROJ = 80 * MiB;
constexpr size_t WS_QB = 320 * MiB;
constexpr size_t WS_KVR = 368 * MiB;
constexpr size_t WS_KB = 432 * MiB;
constexpr size_t WS_MASK = 480 * MiB;
constexpr size_t WS_END = 488 * MiB;

typedef unsigned short bf16;
typedef short bf16x8_t __attribute__((ext_vector_type(8)));
typedef short s16x4_t __attribute__((ext_vector_type(4)));
typedef float f32x16_t __attribute__((ext_vector_type(16)));
typedef float f32x4_t __attribute__((ext_vector_type(4)));
typedef unsigned u32x4_t __attribute__((ext_vector_type(4)));
typedef unsigned u32x2_t __attribute__((ext_vector_type(2)));
#define LAS __attribute__((address_space(3)))

__device__ __forceinline__ unsigned f2bf(float f) { unsigned u = __builtin_bit_cast(unsigned, f); return (u + 0x7fffu + ((u >> 16) & 1u)) >> 16; }
__device__ __forceinline__ unsigned pk2(float lo, float hi) { return f2bf(lo) | (f2bf(hi) << 16); }
__device__ __forceinline__ float bflo(unsigned u) { return __builtin_bit_cast(float, u << 16); }
__device__ __forceinline__ float bfhi(unsigned u) { return __builtin_bit_cast(float, u & 0xffff0000u); }
__device__ __forceinline__ float bf2f(bf16 b) { return __builtin_bit_cast(float, (unsigned)b << 16); }
__device__ __forceinline__ int crow(int r, int hi) { return (r & 3) + 8 * (r >> 2) + 4 * hi; }

__device__ __forceinline__ int opaque_tid() { int t = (int)threadIdx.x; asm volatile("" : "+v"(t)); return t; }

namespace pg8 {
#define PG8_LAS __attribute__((address_space(3)))
typedef unsigned short bf16_t;
typedef short bf16x8 __attribute__((ext_vector_type(8)));
typedef float f32x4 __attribute__((ext_vector_type(4)));
typedef unsigned u32x4 __attribute__((ext_vector_type(4)));
constexpr int BM = 256, BK = 64, HALF = 128, HTB = HALF * BK * 2  , STAGE_BYTES = 8 * HTB, NXCD = 8, WGM = 8;

__host__ __device__ __forceinline__ int lds_byte(int r, int c) { const int st = (r >> 4) * 2 + (c >> 5), rr = r & 15, cc = c & 31, ob = rr * 64 + cc * 2; return st * 1024 + (ob ^ (((ob >> 9) & 1) << 5)); }
__host__ __device__ __forceinline__ void stage_rc(int b, int& R, int& C) { const int st = b / 1024, sb = b % 1024, swz = sb ^ (((sb >> 9) & 1) << 5); R = (st >> 1) * 16 + swz / 64; C = (st & 1) * 32 + (swz % 64) / 2; }
__host__ __device__ __forceinline__ int perm32(int rho) { const int n = rho >> 4, i = rho & 15; return 8 * (i >> 2) + 4 * n + (i & 3); }

struct Unit { int pm, pn; };
struct Gemm { const bf16_t* A; const bf16_t* Bt; int M, N, K, lda; };

struct StaticOrder {
    int nM, nN, nwg, G, c;
    __host__ __device__ void init(int M, int N, int G_, int c_) { nM = M / BM; nN = N / BM; nwg = nM * nN; G = G_; c = c_; }
    __host__ __device__ bool next(int i, Unit& u) const {
        const long L = (long)i * G + c; if (L >= nwg) return false;
        int wgid = (int)L; { const int q = nwg / NXCD, r = nwg % NXCD, xcd = wgid % NXCD, off = wgid / NXCD; wgid = (xcd < r ? xcd * (q + 1) : r * (q + 1) + (xcd - r) * q) + off; }
        const int nig = WGM * nN, gid = wgid / nig, fm = gid * WGM, gsz = (nM - fm) < WGM ? (nM - fm) : WGM;
        u.pm = fm + ((wgid % nig) % gsz); u.pn = (wgid % nig) / gsz; return true;
    }
    __device__ __forceinline__ void a_ready(const Unit&) const {}
    __device__ __forceinline__ void done(const Unit&) const {}
};

__device__ __forceinline__ unsigned cvt_pk_bf16(float lo, float hi) { unsigned r; asm volatile("v_cvt_pk_bf16_f32 %0, %1, %2" : "=v"(r) : "v"(lo), "v"(hi)); return r; }
typedef float f32x2 __attribute__((ext_vector_type(2)));
__device__ __forceinline__ f32x2 gelu_pk(f32x2 v) {
    const f32x2 av = __builtin_elementwise_abs(v), d = av * 0.2316418882f + 1.0f;
    f32x2 t; t.x = __builtin_amdgcn_rcpf(d.x); t.y = __builtin_amdgcn_rcpf(d.y);
    f32x2 q = t * 0.5307027145f + (-0.7265760135f); q = q * t + 0.7107068705f; q = q * t + (-0.142248368f); q = q * t + 0.127414796f; q = q * t;
    const f32x2 s = (v * v) * (-0.72134752044f);
    f32x2 e; e.x = __builtin_amdgcn_exp2f(s.x); e.y = __builtin_amdgcn_exp2f(s.y);
    const f32x2 m = v * (q * e), r = v - m;
    f32x2 o; o.x = v.x < 0.f ? m.x : r.x; o.y = v.y < 0.f ? m.y : r.y; return o;
}

template <int ACT  > struct EpiBf16 {
    static constexpr bool PERM = true, AFTER_DRAIN = false; static_assert(ACT == 0 || ACT == 1, "EpiBf16: ACT is 0 (none) or 1 (gelu_pk)");
    bf16_t* O; int ldc; const float* bias; int split_cols; size_t split_stride; float scale0;
    __device__ __forceinline__ void operator()(const f32x4 (&acc)[2][2][4][2], const Unit& u, int wr, int wc, int fr, int fq) const {
        const int row0 = u.pm * BM + wr * 64 + fr; int colt = u.pn * BM; bf16_t* base = O;
        float sc = 1.f; if (split_cols) { const int t = colt / split_cols; base += (size_t)t * split_stride; colt -= t * split_cols; if (t == 0) sc = scale0; }
        const int col0 = colt + wc * 32 + 8 * fq, bcol0 = u.pn * BM + wc * 32 + 8 * fq;
        f32x4 bv[2][2];
#pragma unroll
        for (int bj = 0; bj < 2; ++bj)
#pragma unroll
            for (int n = 0; n < 2; ++n) bv[bj][n] = bias ? *(const f32x4*)(bias + bcol0 + bj * HALF + 4 * n) : (f32x4){0.f, 0.f, 0.f, 0.f};
#pragma unroll
        for (int ai = 0; ai < 2; ++ai)
#pragma unroll
            for (int m = 0; m < 4; ++m) { bf16_t* rowp = base + (size_t)(row0 + ai * HALF + m * 16) * ldc + col0;
#pragma unroll
                for (int bj = 0; bj < 2; ++bj) { f32x4 v0 = acc[ai][bj][m][0] + bv[bj][0], v1 = acc[ai][bj][m][1] + bv[bj][1];
                    if (ACT == 1) { f32x2 a = gelu_pk((f32x2){v0[0], v0[1]}), b = gelu_pk((f32x2){v0[2], v0[3]}), c = gelu_pk((f32x2){v1[0], v1[1]}), d = gelu_pk((f32x2){v1[2], v1[3]});
                        v0 = (f32x4){a.x, a.y, b.x, b.y}; v1 = (f32x4){c.x, c.y, d.x, d.y}; }
                    v0 = v0 * sc; v1 = v1 * sc; u32x4 w; w.x = cvt_pk_bf16(v0[0], v0[1]); w.y = cvt_pk_bf16(v0[2], v0[3]); w.z = cvt_pk_bf16(v1[0], v1[1]); w.w = cvt_pk_bf16(v1[2], v1[3]);
                    *(u32x4*)(rowp + bj * HALF) = w; } }
    }
};
template <class Epi, class Sched, bool ALIGN_EPI = false, bool SP2 = false>
__device__ __forceinline__ void gemm_phase(PG8_LAS unsigned char* lds, const Gemm g, const Sched& S, const Epi& E) {
    const int tid = opaque_tid(), wid = __builtin_amdgcn_readfirstlane(tid >> 6), lane = tid & 63, wr = wid >> 2, wc = wid & 3, fr = lane & 15, fq = lane >> 4;
    const int K = g.K, nt = K / BK, lda = g.lda;
    unsigned voffA[2], voffB[2];
#pragma unroll
    for (int i = 0; i < 2; ++i) { int R, C; stage_rc(tid * 16 + i * 8192, R, C); const int Rb = Epi::PERM ? ((R & ~31) + perm32(R & 31)) : R;
        voffA[i] = (unsigned)(R * lda + C) * 2u; voffB[i] = (unsigned)(Rb * K + C) * 2u; }
    const size_t kstep = (size_t)(BK * 2);
    const size_t hstepA = (size_t)HALF * lda * 2, hstepB = (size_t)HALF * K * 2;
    const size_t tstepA = 2 * hstepA, tstepB = 2 * hstepB;
    const unsigned ldsw = (unsigned)wid * 1024u;
    const int aoff = lds_byte(wr * 64 + fr, fq * 8), boff = lds_byte(wc * 32 + fr, fq * 8);
#define PG8_SA(b, h) (((b) * 2 + (h)) * HTB)
#define PG8_SB(b, h) ((4 + (b) * 2 + (h)) * HTB)
#define PG8_STAGE(bufoff, gbase, voff) do { _Pragma("unroll") for (int _i = 0; _i < 2; ++_i) \
        __builtin_amdgcn_global_load_lds((const unsigned*)((const char*)(gbase) + (voff)[_i]), (PG8_LAS unsigned*)(lds + (bufoff) + ldsw + _i * 8192), 16, 0, 0); } while (0)
#define PG8_LDA(dst, b, h) do { _Pragma("unroll") for (int m = 0; m < 4; ++m) _Pragma("unroll") for (int k = 0; k < 2; ++k) dst[m][k] = *(const PG8_LAS bf16x8*)(lds + PG8_SA(b, h) + aoff + m * 2048 + k * 1024); } while (0)
#define PG8_LDB(dst, b, h) do { _Pragma("unroll") for (int n = 0; n < 2; ++n) _Pragma("unroll") for (int k = 0; k < 2; ++k) dst[n][k] = *(const PG8_LAS bf16x8*)(lds + PG8_SB(b, h) + boff + n * 2048 + k * 1024); } while (0)
#define PG8_MMA(ai, bj, At, Bt) do { __builtin_amdgcn_s_setprio(1); _Pragma("unroll") for (int m = 0; m < 4; ++m) _Pragma("unroll") for (int n = 0; n < 2; ++n) _Pragma("unroll") for (int k = 0; k < 2; ++k) \
        acc[ai][bj][m][n] = __builtin_amdgcn_mfma_f32_16x16x32_bf16(Bt[n][k], At[m][k], acc[ai][bj][m][n], 0, 0, 0); __builtin_amdgcn_s_setprio(0); } while (0)
#define PG8_WAIT_V(n) asm volatile("s_waitcnt vmcnt(" #n ")" ::: "memory")
#define PG8_WAIT_L(n) asm volatile("s_waitcnt lgkmcnt(" #n ")" ::: "memory")
#define PG8_BAR __builtin_amdgcn_s_barrier()
#define PG8_SCHED __builtin_amdgcn_sched_barrier(0)
    Unit cur, nxt; int ui = 0;
    if (!S.next(0, cur)) return;
    f32x4 acc[2][2][4][2];
#pragma unroll
    for (int a = 0; a < 2; ++a)
#pragma unroll
        for (int b = 0; b < 2; ++b)
#pragma unroll
            for (int m = 0; m < 4; ++m)
#pragma unroll
                for (int n = 0; n < 2; ++n) acc[a][b][m][n] = (f32x4){0.f, 0.f, 0.f, 0.f};
    bf16x8 At[4][2], B0[2][2], B1[2][2];
    const char* cA = (const char*)g.A + (size_t)cur.pm * tstepA; const char* cB = (const char*)g.Bt + (size_t)cur.pn * tstepB;
    S.a_ready(cur);
    if constexpr (SP2) {
        PG8_STAGE(PG8_SB(0, 0), cB, voffB); PG8_STAGE(PG8_SB(0, 1), cB + hstepB, voffB); PG8_STAGE(PG8_SA(0, 0), cA, voffA); PG8_STAGE(PG8_SA(0, 1), cA + hstepA, voffA);
        if (wr == 1) PG8_BAR;
        PG8_WAIT_V(2); PG8_BAR;
        PG8_STAGE(PG8_SB(1, 0), cB + kstep, voffB); PG8_STAGE(PG8_SA(1, 0), cA + kstep, voffA); PG8_STAGE(PG8_SB(1, 1), cB + hstepB + kstep, voffB);
        PG8_WAIT_V(6); PG8_BAR;
    } else {
        PG8_STAGE(PG8_SB(0, 0), cB, voffB); PG8_STAGE(PG8_SA(0, 0), cA, voffA); PG8_STAGE(PG8_SB(0, 1), cB + hstepB, voffB); PG8_STAGE(PG8_SA(0, 1), cA + hstepA, voffA);
        if (wr == 1) PG8_BAR;
        PG8_WAIT_V(4); PG8_BAR;
        PG8_STAGE(PG8_SB(1, 0), cB + kstep, voffB); PG8_STAGE(PG8_SA(1, 0), cA + kstep, voffA); PG8_STAGE(PG8_SB(1, 1), cB + hstepB + kstep, voffB);
        PG8_WAIT_V(6); PG8_BAR;
    }
    for (;;) {
        const bool has_next = S.next(ui + 1, nxt);
        const char* nA = has_next ? (const char*)g.A + (size_t)nxt.pm * tstepA : cA; const char* nB = has_next ? (const char*)g.Bt + (size_t)nxt.pn * tstepB : cB;
        for (int t = 0; t < nt; t += 2) {
            const bool last = (t == nt - 2);
            const char* a1 = cA + (size_t)(t + 1) * kstep;
            const char* a2 = last ? nA : cA + (size_t)(t + 2) * kstep; const char* b2 = last ? nB : cB + (size_t)(t + 2) * kstep;
            const char* a3 = a2 + kstep; const char* b3 = b2 + kstep;
            if (last && has_next) S.a_ready(nxt);
            if constexpr (SP2) {
            PG8_LDB(B0, 0, 0); PG8_LDB(B1, 0, 1); PG8_SCHED; PG8_LDA(At, 0, 0); PG8_STAGE(PG8_SA(1, 1), a1 + hstepA, voffA);
            PG8_WAIT_V(8); PG8_WAIT_L(0); PG8_BAR; PG8_MMA(0, 0, At, B0); PG8_MMA(0, 1, At, B1); PG8_BAR; PG8_SCHED;
            PG8_LDA(At, 0, 1); PG8_STAGE(PG8_SB(0, 0), b2, voffB); PG8_STAGE(PG8_SB(0, 1), b2 + hstepB, voffB); PG8_STAGE(PG8_SA(0, 0), a2, voffA);
            PG8_WAIT_V(8); PG8_WAIT_L(0); PG8_BAR; PG8_MMA(1, 0, At, B0); PG8_MMA(1, 1, At, B1); PG8_BAR; PG8_SCHED;
            PG8_LDB(B0, 1, 0); PG8_LDB(B1, 1, 1); PG8_SCHED; PG8_LDA(At, 1, 0); PG8_STAGE(PG8_SA(0, 1), a2 + hstepA, voffA);
            PG8_WAIT_V(8); PG8_WAIT_L(0); PG8_BAR; PG8_MMA(0, 0, At, B0); PG8_MMA(0, 1, At, B1); PG8_BAR; PG8_SCHED;
            PG8_LDA(At, 1, 1); PG8_STAGE(PG8_SB(1, 0), b3, voffB); PG8_STAGE(PG8_SB(1, 1), b3 + hstepB, voffB); PG8_STAGE(PG8_SA(1, 0), a3, voffA);
            PG8_WAIT_V(8); PG8_WAIT_L(0); PG8_BAR; PG8_MMA(1, 0, At, B0); PG8_MMA(1, 1, At, B1); PG8_BAR; PG8_SCHED;
            } else {
            PG8_LDB(B0, 0, 0); PG8_SCHED; PG8_LDA(At, 0, 0); PG8_STAGE(PG8_SA(1, 1), a1 + hstepA, voffA);
            PG8_WAIT_L(8); PG8_BAR; PG8_WAIT_L(0); PG8_MMA(0, 0, At, B0); PG8_BAR; PG8_SCHED;
            PG8_LDB(B1, 0, 1); PG8_STAGE(PG8_SB(0, 0), b2, voffB);
            PG8_BAR; PG8_WAIT_L(0); PG8_MMA(0, 1, At, B1); PG8_BAR;
            PG8_LDA(At, 0, 1); PG8_STAGE(PG8_SA(0, 0), a2, voffA);
            PG8_BAR; PG8_WAIT_L(0); PG8_MMA(1, 0, At, B0); PG8_BAR; PG8_SCHED;
            PG8_STAGE(PG8_SB(0, 1), b2 + hstepB, voffB);
            PG8_WAIT_V(6); PG8_BAR; PG8_MMA(1, 1, At, B1); PG8_BAR;
            PG8_LDB(B0, 1, 0); PG8_SCHED; PG8_LDA(At, 1, 0); PG8_STAGE(PG8_SA(0, 1), a2 + hstepA, voffA);
            PG8_WAIT_L(8); PG8_BAR; PG8_WAIT_L(0); PG8_MMA(0, 0, At, B0); PG8_BAR; PG8_SCHED;
            PG8_LDB(B1, 1, 1); PG8_STAGE(PG8_SB(1, 0), b3, voffB);
            PG8_BAR; PG8_WAIT_L(0); PG8_MMA(0, 1, At, B1); PG8_BAR;
            PG8_LDA(At, 1, 1); PG8_STAGE(PG8_SA(1, 0), a3, voffA);
            PG8_BAR; PG8_WAIT_L(0); PG8_MMA(1, 0, At, B0); PG8_BAR; PG8_SCHED;
            PG8_STAGE(PG8_SB(1, 1), b3 + hstepB, voffB);
            PG8_WAIT_V(6); PG8_BAR; PG8_MMA(1, 1, At, B1); PG8_BAR;
            }
        }
        if constexpr (ALIGN_EPI) { if (wr == 0) PG8_BAR; }
        if constexpr (!Epi::AFTER_DRAIN) { E(acc, cur, wr, wc, fr, fq); S.done(cur); }
        if (!has_next) break;
#pragma unroll
        for (int a = 0; a < 2; ++a)
#pragma unroll
            for (int b = 0; b < 2; ++b)
#pragma unroll
                for (int m = 0; m < 4; ++m)
#pragma unroll
                    for (int n = 0; n < 2; ++n) acc[a][b][m][n] = (f32x4){0.f, 0.f, 0.f, 0.f};
        cur = nxt; cA = nA; cB = nB; ++ui;
        if constexpr (ALIGN_EPI) { if (wr == 1) PG8_BAR; }
    }
    PG8_WAIT_V(0);
    if constexpr (!ALIGN_EPI) { if (wr == 0) PG8_BAR; }
    PG8_BAR;
    if constexpr (Epi::AFTER_DRAIN) { E.fused(acc, cur, wr, wc, fr, fq, lds, wid, lane); S.done(cur); }
#undef PG8_SA
#undef PG8_SB
#undef PG8_STAGE
#undef PG8_LDA
#undef PG8_LDB
#undef PG8_MMA
#undef PG8_WAIT_V
#undef PG8_WAIT_L
#undef PG8_BAR
#undef PG8_SCHED
}
}

#ifndef PG8_SP2
#define PG8_SP2 true
#endif
#ifndef PG8_ALIGN
#define PG8_ALIGN true
#endif

namespace pg8 {
struct EpiResF32 {
    static constexpr bool PERM = false, AFTER_DRAIN = false;
    const float* base; float* out; int ldc;
    __device__ __forceinline__ void operator()(const f32x4 (&acc)[2][2][4][2], const Unit& u, int wr, int wc, int fr, int fq) const {
        const int col0 = u.pn * BM + wc * 32 + 4 * fq;
#pragma unroll
        for (int ai = 0; ai < 2; ++ai)
#pragma unroll
            for (int m = 0; m < 4; ++m) { const size_t off = (size_t)(u.pm * BM + ai * HALF + wr * 64 + m * 16 + fr) * ldc + col0;
#pragma unroll
                for (int bj = 0; bj < 2; ++bj)
#pragma unroll
                    for (int n = 0; n < 2; ++n) { const f32x4 b = *(const f32x4*)(base + off + bj * HALF + n * 16); *(f32x4*)(out + off + bj * HALF + n * 16) = b + acc[ai][bj][m][n]; } }
    }
};
}

constexpr int GEMM_LDS = pg8::STAGE_BYTES;

__device__ __forceinline__ void rope_table_elem(float* ct, float* st, int idx) {
    const int pos = idx >> 5, j = idx & 31;
    const float freq = exp2f(-(float)j * (13.287712379549449f / 32.0f));
    const float ang = (float)pos * freq;
    double rev = (double)ang * 0.15915494309189535;
    rev -= floor(rev);
    const float fr = (float)rev;
    ct[idx] = __builtin_amdgcn_cosf(fr);
    st[idx] = __builtin_amdgcn_sinf(fr);
}

__device__ __forceinline__ int win_src_col(int n) {
    if (n < 2560) return n;
    if (n < 3072) return n - 2560 + 3304;
    if (n < 3456) return n - 3072 + 2632;
    if (n < 3712) return n - 3456 + 3016;
    if (n < 3776) return n - 3712 + 2560;
    if (n < 3808) return n - 3776 + 3272;
    if (n < 3816) return n - 3808 + 2624;
    return -1;
}
__device__ __forceinline__ void wtrans_tile(LAS float* t, const float* __restrict__ W, int K, int Nold, bf16* __restrict__ WT, int n0, int k0, bool remap, int tid) {
    __syncthreads();
    for (int i = tid; i < 4096; i += 512) { const int kk = i >> 6, nn = i & 63; const int n = n0 + nn; const int src = remap ? win_src_col(n) : n;
        t[kk * 65 + nn] = (src >= 0) ? W[(size_t)(k0 + kk) * Nold + src] : 0.f; }
    __syncthreads();
    for (int i = tid; i < 4096; i += 512) { const int nn = i >> 6, kk = i & 63; WT[(size_t)(n0 + nn) * K + k0 + kk] = (bf16)f2bf(t[kk * 65 + nn]); }
}

__device__ __forceinline__ float wave_sum(float v) {
#pragma unroll
    for (int o = 1; o < 64; o <<= 1) v += __shfl_xor(v, o);
    return v;
}
__device__ __forceinline__ void rmsnorm_x_row(const float* __restrict__ x, const float* __restrict__ g, bf16* __restrict__ xn, int row, int lane) {
    const f32x4_t* xr = (const f32x4_t*)(x + (size_t)row * DMODEL) + lane;
    const f32x4_t* gr = (const f32x4_t*)g + lane;
    f32x4_t v[4]; float s = 0.f;
#pragma unroll
    for (int j = 0; j < 4; ++j) { v[j] = xr[64 * j]; s += (v[j].x * v[j].x + v[j].y * v[j].y) + (v[j].z * v[j].z + v[j].w * v[j].w); }
    const float rs = 1.0f / sqrtf(wave_sum(s) * (1.0f / DMODEL) + RMS_EPS);
    u32x2_t* o = (u32x2_t*)(xn + (size_t)row * DMODEL) + lane;
#pragma unroll
    for (int j = 0; j < 4; ++j) { const f32x4_t gg = gr[64 * j]; u32x2_t w; w.x = pk2(v[j].x * rs * gg.x, v[j].y * rs * gg.y); w.y = pk2(v[j].z * rs * gg.z, v[j].w * rs * gg.w); o[64 * j] = w; }
}

__device__ __forceinline__ void post_a_row(bf16* __restrict__ proj, const float* __restrict__ aq_g, const float* __restrict__ ak_g,
                                           const float* __restrict__ cq_g, const float* __restrict__ ckv_g, const float* __restrict__ ropec, const float* __restrict__ ropes, int row, int lane) {
    const int pos = row & (SEQ - 1);
    bf16* p = proj + (size_t)row * NP;
    const float* cs = ropec + pos * 32; const float* sn = ropes + pos * 32;
    const int h = lane >> 3, j = lane & 7;
#pragma unroll
    for (int which = 0; which < 2; ++which) {
        bf16* base = p + (which ? C_KA : C_QA) + 64 * h;
        const float* g = which ? ak_g : aq_g;
        const u32x2_t r1 = *(const u32x2_t*)(base + 4 * j), r2 = *(const u32x2_t*)(base + 32 + 4 * j);
        float x1[4] = {bflo(r1.x), bfhi(r1.x), bflo(r1.y), bfhi(r1.y)}, x2[4] = {bflo(r2.x), bfhi(r2.x), bflo(r2.y), bfhi(r2.y)};
        float ss = 0.f;
#pragma unroll
        for (int i = 0; i < 4; ++i) ss += x1[i] * x1[i] + x2[i] * x2[i];
        ss += __shfl_xor(ss, 1); ss += __shfl_xor(ss, 2); ss += __shfl_xor(ss, 4);
        const float rs = 1.0f / sqrtf(ss * (1.0f / 64.0f) + RMS_EPS);
        const float sc = which ? 1.0f : C2A;
        float o1[4], o2[4];
#pragma unroll
        for (int i = 0; i < 4; ++i) { const int d = 4 * j + i; const float a = x1[i] * rs * g[d], b = x2[i] * rs * g[d + 32]; const float c = cs[d], s = sn[d];
            o1[i] = (a * c - b * s) * sc; o2[i] = (b * c + a * s) * sc; }
        u32x2_t w1, w2; w1.x = pk2(o1[0], o1[1]); w1.y = pk2(o1[2], o1[3]); w2.x = pk2(o2[0], o2[1]); w2.y = pk2(o2[2], o2[3]);
        *(u32x2_t*)(base + 4 * j) = w1; *(u32x2_t*)(base + 32 + 4 * j) = w2;
    }
    {
        bf16* base = p + C_QI + 64 * h;
        const unsigned r1 = *(const unsigned*)(base + 2 * j), r2 = *(const unsigned*)(base + 16 + 2 * j);
        const float a0 = bflo(r1), a1 = bfhi(r1), b0 = bflo(r2), b1 = bfhi(r2);
        const float c0 = cs[4 * j], s0 = sn[4 * j], c1 = cs[4 * j + 2], s1 = sn[4 * j + 2];
        *(unsigned*)(base + 2 * j) = pk2(a0 * c0 - b0 * s0, a1 * c1 - b1 * s1);
        *(unsigned*)(base + 16 + 2 * j) = pk2(b0 * c0 + a0 * s0, b1 * c1 + a1 * s1);
    }
    if (lane < 8) {
        bf16* base = p + C_KI;
        const unsigned r1 = *(const unsigned*)(base + 2 * j), r2 = *(const unsigned*)(base + 16 + 2 * j);
        const float a0 = bflo(r1), a1 = bfhi(r1), b0 = bflo(r2), b1 = bfhi(r2);
        const float c0 = cs[4 * j], s0 = sn[4 * j], c1 = cs[4 * j + 2], s1 = sn[4 * j + 2];
        *(unsigned*)(base + 2 * j) = pk2(a0 * c0 - b0 * s0, a1 * c1 - b1 * s1);
        *(unsigned*)(base + 16 + 2 * j) = pk2(b0 * c0 + a0 * s0, b1 * c1 + a1 * s1);
    }
    {
        unsigned* base = (unsigned*)(p + C_CQ + 6 * lane);
        const unsigned r0 = base[0], r1 = base[1], r2 = base[2];
        float v[6] = {bflo(r0), bfhi(r0), bflo(r1), bfhi(r1), bflo(r2), bfhi(r2)};
        float ss = 0.f;
#pragma unroll
        for (int i = 0; i < 6; ++i) ss += v[i] * v[i];
        const float rs = 1.0f / sqrtf(wave_sum(ss) * (1.0f / 384.0f) + RMS_EPS);
        const float* g = cq_g + 6 * lane;
        base[0] = pk2(v[0] * rs * g[0], v[1] * rs * g[1]); base[1] = pk2(v[2] * rs * g[2], v[3] * rs * g[3]); base[2] = pk2(v[4] * rs * g[4], v[5] * rs * g[5]);
    }
    {
        u32x2_t* base = (u32x2_t*)(p + C_CKV + 4 * lane);
        const u32x2_t r = *base;
        float v[4] = {bflo(r.x), bfhi(r.x), bflo(r.y), bfhi(r.y)};
        float ss = (v[0] * v[0] + v[1] * v[1]) + (v[2] * v[2] + v[3] * v[3]);
        const float rs = 1.0f / sqrtf(wave_sum(ss) * (1.0f / 256.0f) + RMS_EPS);
        const float* g = ckv_g + 4 * lane;
        u32x2_t w; w.x = pk2(v[0] * rs * g[0], v[1] * rs * g[1]); w.y = pk2(v[2] * rs * g[2], v[3] * rs * g[3]);
        *base = w;
    }
}

__device__ __forceinline__ void post_b_row(bf16* __restrict__ qb, const bf16* __restrict__ kvr, const bf16* __restrict__ proj, bf16* __restrict__ kb,
                                           const float* __restrict__ bq_g, const float* __restrict__ bk_g, const float* __restrict__ ropec, const float* __restrict__ ropes, int row, int lane) {
    const int pos = row & (SEQ - 1);
    const float* cs = ropec + pos * 32; const float* sn = ropes + pos * 32;
    const int h = lane >> 3, j = lane & 7;
    const float c0 = cs[4 * j], s0 = sn[4 * j], c1 = cs[4 * j + 2], s1 = sn[4 * j + 2];
#pragma unroll
    for (int which = 0; which < 2; ++which) {
        const bf16* nsrc = which ? (kvr + (size_t)row * 1024 + 128 * h + 8 * j) : (qb + (size_t)row * 768 + 96 * h + 8 * j);
        const bf16* rsrc = which ? (proj + (size_t)row * NP + C_KR + 2 * j) : (qb + (size_t)row * 768 + 96 * h + 64 + 2 * j);
        const float* g = which ? bk_g : bq_g;
        const u32x4_t rn = *(const u32x4_t*)nsrc;
        const unsigned r1 = *(const unsigned*)rsrc, r2 = *(const unsigned*)(rsrc + 16);
        float v[8] = {bflo(rn.x), bfhi(rn.x), bflo(rn.y), bfhi(rn.y), bflo(rn.z), bfhi(rn.z), bflo(rn.w), bfhi(rn.w)};
        const float a0 = bflo(r1), a1 = bfhi(r1), b0 = bflo(r2), b1 = bfhi(r2);
        float ss = (a0 * a0 + a1 * a1) + (b0 * b0 + b1 * b1);
#pragma unroll
        for (int i = 0; i < 8; ++i) ss += v[i] * v[i];
        ss += __shfl_xor(ss, 1); ss += __shfl_xor(ss, 2); ss += __shfl_xor(ss, 4);
        const float rs = 1.0f / sqrtf(ss * (1.0f / 96.0f) + RMS_EPS);
        const float sc = which ? 1.0f : C2B;
        u32x4_t wn;
        { const float* gn = g + 8 * j; const float q = rs * sc;
          wn.x = pk2(v[0] * q * gn[0], v[1] * q * gn[1]); wn.y = pk2(v[2] * q * gn[2], v[3] * q * gn[3]); wn.z = pk2(v[4] * q * gn[4], v[5] * q * gn[5]); wn.w = pk2(v[6] * q * gn[6], v[7] * q * gn[7]); }
        const float A0 = a0 * rs * g[64 + 2 * j], A1 = a1 * rs * g[64 + 2 * j + 1], B0 = b0 * rs * g[80 + 2 * j], B1 = b1 * rs * g[80 + 2 * j + 1];
        const unsigned w1 = pk2((A0 * c0 - B0 * s0) * sc, (A1 * c1 - B1 * s1) * sc), w2 = pk2((B0 * c0 + A0 * s0) * sc, (B1 * c1 + A1 * s1) * sc);
        bf16* dst = which ? (kb + (size_t)row * 768 + 96 * h) : (qb + (size_t)row * 768 + 96 * h);
        *(u32x4_t*)(dst + 8 * j) = wn; *(unsigned*)(dst + 64 + 2 * j) = w1; *(unsigned*)(dst + 80 + 2 * j) = w2;
    }
}

constexpr int IDX_QPITCH = 1040;
constexpr int IDX_LDS = 32 * IDX_QPITCH + 2 * 8 * 32 * 4 + 8 * 32 * 4;
constexpr int TOPK = 256;

__device__ __forceinline__ unsigned sortable_key(float x) { const unsigned u = __builtin_bit_cast(unsigned, x + 0.0f); return (u & 0x80000000u) ? ~u : (u | 0x80000000u); }

__device__ __forceinline__ void indexer_unit(LAS unsigned char* lds, const bf16* __restrict__ proj, unsigned long long* __restrict__ mask, int b, int qb) {
    const int tid = opaque_tid(), lane = tid & 63, w = __builtin_amdgcn_readfirstlane(tid >> 6), r32 = lane & 31, hi = lane >> 5;
    const int L = 64 * ((qb >> 1) + 1), nt32 = L >> 5;
    const int nloc = (nt32 - w + 7) >> 3;
    unsigned long long* mbase = mask + ((size_t)(b * 64 + qb) * 64) * 16;
    if (L <= TOPK) {
        for (int i = 0; i < nloc; ++i) { const int j = w + 8 * i; if (lane < 16) mbase[(size_t)j * 16 + lane] = ~0ull; }
        return;
    }
    const size_t row0 = (size_t)b * SEQ + 32 * qb;
    __syncthreads();
    for (int c = tid; c < 32 * 64; c += 512) { const int r = c >> 6, ch = c & 63;
        *(LAS u32x4_t*)(lds + r * IDX_QPITCH + ch * 16) = *(const u32x4_t*)(proj + (row0 + r) * NP + C_QI + ch * 8); }
    LAS float* wl = (LAS float*)(lds + 32 * IDX_QPITCH + 2048);
    if (tid < 256) { const int q = tid & 31, hh = tid >> 5; wl[hh * 32 + q] = bf2f(proj[(row0 + q) * NP + C_WI + hh]); }
    __syncthreads();
    unsigned key[8][16];
    const LAS unsigned char* qrow = lds + r32 * IDX_QPITCH + hi * 16;
#pragma unroll
    for (int i = 0; i < 8; ++i) {
        if (i < nloc) {
            const int j = w + 8 * i;
            const bf16* kp = proj + ((size_t)b * SEQ + 32 * j + r32) * NP + C_KI + 8 * hi;
            bf16x8_t kf[4];
#pragma unroll
            for (int s = 0; s < 4; ++s) kf[s] = *(const bf16x8_t*)(kp + 16 * s);
            f32x16_t tot;
#pragma unroll
            for (int r = 0; r < 16; ++r) tot[r] = 0.f;
#pragma unroll 1
            for (int h = 0; h < 8; ++h) {
                const float wh = wl[h * 32 + r32];
                f32x16_t acc;
#pragma unroll
                for (int r = 0; r < 16; ++r) acc[r] = 0.f;
#pragma unroll
                for (int s = 0; s < 4; ++s) { const bf16x8_t qf = *(const LAS bf16x8_t*)(qrow + (64 * h + 16 * s) * 2); acc = __builtin_amdgcn_mfma_f32_32x32x16_bf16(kf[s], qf, acc, 0, 0, 0); }
#pragma unroll
                for (int r = 0; r < 16; ++r) tot[r] = fmaf(wh, fmaxf(acc[r], 0.f), tot[r]);
            }
#pragma unroll
            for (int r = 0; r < 16; ++r) key[i][r] = sortable_key(tot[r]);
            __builtin_amdgcn_sched_barrier(0);
        } else {
#pragma unroll
            for (int r = 0; r < 16; ++r) key[i][r] = 0u;
        }
    }
    LAS int* cnts = (LAS int*)(lds + 32 * IDX_QPITCH);
    int step = 0;
#define IDX_REDUCE(cntvar, totvar) do { int c_ = (cntvar); c_ += __shfl_xor(c_, 32); const int buf_ = (step & 1) * 256; ++step; \
        if (lane < 32) cnts[buf_ + w * 32 + lane] = c_; __syncthreads(); int t_ = 0; _Pragma("unroll") for (int ww = 0; ww < 8; ++ww) t_ += cnts[buf_ + ww * 32 + r32]; (totvar) = t_; } while (0)
    unsigned T = 0u;
    for (int bit = 31; bit >= 0; --bit) {
        const unsigned cand = T | (1u << bit);
        int cnt = 0;
#pragma unroll
        for (int i = 0; i < 8; ++i) if (i < nloc) {
#pragma unroll
            for (int r = 0; r < 16; ++r) cnt += (key[i][r] >= cand) ? 1 : 0; }
        int tot; IDX_REDUCE(cnt, tot);
        if (tot >= TOPK) T = cand;
    }
    int cgt = 0, ceq = 0;
#pragma unroll
    for (int i = 0; i < 8; ++i) if (i < nloc) {
#pragma unroll
        for (int r = 0; r < 16; ++r) { cgt += (key[i][r] > T) ? 1 : 0; ceq += (key[i][r] == T) ? 1 : 0; } }
    int tgt, teq; IDX_REDUCE(cgt, tgt); IDX_REDUCE(ceq, teq);
    const int need = TOPK - tgt;
    int X = 1 << 20;
    if (__any(teq > need)) {
        X = 0;
        for (int bit = 10; bit >= 0; --bit) {
            const int cand = X | (1 << bit);
            int cnt = 0;
#pragma unroll
            for (int i = 0; i < 8; ++i) if (i < nloc) {
                const int ti = cand - 32 * (w + 8 * i) - 4 * hi;
#pragma unroll
                for (int r = 0; r < 16; ++r) cnt += (key[i][r] == T && ((r & 3) + 8 * (r >> 2)) < ti) ? 1 : 0; }
            int tot; IDX_REDUCE(cnt, tot);
            if (tot < need) X = cand;
        }
    }
#undef IDX_REDUCE
#pragma unroll
    for (int i = 0; i < 8; ++i) if (i < nloc) {
        const int j = w + 8 * i;
        const int xi = X - 32 * j - 4 * hi;
        unsigned long long mine = 0ull;
#pragma unroll
        for (int r = 0; r < 16; ++r) {
            const bool sel = (key[i][r] > T) || (key[i][r] == T && ((r & 3) + 8 * (r >> 2)) <= xi);
            const unsigned long long bal = __ballot(sel);
            if (lane == r) mine = bal; }
        if (lane < 16) mbase[(size_t)j * 16 + lane] = mine;
    }
}

struct AttnArgs { const bf16* Q; const bf16* K; const bf16* V; const bf16* G; bf16* O; const unsigned long long* mask; int qpitch, qhs, kpitch, khs, vpitch, vhs, gpitch, ocol; };

template <int DQK> struct AttnCfg { static constexpr int KP = (DQK + 8) * 2, VP = 192, K_OFF = 0, V_OFF = 64 * KP, WS_OFF = V_OFF + 64 * VP, LDS = WS_OFF + 8 * 64 * 4; };

template <int DQK, bool MASKED>
__device__ __forceinline__ void attn_unit8(LAS unsigned char* lds, const AttnArgs& a, int b, int h, int q0) {
    typedef AttnCfg<DQK> C;
    const int tid = opaque_tid(), lane = tid & 63, w = __builtin_amdgcn_readfirstlane(tid >> 6), r32 = lane & 31, hi = lane >> 5;
    const size_t rowb = (size_t)b * SEQ;
    const int qw = q0 + 32 * w, ntw = (qw >> 6) + 1, nt = (q0 >> 6) + 4;
    constexpr int NS = DQK / 16;
    bf16x8_t qf[NS];
    { const bf16* qp = a.Q + (rowb + qw + r32) * a.qpitch + h * a.qhs + 8 * hi;
#pragma unroll
      for (int s = 0; s < NS; ++s) qf[s] = *(const bf16x8_t*)(qp + 16 * s); }
    f32x16_t o0, o1;
#pragma unroll
    for (int r = 0; r < 16; ++r) { o0[r] = 0.f; o1[r] = 0.f; }
    float m = -INFINITY, l = 0.f;
    LAS float* wsf = (LAS float*)(lds + C::WS_OFF) + w * 64;
    const bf16* Kh = a.K + rowb * a.kpitch + h * a.khs; const bf16* Vh = a.V + rowb * a.vpitch + h * a.vhs;
    const unsigned long long* mrow = MASKED ? a.mask + ((size_t)(b * 64 + (qw >> 5)) * 64) * 16 : nullptr;
    const LAS unsigned char* kfrag = lds + C::K_OFF + r32 * C::KP + hi * 16;
    const LAS unsigned char* vfrag = lds + C::V_OFF + (4 * hi + ((lane & 15) >> 2)) * C::VP + (16 * ((lane >> 4) & 1) + 4 * (lane & 3)) * 2;
    for (int t = 0; t < nt; ++t) {
        __syncthreads();
        constexpr int KCH = DQK / 8;
        for (int c = tid; c < 64 * KCH; c += 512) { const int r = c / KCH, ch = c % KCH;
            *(LAS u32x4_t*)(lds + C::K_OFF + r * C::KP + ch * 16) = *(const u32x4_t*)(Kh + (size_t)(64 * t + r) * a.kpitch + ch * 8); }
        for (int c = tid; c < 64 * 8; c += 512) { const int r = c >> 3, ch = c & 7;
            *(LAS u32x4_t*)(lds + C::V_OFF + r * C::VP + ch * 16) = *(const u32x4_t*)(Vh + (size_t)(64 * t + r) * a.vpitch + ch * 8); }
        __syncthreads();
        if (t < ntw) {
            f32x16_t p0, p1;
#pragma unroll
            for (int r = 0; r < 16; ++r) { p0[r] = 0.f; p1[r] = 0.f; }
#pragma unroll
            for (int s = 0; s < NS; ++s) {
                const bf16x8_t k0 = *(const LAS bf16x8_t*)(kfrag + s * 32), k1 = *(const LAS bf16x8_t*)(kfrag + 32 * C::KP + s * 32);
                p0 = __builtin_amdgcn_mfma_f32_32x32x16_bf16(k0, qf[s], p0, 0, 0, 0);
                p1 = __builtin_amdgcn_mfma_f32_32x32x16_bf16(k1, qf[s], p1, 0, 0, 0);
            }
            if (MASKED) {
                const unsigned long long* mw = mrow + (size_t)(2 * t) * 16;
#pragma unroll
                for (int r = 0; r < 16; ++r) { const unsigned long long w0 = mw[r], w1 = mw[16 + r];
                    if (!((w0 >> lane) & 1ull)) p0[r] = -INFINITY;
                    if (!((w1 >> lane) & 1ull)) p1[r] = -INFINITY; }
            }
            float mx = fmaxf(p0[0], p1[0]);
#pragma unroll
            for (int r = 1; r < 16; ++r) mx = fmaxf(mx, fmaxf(p0[r], p1[r]));
            mx = fmaxf(mx, __shfl_xor(mx, 32));
            const float mnew = fmaxf(m, mx), muse = (mnew == -INFINITY) ? 0.f : mnew;
            const float alpha = __builtin_amdgcn_exp2f(m - muse);
            float rs = 0.f;
#pragma unroll
            for (int r = 0; r < 16; ++r) { p0[r] = __builtin_amdgcn_exp2f(p0[r] - muse); p1[r] = __builtin_amdgcn_exp2f(p1[r] - muse); rs += p0[r] + p1[r]; }
            rs += __shfl_xor(rs, 32);
            l = l * alpha + rs; m = mnew;
            if (hi == 0) wsf[r32] = alpha;
            asm volatile("s_waitcnt lgkmcnt(0)" ::: "memory");
#pragma unroll
            for (int r = 0; r < 16; ++r) { const float f = wsf[crow(r, hi)]; o0[r] *= f; o1[r] *= f; }
            bf16x8_t pa[4];
#pragma unroll
            for (int k = 0; k < 4; ++k) { u32x4_t pw;
#pragma unroll
                for (int i = 0; i < 4; ++i) { const float lo = (k < 2) ? p0[8 * (k & 1) + 2 * i] : p1[8 * (k & 1) + 2 * i], hh = (k < 2) ? p0[8 * (k & 1) + 2 * i + 1] : p1[8 * (k & 1) + 2 * i + 1]; pw[i] = pk2(lo, hh); }
                pa[k] = __builtin_bit_cast(bf16x8_t, pw); }
#pragma unroll
            for (int k = 0; k < 4; ++k) {
#pragma unroll
                for (int db = 0; db < 2; ++db) {
                    const LAS unsigned char* vp = vfrag + (16 * k) * C::VP + db * 64;
                    const s16x4_t lo = __builtin_bit_cast(s16x4_t, __builtin_amdgcn_ds_read_tr16_b64_v4i16((LAS s16x4_t*)vp));
                    const s16x4_t hh = __builtin_bit_cast(s16x4_t, __builtin_amdgcn_ds_read_tr16_b64_v4i16((LAS s16x4_t*)(vp + 8 * C::VP)));
                    const bf16x8_t vb = (bf16x8_t){lo[0], lo[1], lo[2], lo[3], hh[0], hh[1], hh[2], hh[3]};
                    if (db == 0) o0 = __builtin_amdgcn_mfma_f32_32x32x16_bf16(pa[k], vb, o0, 0, 0, 0);
                    else o1 = __builtin_amdgcn_mfma_f32_32x32x16_bf16(pa[k], vb, o1, 0, 0, 0);
                }
            }
        }
    }
    asm volatile("s_waitcnt lgkmcnt(0)" ::: "memory");
    if (hi == 0) wsf[32 + r32] = l;
    asm volatile("s_waitcnt lgkmcnt(0)" ::: "memory");
#pragma unroll
    for (int r = 0; r < 16; ++r) {
        const int row = qw + crow(r, hi);
        const float inv = 1.0f / wsf[32 + crow(r, hi)];
        const bf16* gp = a.G + (rowb + row) * a.gpitch + 64 * h;
        bf16* op = a.O + (rowb + row) * 1024 + a.ocol + 64 * h;
        const float g0 = bf2f(gp[r32]), g1 = bf2f(gp[32 + r32]);
        const float s0 = g0 / (1.0f + __expf(-g0)), s1 = g1 / (1.0f + __expf(-g1));
        op[r32] = (bf16)f2bf(o0[r] * inv * s0); op[32 + r32] = (bf16)f2bf(o1[r] * inv * s1);
    }
}
namespace fa {
using bf16x8=__attribute__((ext_vector_type(8)))short;
using s16x4=__attribute__((ext_vector_type(4)))short;
using f32x16=__attribute__((ext_vector_type(16)))float;
using u32x4=__attribute__((ext_vector_type(4)))unsigned;
constexpr int SEQ=2048,D=64;
constexpr int NW=8,QBLK=32,QB=QBLK*NW,KVBLK=64,NQB=SEQ/QB;
__device__ __forceinline__ int crow(int r,int hi){return (r&3)+8*(r>>2)+4*hi;}
#define SBAR() __builtin_amdgcn_sched_barrier(0)
__device__ __forceinline__ void allneg(f32x16&p0,f32x16&p1){
  const float NEG=-INFINITY;
  #pragma unroll
  for(int r=0;r<16;++r){p0[r]=NEG;p1[r]=NEG;}
}

constexpr int NSLOT=3, SLOTB=8192, SLOTKMAX=12288;
constexpr int LDS_K=0, LDS_V=NSLOT*SLOTKMAX, LDS_WS=LDS_V+NSLOT*SLOTB, LDS_OST=LDS_WS+NW*64*4, LDS_BYTES=LDS_OST+NW*4096;
__device__ __forceinline__ void glds16(const void*gsrc,unsigned lds_dst){unsigned keep;
  asm volatile("s_mov_b32 %0, m0\n\ts_mov_b32 m0, %2\n\ts_nop 0\n\tglobal_load_lds_dwordx4 %1, off\n\ts_mov_b32 m0, %0":"=&s"(keep):"v"(gsrc),"s"(lds_dst):"memory");}
__device__ __forceinline__ float max3f(float a,float b,float c){float r;asm("v_max3_f32 %0, %1, %2, %3":"=v"(r):"v"(a),"v"(b),"v"(c));return r;}
__device__ __forceinline__ float max2f(float a,float b){float r;asm("v_max_f32_e32 %0, %1, %2":"=v"(r):"v"(a),"v"(b));return r;}
__device__ __forceinline__ float fadd_s(float a,float b){float r;asm("v_add_f32_e32 %0, %1, %2":"=v"(r):"v"(a),"v"(b));return r;}
__device__ __forceinline__ float fsub_s(float a,float b){float r;asm("v_sub_f32_e32 %0, %1, %2":"=v"(r):"v"(a),"v"(b));return r;}
typedef float f32x2_t __attribute__((ext_vector_type(2))); typedef __bf16 bf16x2_t __attribute__((ext_vector_type(2)));
__device__ __forceinline__ unsigned cvtpk_s(float lo,float hi){f32x2_t v={lo,hi};bf16x2_t b=__builtin_convertvector(v,bf16x2_t);return __builtin_bit_cast(unsigned,b);}
#define WAIT_BAR(N) asm volatile("s_waitcnt vmcnt(" #N ") lgkmcnt(0)\n\ts_barrier":::"memory")

template<int NS> __device__ __forceinline__ void qkt(f32x16&p0,f32x16&p1,const char*Kslot,const bf16x8*qr,int r32,int hi){
  const char*kb=Kslot+hi*1024+r32*16;
  #pragma unroll
  for(int d0=0;d0<NS;++d0){
    const bf16x8 b0=*reinterpret_cast<const bf16x8*>(kb+d0*2048);
    const bf16x8 b1=*reinterpret_cast<const bf16x8*>(kb+d0*2048+512);
    if(d0==0){p0=__builtin_amdgcn_mfma_f32_32x32x16_bf16(b0,qr[0],f32x16{},0,0,0);p1=__builtin_amdgcn_mfma_f32_32x32x16_bf16(b1,qr[0],f32x16{},0,0,0);}
    else{p0=__builtin_amdgcn_mfma_f32_32x32x16_bf16(b0,qr[d0],p0,0,0,0);p1=__builtin_amdgcn_mfma_f32_32x32x16_bf16(b1,qr[d0],p1,0,0,0);}}
}
typedef __attribute__((address_space(3))) const char* lds_cptr;
typedef short v4i16_t __attribute__((ext_vector_type(4)));
template<int NS> __device__ __forceinline__ void kloadN(bf16x8*kf,lds_cptr kp){
  #pragma unroll
  for(int d0=0;d0<NS;++d0){ kf[2*d0]=*(const __attribute__((address_space(3))) bf16x8*)(kp+d0*2048); kf[2*d0+1]=*(const __attribute__((address_space(3))) bf16x8*)(kp+d0*2048+512); }
}
__device__ __forceinline__ void kload2(bf16x8*kf,lds_cptr kp,int j){ kf[2*j]=*(const __attribute__((address_space(3))) bf16x8*)(kp+j*2048); kf[2*j+1]=*(const __attribute__((address_space(3))) bf16x8*)(kp+j*2048+512); }
__device__ __forceinline__ s16x4 vtr(lds_cptr p){ return __builtin_bit_cast(s16x4,__builtin_amdgcn_ds_read_tr16_b64_v4i16((__attribute__((address_space(3))) v4i16_t*)p)); }
__device__ __forceinline__ float rowmax(const f32x16&p0,const f32x16&p1){
  float a=max3f(p0[0],p0[1],p1[0]),b=max3f(p0[2],p0[3],p1[1]);a=max3f(a,p1[2],p1[3]);
  #pragma unroll
  for(int r=4;r<16;r+=4){a=max3f(a,p0[r],p0[r+1]);b=max3f(b,p0[r+2],p0[r+3]);a=max3f(a,p1[r],p1[r+1]);b=max3f(b,p1[r+2],p1[r+3]);}
  const float m=max2f(a,b);
  auto rr=__builtin_amdgcn_permlane32_swap(__float_as_uint(m),__float_as_uint(m),false,false);
  return max2f(__uint_as_float(rr[0]),__uint_as_float(rr[1]));
}
__device__ __forceinline__ void pv(f32x16*o,int vb,bf16x8 pa0,bf16x8 pa1,bf16x8 pa2,bf16x8 pa3){
  #pragma unroll
  for(int d0=0;d0<2;++d0){s16x4 lo[4],hi[4];
    #pragma unroll
    for(int ks=0;ks<4;++ks){
      asm volatile("ds_read_b64_tr_b16 %0,%1 offset:%c2":"=&v"(lo[ks]):"v"(vb),"i"(d0*4096+ks*1024):"memory");
      asm volatile("ds_read_b64_tr_b16 %0,%1 offset:%c2":"=&v"(hi[ks]):"v"(vb),"i"(d0*4096+ks*1024+512):"memory");}
    asm volatile("s_waitcnt lgkmcnt(0)":::"memory");SBAR();
    #define PK(k) (bf16x8){lo[k][0],lo[k][1],lo[k][2],lo[k][3],hi[k][0],hi[k][1],hi[k][2],hi[k][3]}
    o[d0]=__builtin_amdgcn_mfma_f32_32x32x16_bf16(pa0,PK(0),o[d0],0,0,0);
    o[d0]=__builtin_amdgcn_mfma_f32_32x32x16_bf16(pa1,PK(1),o[d0],0,0,0);
    o[d0]=__builtin_amdgcn_mfma_f32_32x32x16_bf16(pa2,PK(2),o[d0],0,0,0);
    o[d0]=__builtin_amdgcn_mfma_f32_32x32x16_bf16(pa3,PK(3),o[d0],0,0,0);
    #undef PK
  }
}

#ifndef ATTN_STORE16
#define ATTN_STORE16(p,v) (*(u32x4*)(p)=(v))
#endif
template<int THRL,bool SEL,int NS> __device__ __forceinline__ void attn_unit(int b,int h,int qb,const AttnArgs&a,char*shm){
  const int tid=opaque_tid(),lane=tid&63,r32=lane&31,hi=lane>>5; const int wid=__builtin_amdgcn_readfirstlane(tid>>6);
  const long rowbase=(long)b*SEQ; const int q0=qb*QB;
  const long qpitch=a.qpitch,kpitch=a.kpitch,vpitch=a.vpitch;
  const bf16*Qw=a.Q+(rowbase+q0+wid*QBLK)*qpitch+h*a.qhs;
  const bf16*Kh=a.K+rowbase*kpitch+h*a.khs,*Vh=a.V+rowbase*vpitch+h*a.vhs;
  typedef const __attribute__((address_space(4))) unsigned long long* cmask_t;
  const cmask_t mrow=SEL?(cmask_t)(a.mask+((size_t)(b*64+(q0>>5)+wid)*64)*16):(cmask_t)nullptr;
  unsigned long long mk[32];
  const unsigned lds0=(unsigned)(uintptr_t)shm;
  float*wsf=(float*)(shm+LDS_WS)+wid*64;
  const bf16*ksrc=Kh+(long)lane*kpitch+wid*8;
  const bf16*vsrc=Vh+(long)(16*(wid&3)+(lane>>2))*vpitch+(wid>>2)*32+(lane&3)*8;
  const unsigned kdst=lds0+LDS_K+wid*1024, vdst=lds0+LDS_V+wid*1024;
  const bf16*ksrc2=Kh+(long)lane*kpitch+(8+(wid&3))*8; const unsigned kdst2=lds0+LDS_K+(8+(wid&3))*1024;
  #define KS(sl) (((sl)>>2)*NS)
  #define DMA_K(t,slot) do{ glds16(ksrc+(long)(t)*KVBLK*kpitch,(unsigned)__builtin_amdgcn_readfirstlane(kdst+KS(slot))); if constexpr(NS==6) glds16(ksrc2+(long)(t)*KVBLK*kpitch,(unsigned)__builtin_amdgcn_readfirstlane(kdst2+KS(slot))); }while(0)
  #define WB2() do{ if constexpr(NS==6){WAIT_BAR(3);}else{WAIT_BAR(2);} }while(0)
  #define DMA_V(t,slot) glds16(vsrc+(long)(t)*KVBLK*vpitch,(unsigned)__builtin_amdgcn_readfirstlane(vdst+(slot)))
  const int vb0=(int)(lds0+LDS_V)+((lane>>4)&1)*32+(lane&3)*8+(4*hi+((lane&15)>>2))*64;
  const char*Kbase=shm+LDS_K; bf16x8 kf[2*NS];
  const lds_cptr shm3=(lds_cptr)shm; const lds_cptr kp0=shm3+LDS_K+hi*1024+r32*16; const lds_cptr vp0=shm3+LDS_V+((lane>>4)&1)*32+(lane&3)*8+(4*hi+((lane&15)>>2))*64;
  const int NT=(q0+QB)/KVBLK;
  DMA_K(0,0);DMA_V(0,0);DMA_K(1,SLOTB);
  bf16x8 qr[NS];
  #pragma unroll
  for(int d0=0;d0<NS;++d0)qr[d0]=*reinterpret_cast<const bf16x8*>(&Qw[(long)r32*qpitch+d0*16+hi*8]);
  float l_reg=0.f;f32x16 o[2];o[0]=f32x16{};o[1]=f32x16{};
  const int qrel=wid*QBLK+r32;
  #define CMASK(P0,P1,t) do{int jb_=(t)-(NT-4); if(jb_>(wid>>1))allneg(P0,P1);}while(0)
  #define MKLOAD(t) do{ if constexpr(SEL){ const cmask_t mw_=mrow+(long)(t)*32; _Pragma("unroll") for(int r=0;r<32;++r)mk[r]=mw_[r]; } }while(0)
  #define MKZ(X,B,WB) do{ if constexpr(SEL){ _Pragma("unroll") for(int r=0;r<4;++r)X[(B)+r]=__builtin_amdgcn_inverse_ballot_w64(mk[(WB)+(B)+r])?X[(B)+r]:0.f; } }while(0)
  #define START(P0,P1) do{ _Pragma("unroll") for(int r=0;r<16;++r)P0[r]=__builtin_amdgcn_exp2f(P0[r]); }while(0)
  #define RESC() do{}while(0)
  f32x16 pA0,pA1,pB0,pB1;
  int sl_prev=0,sl_cur=0,sl_next=SLOTB;
  #define ROT() do{sl_prev=sl_cur;sl_cur=sl_next;sl_next=(sl_next==(NSLOT-1)*SLOTB)?0:sl_next+SLOTB;}while(0)
  MKLOAD(0);
  DMA_K(2,2*SLOTB);
  if constexpr(NS==6){WAIT_BAR(5);}else{WAIT_BAR(3);}
  qkt<NS>(pA0,pA1,Kbase,qr,r32,hi);asm volatile("s_nop 15\n\ts_nop 7":"+v"(pA0),"+v"(pA1));CMASK(pA0,pA1,0);
  START(pA0,pA1);
  _Pragma("unroll") for(int r=0;r<16;++r)pA1[r]=__builtin_amdgcn_exp2f(pA1[r]);
  MKZ(pA0,0,0);MKZ(pA0,4,0);MKZ(pA0,8,0);MKZ(pA0,12,0);MKZ(pA1,0,16);MKZ(pA1,4,16);MKZ(pA1,8,16);MKZ(pA1,12,16);
  WAIT_BAR(0);
  DMA_K(3,0);DMA_V(1,SLOTB);
  ROT();
  kloadN<NS>(kf,kp0+KS(sl_cur));
  WB2();
  s16x4 vlo[8],vhi[8]; u32x4 pw0,pw1,pw2,pw3;
  #define PKW(P,B) cvtpk_s(P[B],P[B+1])
  #define PAF(k) __builtin_bit_cast(bf16x8,pw##k)
  #define VFR(i) (bf16x8){vlo[i][0],vlo[i][1],vlo[i][2],vlo[i][3],vhi[i][0],vhi[i][1],vhi[i][2],vhi[i][3]}
  #define PIN(x) asm volatile("":"+v"(x))
  #define MX3(a,b,c) __builtin_fmaxf(__builtin_fmaxf((a),(b)),(c))
  #define GAPA(MF,A0,A1,A2,A3,W0,W1,PW) do{ MF; sacc+=A0; sacc+=A1; sacc+=A2; sacc+=A3; PIN(sacc); W0; W1; PIN(PW); SBAR(); }while(0)
  #define EX(v) __builtin_amdgcn_exp2f(v)
  #define GAPB(MF,X,B,WB) do{ MF; X[B]=EX(X[B]); X[B+1]=EX(X[B+1]); X[B+2]=EX(X[B+2]); X[B+3]=EX(X[B+3]); MKZ(X,B,WB); PIN(X); SBAR(); }while(0)
  #define VRD(i) do{ vlo[i]=vtr(vp_+(((i)>>2)*4096+((i)&3)*1024)); vhi[i]=vtr(vp_+(((i)>>2)*4096+((i)&3)*1024+512)); }while(0)
  #define KRD(G,j) do{ if(G){ kload2(kf,kp0+KS(sl_next),j); SBAR(); } }while(0)
  #define KRD6(G,j) do{ if constexpr(NS==6){ KRD(G,j); } }while(0)
  #define STEP(C0,C1,P0,P1,t,GK,GV,GL) do{ SBAR(); MKLOAD(t); \
    const lds_cptr vp_=vp0+sl_prev; \
    VRD(0); SBAR(); float sacc=(P0[0]+P0[1]); \
    GAPA(C0=__builtin_amdgcn_mfma_f32_32x32x16_bf16(kf[0],qr[0],f32x16{},0,0,0), P0[2],P0[3],P0[4],P0[5],     pw0[0]=PKW(P0,0), pw0[1]=PKW(P0,2), pw0); \
    VRD(4); SBAR(); GAPA(C1=__builtin_amdgcn_mfma_f32_32x32x16_bf16(kf[1],qr[0],f32x16{},0,0,0), P0[6],P0[7],P0[8],P0[9],     pw0[2]=PKW(P0,4), pw0[3]=PKW(P0,6), pw0); \
    VRD(1); SBAR(); GAPA(C0=__builtin_amdgcn_mfma_f32_32x32x16_bf16(kf[2],qr[1],C0,0,0,0),   P0[10],P0[11],P0[12],P0[13], pw1[0]=PKW(P0,8), pw1[1]=PKW(P0,10), pw1); \
    VRD(5); SBAR(); GAPA(C1=__builtin_amdgcn_mfma_f32_32x32x16_bf16(kf[3],qr[1],C1,0,0,0),   P0[14],P0[15],P1[0],P1[1],   pw1[2]=PKW(P0,12),pw1[3]=PKW(P0,14), pw1); \
    VRD(2); SBAR(); GAPA(C0=__builtin_amdgcn_mfma_f32_32x32x16_bf16(kf[4],qr[2],C0,0,0,0),   P1[2],P1[3],P1[4],P1[5],     pw2[0]=PKW(P1,0), pw2[1]=PKW(P1,2), pw2); \
    VRD(6); SBAR(); GAPA(C1=__builtin_amdgcn_mfma_f32_32x32x16_bf16(kf[5],qr[2],C1,0,0,0),   P1[6],P1[7],P1[8],P1[9],     pw2[2]=PKW(P1,4), pw2[3]=PKW(P1,6), pw2); \
    VRD(3); SBAR(); GAPA(C0=__builtin_amdgcn_mfma_f32_32x32x16_bf16(kf[6],qr[3],C0,0,0,0),   P1[10],P1[11],P1[12],P1[13], pw3[0]=PKW(P1,8), pw3[1]=PKW(P1,10), pw3); \
    VRD(7); SBAR(); GAPA(C1=__builtin_amdgcn_mfma_f32_32x32x16_bf16(kf[7],qr[3],C1,0,0,0),   P1[14],P1[15],0.f,0.f,       pw3[2]=PKW(P1,12),pw3[3]=PKW(P1,14), pw3); \
    if constexpr(NS==6){ C0=__builtin_amdgcn_mfma_f32_32x32x16_bf16(kf[8],qr[4],C0,0,0,0); C1=__builtin_amdgcn_mfma_f32_32x32x16_bf16(kf[9],qr[4],C1,0,0,0); \
      C0=__builtin_amdgcn_mfma_f32_32x32x16_bf16(kf[10],qr[5],C0,0,0,0); C1=__builtin_amdgcn_mfma_f32_32x32x16_bf16(kf[11],qr[5],C1,0,0,0); SBAR(); } \
    l_reg+=sacc; \
    if(GK){DMA_K((t)+3,sl_cur);} if(GV){DMA_V((t)+1,sl_next);} \
    CMASK(C0,C1,t); \
    SBAR(); \
    GAPB(o[0]=__builtin_amdgcn_mfma_f32_32x32x16_bf16(PAF(0),VFR(0),o[0],0,0,0), C0,0,0); \
    GAPB(o[1]=__builtin_amdgcn_mfma_f32_32x32x16_bf16(PAF(0),VFR(4),o[1],0,0,0), C0,4,0); \
    KRD(GL,0); GAPB(o[0]=__builtin_amdgcn_mfma_f32_32x32x16_bf16(PAF(1),VFR(1),o[0],0,0,0), C0,8,0); \
    KRD(GL,1); GAPB(o[1]=__builtin_amdgcn_mfma_f32_32x32x16_bf16(PAF(1),VFR(5),o[1],0,0,0), C0,12,0); \
    KRD(GL,2); GAPB(o[0]=__builtin_amdgcn_mfma_f32_32x32x16_bf16(PAF(2),VFR(2),o[0],0,0,0), C1,0,16); \
    KRD(GL,3); GAPB(o[1]=__builtin_amdgcn_mfma_f32_32x32x16_bf16(PAF(2),VFR(6),o[1],0,0,0), C1,4,16); \
    KRD6(GL,4); GAPB(o[0]=__builtin_amdgcn_mfma_f32_32x32x16_bf16(PAF(3),VFR(3),o[0],0,0,0), C1,8,16); \
    KRD6(GL,5); GAPB(o[1]=__builtin_amdgcn_mfma_f32_32x32x16_bf16(PAF(3),VFR(7),o[1],0,0,0), C1,12,16); \
    }while(0)
  int t=1;
  #undef CMASK
  #define CMASK(P0,P1,t) do{}while(0)
  for(;t+5<NT;t+=2){
    STEP(pB0,pB1,pA0,pA1,t,true,true,true);     WB2(); RESC(); ROT();
    STEP(pA0,pA1,pB0,pB1,t+1,true,true,true);   WB2(); RESC(); ROT();
  }
  #undef CMASK
  #define CMASK(P0,P1,t) do{int jb_=(t)-(NT-4); if(jb_>(wid>>1))allneg(P0,P1);}while(0)
  #define ENDW(tt) do{ if((tt)+3<NT){WB2();} else if((tt)+2<NT){WAIT_BAR(1);} else {WAIT_BAR(0);} }while(0)
  for(;t+1<NT;t+=2){
    STEP(pB0,pB1,pA0,pA1,t,(t+3<NT),(t+1<NT),(t+1<NT));       ENDW(t);   RESC(); ROT();
    STEP(pA0,pA1,pB0,pB1,t+1,(t+4<NT),(t+2<NT),(t+2<NT));     ENDW(t+1); RESC(); ROT();
  }
  STEP(pB0,pB1,pA0,pA1,NT-1,false,false,false); RESC();
  { float sacc=pB0[0]+pB0[1]; _Pragma("unroll") for(int r=2;r<16;++r)sacc+=pB0[r]; _Pragma("unroll") for(int r=0;r<16;++r)sacc+=pB1[r]; l_reg+=sacc;
    pw0=(u32x4){PKW(pB0,0),PKW(pB0,2),PKW(pB0,4),PKW(pB0,6)};pw1=(u32x4){PKW(pB0,8),PKW(pB0,10),PKW(pB0,12),PKW(pB0,14)};pw2=(u32x4){PKW(pB1,0),PKW(pB1,2),PKW(pB1,4),PKW(pB1,6)};pw3=(u32x4){PKW(pB1,8),PKW(pB1,10),PKW(pB1,12),PKW(pB1,14)};
    SBAR(); pv(o,vb0+sl_cur,PAF(0),PAF(1),PAF(2),PAF(3)); }
  #undef PKW
  #undef PAF
  #undef VFR
  #undef PIN
  #undef MX3
  #undef GAPA
  #undef GAPB
  #undef EX
  #undef VRD
  #undef KRD
  #undef KRD6
  #undef STEP
  #undef ENDW
  {auto rr=__builtin_amdgcn_permlane32_swap(__float_as_uint(l_reg),__float_as_uint(l_reg),false,false);l_reg=__uint_as_float(rr[0])+__uint_as_float(rr[1]);}
  if(hi==0)wsf[32+r32]=l_reg;asm volatile("s_waitcnt lgkmcnt(0)":::"memory");
  float rli[16];
  #pragma unroll
  for(int r=0;r<16;++r)rli[r]=__builtin_amdgcn_rcpf(wsf[32+crow(r,hi)]);
  bf16*Ow=a.O+(rowbase+q0+wid*QBLK)*1024+a.ocol+h*D;
  const bf16*Gw=a.G+(rowbase+q0+wid*QBLK)*(long)a.gpitch+h*D;
  { bf16*stg=(bf16*)(shm+LDS_OST)+wid*2048;
    #pragma unroll
    for(int r=0;r<16;++r){const int orow=crow(r,hi);
      #pragma unroll
      for(int d0=0;d0<2;++d0)stg[orow*64+d0*32+r32]=(bf16)f2bf(o[d0][r]*rli[r]);}
    asm volatile("s_waitcnt lgkmcnt(0)":::"memory");
    #pragma unroll
    for(int i=0;i<4;++i){const int row=i*8+(lane>>3),ch=lane&7; const u32x4 v=*(const u32x4*)(stg+row*64+ch*8);
      const u32x4 g=*(const u32x4*)(Gw+(long)row*a.gpitch+ch*8); u32x4 w;
      #pragma unroll
      for(int e=0;e<4;++e){ const float g0=bflo(g[e]),g1=bfhi(g[e]); const float s0=g0/(1.0f+__expf(-g0)),s1=g1/(1.0f+__expf(-g1)); w[e]=pk2(bflo(v[e])*s0,bfhi(v[e])*s1); }
      ATTN_STORE16(Ow+(long)row*1024+ch*8,w);} }
  asm volatile("s_waitcnt lgkmcnt(0)\n\ts_barrier":::"memory");
  #undef DMA_K
  #undef KS
  #undef WB2
  #undef DMA_V
  #undef CMASK
  #undef MKLOAD
  #undef MKZ
  #undef START
  #undef RESC
  #undef ROT
}
constexpr int ATTN_LDS_BYTES=LDS_BYTES;
#undef SBAR
#undef WAIT_BAR
}
#define XB_TMO      128
#define XB_XCNT(j)  (256  + 64 * (j))
#define XB_XSUB(j)  (1280 + 64 * (j))
#define XB_XGEN(j)  (2304 + 64 * (j))
#define XB_TOP      3328
#define XB_TOPGEN   3392
#define XCD_BAR_WORDS 3456
#define XB_SPIN_CAP (1u << 18)

__device__ __forceinline__ unsigned xb_ld(unsigned* p)              { return __hip_atomic_load(p, __ATOMIC_RELAXED, __HIP_MEMORY_SCOPE_AGENT); }
__device__ __forceinline__ unsigned xb_add(unsigned* p, unsigned v) { return __hip_atomic_fetch_add(p, v, __ATOMIC_RELAXED, __HIP_MEMORY_SCOPE_AGENT); }
__device__ __forceinline__ unsigned xb_xcc_id() { return (unsigned)__builtin_amdgcn_s_getreg((3 << 11) | 20) & 0xFu; }
#define XB_SPIN(cond, bar) do { unsigned _sp = 0; while (cond) { __builtin_amdgcn_s_sleep(1); \
    if ((++_sp & 255u) == 0u) { if (xb_ld(&(bar)[XB_TMO])) break; if (_sp > XB_SPIN_CAP) { atomicAdd(&(bar)[XB_TMO], 1u); break; } } } } while (0)

struct XcdBarrier {
    unsigned* bar; unsigned x;
    volatile LAS unsigned* st;
};

__device__ __forceinline__ XcdBarrier xcd_barrier_post(unsigned* bar, volatile LAS unsigned* st) {
    XcdBarrier b; b.bar = bar; b.x = xb_xcc_id(); b.st = st;
    if (threadIdx.x == 0) (void)xb_add(&bar[XB_XCNT(b.x)], 1u);
    return b;
}
__device__ __forceinline__ void xcd_barrier_complete(unsigned* bar, unsigned x, unsigned& nloc, unsigned& nx) {
    const unsigned G = gridDim.x * gridDim.y * gridDim.z;
    unsigned sum, cnt, mine, sp = 0u;
    for (;;) {
        sum = 0u; cnt = 0u; mine = 0u;
#pragma unroll
        for (unsigned j = 0; j < 16; ++j) { const unsigned c = xb_ld(&bar[XB_XCNT(j)]); sum += c; cnt += (c > 0u) ? 1u : 0u; mine = (j == x) ? c : mine; }
        if (sum == G) break;
        __builtin_amdgcn_s_sleep(1);
        if ((++sp & 255u) == 0u) { if (xb_ld(&bar[XB_TMO])) break; if (sp > XB_SPIN_CAP) { atomicAdd(&bar[XB_TMO], 1u); break; } }
    }
    nloc = mine > 0u ? mine : 1u; nx = cnt > 0u ? cnt : 1u;
}

__device__ __forceinline__ void xcd_barrier(const XcdBarrier& b) {
    asm volatile("s_waitcnt vmcnt(0)" ::: "memory");
    __syncthreads();
    if (threadIdx.x == 0) {
        unsigned* bar = b.bar;
        __builtin_amdgcn_s_waitcnt(0);
        unsigned nloc = b.st[0], nx = b.st[1];
        if (nloc == 0u) { xcd_barrier_complete(bar, b.x, nloc, nx); b.st[0] = nloc; b.st[1] = nx; }
        const unsigned old = xb_add(&bar[XB_XSUB(b.x)], 1u);
        const unsigned gen = old / nloc;
        if (old + 1u == (gen + 1u) * nloc) {
            __builtin_amdgcn_fence(__ATOMIC_RELEASE, "agent");
            asm volatile("s_waitcnt vmcnt(0)" ::: "memory");
            const unsigned og = xb_add(&bar[XB_TOP], 1u);
            const unsigned tg = og / nx;
            if (og + 1u == (tg + 1u) * nx) xb_add(&bar[XB_TOPGEN], 1u);
            else XB_SPIN(xb_ld(&bar[XB_TOPGEN]) == tg, bar);
            __builtin_amdgcn_fence(__ATOMIC_ACQUIRE, "agent");
            xb_add(&bar[XB_XGEN(b.x)], 1u);
            asm volatile("s_waitcnt vmcnt(0)" ::: "memory");
        } else {
            XB_SPIN(xb_ld(&bar[XB_XGEN(b.x)]) == gen, bar);
            __builtin_amdgcn_fence(__ATOMIC_ACQUIRE, "agent");
            asm volatile("s_waitcnt vmcnt(0)" ::: "memory");
        }
    }
    __syncthreads();
}

constexpr int NWAVES = 8;
constexpr int RING_BYTES = 131072;
constexpr int LDSCTL_OFF = RING_BYTES, MISC_OFF = LDSCTL_OFF + 320;
constexpr int LDS_BYTES = 147456;
constexpr int CW_BAR = 4096;
constexpr size_t CTL_ZERO_BYTES = 64 * 1024;
static_assert((CW_BAR + XCD_BAR_WORDS) * 4 <= (int)CTL_ZERO_BYTES, "barrier words inside the memset region");

struct MegaArgs { const float* in[12]; float* out; unsigned char* ws; };

__global__ void __launch_bounds__(NWAVES * 64, 2) mega_fwd(MegaArgs args) {
    extern __shared__ __attribute__((aligned(16))) unsigned char lds_raw[];
    LAS unsigned char* lds = (LAS unsigned char*)lds_raw;
    int tid = opaque_tid(), lane = tid & 63; const int wave = __builtin_amdgcn_readfirstlane(tid >> 6);
    const int G = gridDim.x, bx = blockIdx.x, vcu = (G % 8 == 0) ? (bx % 8) * (G / 8) + bx / 8 : bx;
    unsigned char* ws = args.ws;
    const float* x = args.in[0]; const float* norm_gain = args.in[1]; const float* w_in = args.in[2];
    const float* a_q_norm = args.in[3]; const float* a_k_norm = args.in[4]; const float* b_q_lat = args.in[5]; const float* b_kv_lat = args.in[6];
    const float* w_uq = args.in[7]; const float* w_ukv = args.in[8]; const float* b_q_norm = args.in[9]; const float* b_k_norm = args.in[10];
    const float* w_out = args.in[11];
    bf16* WIN = (bf16*)(ws + WS_WIN); bf16* WUQ = (bf16*)(ws + WS_WUQ); bf16* WUKV = (bf16*)(ws + WS_WUKV); bf16* WOUT = (bf16*)(ws + WS_WOUT);
    float* RC = (float*)(ws + WS_ROPE); float* RS = RC + SEQ * 32;
    bf16* XN = (bf16*)(ws + WS_XN); bf16* MIXED = (bf16*)(ws + WS_MIXED); bf16* PROJ = (bf16*)(ws + WS_PROJ);
    bf16* QB = (bf16*)(ws + WS_QB); bf16* KVR = (bf16*)(ws + WS_KVR); bf16* KB = (bf16*)(ws + WS_KB);
    unsigned long long* MASK = (unsigned long long*)(ws + WS_MASK);

    for (int u = tid; u < (LDS_BYTES - LDSCTL_OFF) / 4; u += NWAVES * 64) ((LAS unsigned*)(lds + LDSCTL_OFF))[u] = 0u;
    __syncthreads();
    XcdBarrier bar = xcd_barrier_post((unsigned*)(ws + WS_CTL) + CW_BAR, (volatile LAS unsigned*)(lds + MISC_OFF) + 8);

    const int gw = vcu * NWAVES + wave, NGW = G * NWAVES;

    for (int i = vcu * 512 + tid; i < SEQ * 32; i += G * 512) rope_table_elem(RC, RS, i);
    {
        constexpr int T_IN = (NP / 64) * 16, T_UQ = 12 * 6, T_UKV = 16 * 4, T_OUT = 16 * 16;
        LAS float* tile = (LAS float*)lds;
        for (int it = vcu; it < T_IN + T_UQ + T_UKV + T_OUT; it += G) {
            int r = it;
            if (r < T_IN) { wtrans_tile(tile, w_in, 1024, D_IN_OLD, WIN, (r % (NP / 64)) * 64, (r / (NP / 64)) * 64, true, tid); continue; } r -= T_IN;
            if (r < T_UQ) { wtrans_tile(tile, w_uq, 384, 768, WUQ, (r % 12) * 64, (r / 12) * 64, false, tid); continue; } r -= T_UQ;
            if (r < T_UKV) { wtrans_tile(tile, w_ukv, 256, 1024, WUKV, (r % 16) * 64, (r / 16) * 64, false, tid); continue; } r -= T_UKV;
            wtrans_tile(tile, w_out, 1024, 1024, WOUT, (r % 16) * 64, (r / 16) * 64, false, tid);
        }
    }
    for (int m = gw; m < MTOK; m += NGW) rmsnorm_x_row(x, norm_gain, XN, m, lane);
    xcd_barrier(bar);

    {
        pg8::Gemm g{XN, WIN, MTOK, NP, 1024, 1024}; pg8::StaticOrder S; S.init(MTOK, NP, G, bx);
        pg8::EpiBf16<0> E{PROJ, NP, nullptr, 0, 0, 1.f};
        pg8::gemm_phase<pg8::EpiBf16<0>, pg8::StaticOrder, true, true>(lds, g, S, E);
    }
    xcd_barrier(bar);

    tid = opaque_tid(); lane = tid & 63;
    for (int m = gw; m < MTOK; m += NGW) post_a_row(PROJ, a_q_norm, a_k_norm, b_q_lat, b_kv_lat, RC, RS, m, lane);
    xcd_barrier(bar);

    {
        pg8::Gemm g{PROJ + C_CQ, WUQ, MTOK, 768, 384, NP}; pg8::StaticOrder S; S.init(MTOK, 768, G, bx);
        pg8::EpiBf16<0> E{QB, 768, nullptr, 0, 0, 1.f};
        pg8::gemm_phase<pg8::EpiBf16<0>, pg8::StaticOrder, true, true>(lds, g, S, E);
    }
    {
        pg8::Gemm g{PROJ + C_CKV, WUKV, MTOK, 1024, 256, NP}; pg8::StaticOrder S; S.init(MTOK, 1024, G, bx);
        pg8::EpiBf16<0> E{KVR, 1024, nullptr, 0, 0, 1.f};
        pg8::gemm_phase<pg8::EpiBf16<0>, pg8::StaticOrder, true, true>(lds, g, S, E);
    }
    for (int p = vcu; p < 512; p += G) {
        const int b = p & 15, qq = p >> 4;
        indexer_unit(lds, PROJ, MASK, b, 63 - qq);
        indexer_unit(lds, PROJ, MASK, b, qq);
    }
    xcd_barrier(bar);

    tid = opaque_tid(); lane = tid & 63;
    for (int m = gw; m < MTOK; m += NGW) post_b_row(QB, KVR, PROJ, KB, b_q_norm, b_k_norm, RC, RS, m, lane);
    xcd_barrier(bar);

    {
        const AttnArgs aA{PROJ + C_QA, PROJ + C_KA, PROJ + C_VA, PROJ + C_GA, MIXED, MASK, NP, 64, NP, 64, NP, 64, NP, 0};
        const AttnArgs aB{QB, KB, KVR + 64, PROJ + C_GB, MIXED, nullptr, 768, 96, 768, 96, 1024, 128, NP, 512};
        for (int p = vcu; p < 512; p += G) {
            const int s = p & 3, h = (p >> 2) & 7, b = p >> 5;
            fa::attn_unit<8, true, 4>(b, h, 7 - s, aA, (char*)lds_raw);
            fa::attn_unit<8, true, 4>(b, h, s, aA, (char*)lds_raw);
            fa::attn_unit<8, false, 6>(b, h, 7 - s, aB, (char*)lds_raw);
            fa::attn_unit<8, false, 6>(b, h, s, aB, (char*)lds_raw);
        }
    }
    xcd_barrier(bar);

    {
        pg8::Gemm g{MIXED, WOUT, MTOK, 1024, 1024, 1024}; pg8::StaticOrder S; S.init(MTOK, 1024, G, bx);
        pg8::EpiResF32 E{x, args.out, 1024};
        pg8::gemm_phase<pg8::EpiResF32, pg8::StaticOrder, true, true>(lds, g, S, E);
    }
}

extern "C" void kernel_launch(void* const* d_in, const int* in_sizes, int n_in, void* d_out, int out_size, void* d_ws, size_t ws_size, hipStream_t stream) {
    static int grid = 0;
    if (grid == 0) {
        if (n_in != 12 || in_sizes[0] != MTOK * DMODEL || out_size != MTOK * DMODEL || ws_size < WS_END) {
            fprintf(stderr, "kernel_launch: unexpected shapes / workspace (n_in %d, in0 %d, out %d, ws %zu)\n", n_in, n_in > 0 ? in_sizes[0] : -1, out_size, ws_size); grid = -1; return; }
        int dev = 0, cus = 0, per_cu = 0;
        if (hipGetDevice(&dev) != hipSuccess || hipDeviceGetAttribute(&cus, hipDeviceAttributeMultiprocessorCount, dev) != hipSuccess) { grid = -1; return; }
        if (hipFuncSetAttribute((const void*)mega_fwd, hipFuncAttributeMaxDynamicSharedMemorySize, LDS_BYTES) != hipSuccess) { fprintf(stderr, "kernel_launch: hipFuncSetAttribute failed\n"); grid = -1; return; }
        if (hipOccupancyMaxActiveBlocksPerMultiprocessor(&per_cu, (const void*)mega_fwd, NWAVES * 64, LDS_BYTES) != hipSuccess || per_cu < 1) {
            fprintf(stderr, "kernel_launch: occupancy query says %d workgroups per CU\n", per_cu); (void)hipGetLastError(); grid = -1; return; }
        grid = cus;
    }
    if (grid < 0) return;
    (void)hipMemsetAsync((char*)d_ws + WS_CTL, 0, CTL_ZERO_BYTES, stream);
    MegaArgs a{};
    for (int i = 0; i < 12; ++i) a.in[i] = (const float*)d_in[i];
    a.out = (float*)d_out; a.ws = (unsigned char*)d_ws;
    hipLaunchKernelGGL(mega_fwd, dim3(grid), dim3(NWAVES * 64), LDS_BYTES, stream, a);
}
```

```cpp
#include <hip/hip_runtime.h>
#include <cstdint>
#include <cstdio>

constexpr int BATCH = 16, SEQ = 2048, DMODEL = 1024, MTOK = BATCH * SEQ;
constexpr int NP = 3840;
constexpr int C_QA = 0, C_KA = 512, C_VA = 1024, C_GA = 1536, C_QI = 2048, C_GB = 2560, C_CQ = 3072, C_CKV = 3456, C_KI = 3712, C_KR = 3776, C_WI = 3808;
constexpr int D_IN_OLD = 3816;
constexpr float RMS_EPS = 1e-6f;
constexpr float LOG2E = 1.4426950408889634f;
constexpr float C2A = 0.125f * LOG2E;
constexpr float C2B = 0.10206207261596575f * LOG2E;

constexpr size_t MiB = 1u << 20;
constexpr size_t WS_CTL = 0;
constexpr size_t WS_WIN = 2 * MiB;
constexpr size_t WS_WUQ = 10 * MiB;
constexpr size_t WS_WUKV = 11 * MiB;
constexpr size_t WS_WOUT = 12 * MiB;
constexpr size_t WS_ROPE = 14 * MiB;
constexpr size_t WS_GAINS = 15 * MiB;
constexpr size_t WS_XN = 16 * MiB;
constexpr size_t WS_MIXED = WS_XN;
constexpr size_t WS_PROJ = 80 * MiB;
constexpr size_t WS_QB = 320 * MiB;
constexpr size_t WS_VB = 368 * MiB;
constexpr size_t WS_SSQ = 400 * MiB;
constexpr size_t WS_KB = 432 * MiB;
constexpr size_t WS_MASK = 480 * MiB;
constexpr size_t WS_END = 488 * MiB;

typedef unsigned short bf16;
typedef short bf16x8_t __attribute__((ext_vector_type(8)));
typedef short s16x4_t __attribute__((ext_vector_type(4)));
typedef float f32x16_t __attribute__((ext_vector_type(16)));
typedef float f32x4_t __attribute__((ext_vector_type(4)));
typedef unsigned u32x4_t __attribute__((ext_vector_type(4)));
typedef unsigned u32x2_t __attribute__((ext_vector_type(2)));
#define LAS __attribute__((address_space(3)))

__device__ __forceinline__ unsigned f2bf(float f) { unsigned u = __builtin_bit_cast(unsigned, f); return (u + 0x7fffu + ((u >> 16) & 1u)) >> 16; }
__device__ __forceinline__ unsigned pk2(float lo, float hi) { return f2bf(lo) | (f2bf(hi) << 16); }
__device__ __forceinline__ float bflo(unsigned u) { return __builtin_bit_cast(float, u << 16); }
__device__ __forceinline__ float bfhi(unsigned u) { return __builtin_bit_cast(float, u & 0xffff0000u); }
__device__ __forceinline__ float bf2f(bf16 b) { return __builtin_bit_cast(float, (unsigned)b << 16); }
__device__ __forceinline__ int crow(int r, int hi) { return (r & 3) + 8 * (r >> 2) + 4 * hi; }

__device__ __forceinline__ int opaque_tid() { int t = (int)threadIdx.x; asm volatile("" : "+v"(t)); return t; }

namespace pg8 {
#define PG8_LAS __attribute__((address_space(3)))
typedef unsigned short bf16_t;
typedef short bf16x8 __attribute__((ext_vector_type(8)));
typedef float f32x4 __attribute__((ext_vector_type(4)));
typedef unsigned u32x4 __attribute__((ext_vector_type(4)));
constexpr int BM = 256, BK = 64, HALF = 128, HTB = HALF * BK * 2  , STAGE_BYTES = 8 * HTB, NXCD = 8, WGM = 8;

__host__ __device__ __forceinline__ int lds_byte(int r, int c) { const int st = (r >> 4) * 2 + (c >> 5), rr = r & 15, cc = c & 31, ob = rr * 64 + cc * 2; return st * 1024 + (ob ^ (((ob >> 9) & 1) << 5)); }
__host__ __device__ __forceinline__ void stage_rc(int b, int& R, int& C) { const int st = b / 1024, sb = b % 1024, swz = sb ^ (((sb >> 9) & 1) << 5); R = (st >> 1) * 16 + swz / 64; C = (st & 1) * 32 + (swz % 64) / 2; }
__host__ __device__ __forceinline__ int perm32(int rho) { const int n = rho >> 4, i = rho & 15; return 8 * (i >> 2) + 4 * n + (i & 3); }

struct Unit { int pm, pn; };
struct Gemm { const bf16_t* A; const bf16_t* Bt; int M, N, K, lda; };

struct StaticOrder {
    int nM, nN, nwg, G, c;
    __host__ __device__ void init(int M, int N, int G_, int c_) { nM = M / BM; nN = N / BM; nwg = nM * nN; G = G_; c = c_; }
    __host__ __device__ bool next(int i, Unit& u) const {
        const long L = (long)i * G + c; if (L >= nwg) return false;
        int wgid = (int)L; { const int q = nwg / NXCD, r = nwg % NXCD, xcd = wgid % NXCD, off = wgid / NXCD; wgid = (xcd < r ? xcd * (q + 1) : r * (q + 1) + (xcd - r) * q) + off; }
        const int nig = WGM * nN, gid = wgid / nig, fm = gid * WGM, gsz = (nM - fm) < WGM ? (nM - fm) : WGM;
        u.pm = fm + ((wgid % nig) % gsz); u.pn = (wgid % nig) / gsz; return true;
    }
    __device__ __forceinline__ void a_ready(const Unit&) const {}
    __device__ __forceinline__ void done(const Unit&) const {}
};

__device__ __forceinline__ unsigned cvt_pk_bf16(float lo, float hi) { unsigned r; asm volatile("v_cvt_pk_bf16_f32 %0, %1, %2" : "=v"(r) : "v"(lo), "v"(hi)); return r; }
typedef float f32x2 __attribute__((ext_vector_type(2)));
__device__ __forceinline__ f32x2 gelu_pk(f32x2 v) {
    const f32x2 av = __builtin_elementwise_abs(v), d = av * 0.2316418882f + 1.0f;
    f32x2 t; t.x = __builtin_amdgcn_rcpf(d.x); t.y = __builtin_amdgcn_rcpf(d.y);
    f32x2 q = t * 0.5307027145f + (-0.7265760135f); q = q * t + 0.7107068705f; q = q * t + (-0.142248368f); q = q * t + 0.127414796f; q = q * t;
    const f32x2 s = (v * v) * (-0.72134752044f);
    f32x2 e; e.x = __builtin_amdgcn_exp2f(s.x); e.y = __builtin_amdgcn_exp2f(s.y);
    const f32x2 m = v * (q * e), r = v - m;
    f32x2 o; o.x = v.x < 0.f ? m.x : r.x; o.y = v.y < 0.f ? m.y : r.y; return o;
}

template <int ACT  > struct EpiBf16 {
    static constexpr bool PERM = true, AFTER_DRAIN = false; static_assert(ACT == 0 || ACT == 1, "EpiBf16: ACT is 0 (none) or 1 (gelu_pk)");
    bf16_t* O; int ldc; const float* bias; int split_cols; size_t split_stride; float scale0;
    __device__ __forceinline__ void operator()(const f32x4 (&acc)[2][2][4][2], const Unit& u, int wr, int wc, int fr, int fq) const {
        const int row0 = u.pm * BM + wr * 64 + fr; int colt = u.pn * BM; bf16_t* base = O;
        float sc = 1.f; if (split_cols) { const int t = colt / split_cols; base += (size_t)t * split_stride; colt -= t * split_cols; if (t == 0) sc = scale0; }
        const int col0 = colt + wc * 32 + 8 * fq, bcol0 = u.pn * BM + wc * 32 + 8 * fq;
        f32x4 bv[2][2];
#pragma unroll
        for (int bj = 0; bj < 2; ++bj)
#pragma unroll
            for (int n = 0; n < 2; ++n) bv[bj][n] = bias ? *(const f32x4*)(bias + bcol0 + bj * HALF + 4 * n) : (f32x4){0.f, 0.f, 0.f, 0.f};
#pragma unroll
        for (int ai = 0; ai < 2; ++ai)
#pragma unroll
            for (int m = 0; m < 4; ++m) { bf16_t* rowp = base + (size_t)(row0 + ai * HALF + m * 16) * ldc + col0;
#pragma unroll
                for (int bj = 0; bj < 2; ++bj) { f32x4 v0 = acc[ai][bj][m][0] + bv[bj][0], v1 = acc[ai][bj][m][1] + bv[bj][1];
                    if (ACT == 1) { f32x2 a = gelu_pk((f32x2){v0[0], v0[1]}), b = gelu_pk((f32x2){v0[2], v0[3]}), c = gelu_pk((f32x2){v1[0], v1[1]}), d = gelu_pk((f32x2){v1[2], v1[3]});
                        v0 = (f32x4){a.x, a.y, b.x, b.y}; v1 = (f32x4){c.x, c.y, d.x, d.y}; }
                    v0 = v0 * sc; v1 = v1 * sc; u32x4 w; w.x = cvt_pk_bf16(v0[0], v0[1]); w.y = cvt_pk_bf16(v0[2], v0[3]); w.z = cvt_pk_bf16(v1[0], v1[1]); w.w = cvt_pk_bf16(v1[2], v1[3]);
                    *(u32x4*)(rowp + bj * HALF) = w; } }
    }
};
template <class Epi, class Sched, bool ALIGN_EPI = false, bool SP2 = false>
__device__ __forceinline__ void gemm_phase(PG8_LAS unsigned char* lds, const Gemm g, const Sched& S, const Epi& E) {
    const int tid = opaque_tid(), wid = __builtin_amdgcn_readfirstlane(tid >> 6), lane = tid & 63, wr = wid >> 2, wc = wid & 3, fr = lane & 15, fq = lane >> 4;
    int Kq = g.K, ldq = g.lda; asm volatile("" : "+s"(Kq), "+s"(ldq));
    const int K = Kq, nt = K / BK, lda = ldq;
    unsigned voffA[2], voffB[2];
#pragma unroll
    for (int i = 0; i < 2; ++i) { int R, C; stage_rc(tid * 16 + i * 8192, R, C); const int Rb = Epi::PERM ? ((R & ~31) + perm32(R & 31)) : R;
        voffA[i] = (unsigned)(R * lda + C) * 2u; voffB[i] = (unsigned)(Rb * K + C) * 2u; }
    const size_t kstep = (size_t)(BK * 2);
    const size_t hstepA = (size_t)HALF * lda * 2, hstepB = (size_t)HALF * K * 2;
    const size_t tstepA = 2 * hstepA, tstepB = 2 * hstepB;
    const unsigned ldsw = (unsigned)wid * 1024u;
    const int aoff = lds_byte(wr * 64 + fr, fq * 8), boff = lds_byte(wc * 32 + fr, fq * 8);
#define PG8_SA(b, h) (((b) * 2 + (h)) * HTB)
#define PG8_SB(b, h) ((4 + (b) * 2 + (h)) * HTB)
#define PG8_STAGE(bufoff, gbase, voff) do { _Pragma("unroll") for (int _i = 0; _i < 2; ++_i) \
        __builtin_amdgcn_global_load_lds((const unsigned*)((const char*)(gbase) + (voff)[_i]), (PG8_LAS unsigned*)(lds + (bufoff) + ldsw + _i * 8192), 16, 0, 0); } while (0)
#define PG8_LDA(dst, b, h) do { _Pragma("unroll") for (int m = 0; m < 4; ++m) _Pragma("unroll") for (int k = 0; k < 2; ++k) dst[m][k] = *(const PG8_LAS bf16x8*)(lds + PG8_SA(b, h) + aoff + m * 2048 + k * 1024); } while (0)
#define PG8_LDB(dst, b, h) do { _Pragma("unroll") for (int n = 0; n < 2; ++n) _Pragma("unroll") for (int k = 0; k < 2; ++k) dst[n][k] = *(const PG8_LAS bf16x8*)(lds + PG8_SB(b, h) + boff + n * 2048 + k * 1024); } while (0)
#define PG8_MMA(ai, bj, At, Bt) do { __builtin_amdgcn_s_setprio(1); _Pragma("unroll") for (int m = 0; m < 4; ++m) _Pragma("unroll") for (int n = 0; n < 2; ++n) _Pragma("unroll") for (int k = 0; k < 2; ++k) \
        acc[ai][bj][m][n] = __builtin_amdgcn_mfma_f32_16x16x32_bf16(Bt[n][k], At[m][k], acc[ai][bj][m][n], 0, 0, 0); __builtin_amdgcn_s_setprio(0); } while (0)
#define PG8_WAIT_V(n) asm volatile("s_waitcnt vmcnt(" #n ")" ::: "memory")
#define PG8_WAIT_L(n) asm volatile("s_waitcnt lgkmcnt(" #n ")" ::: "memory")
#define PG8_BAR __builtin_amdgcn_s_barrier()
#define PG8_SCHED __builtin_amdgcn_sched_barrier(0)
    Unit cur, nxt; int ui = 0;
    if (!S.next(0, cur)) return;
    f32x4 acc[2][2][4][2];
#pragma unroll
    for (int a = 0; a < 2; ++a)
#pragma unroll
        for (int b = 0; b < 2; ++b)
#pragma unroll
            for (int m = 0; m < 4; ++m)
#pragma unroll
                for (int n = 0; n < 2; ++n) acc[a][b][m][n] = (f32x4){0.f, 0.f, 0.f, 0.f};
    bf16x8 At[4][2], B0[2][2], B1[2][2];
    const char* cA = (const char*)g.A + (size_t)cur.pm * tstepA; const char* cB = (const char*)g.Bt + (size_t)cur.pn * tstepB;
    S.a_ready(cur);
    if constexpr (SP2) {
        PG8_STAGE(PG8_SB(0, 0), cB, voffB); PG8_STAGE(PG8_SB(0, 1), cB + hstepB, voffB); PG8_STAGE(PG8_SA(0, 0), cA, voffA); PG8_STAGE(PG8_SA(0, 1), cA + hstepA, voffA);
        if (wr == 1) PG8_BAR;
        PG8_WAIT_V(2); PG8_BAR;
        PG8_STAGE(PG8_SB(1, 0), cB + kstep, voffB); PG8_STAGE(PG8_SA(1, 0), cA + kstep, voffA); PG8_STAGE(PG8_SB(1, 1), cB + hstepB + kstep, voffB);
        PG8_WAIT_V(6); PG8_BAR;
    } else {
        PG8_STAGE(PG8_SB(0, 0), cB, voffB); PG8_STAGE(PG8_SA(0, 0), cA, voffA); PG8_STAGE(PG8_SB(0, 1), cB + hstepB, voffB); PG8_STAGE(PG8_SA(0, 1), cA + hstepA, voffA);
        if (wr == 1) PG8_BAR;
        PG8_WAIT_V(4); PG8_BAR;
        PG8_STAGE(PG8_SB(1, 0), cB + kstep, voffB); PG8_STAGE(PG8_SA(1, 0), cA + kstep, voffA); PG8_STAGE(PG8_SB(1, 1), cB + hstepB + kstep, voffB);
        PG8_WAIT_V(6); PG8_BAR;
    }
    for (;;) {
        const bool has_next = S.next(ui + 1, nxt);
        const char* nA = has_next ? (const char*)g.A + (size_t)nxt.pm * tstepA : cA; const char* nB = has_next ? (const char*)g.Bt + (size_t)nxt.pn * tstepB : cB;
        for (int t = 0; t < nt; t += 2) {
            const bool last = (t == nt - 2);
            const char* a1 = cA + (size_t)(t + 1) * kstep;
            const char* a2 = last ? nA : cA + (size_t)(t + 2) * kstep; const char* b2 = last ? nB : cB + (size_t)(t + 2) * kstep;
            const char* a3 = a2 + kstep; const char* b3 = b2 + kstep;
            if (last && has_next) S.a_ready(nxt);
            if constexpr (SP2) {
            PG8_LDB(B0, 0, 0); PG8_LDB(B1, 0, 1); PG8_SCHED; PG8_LDA(At, 0, 0); PG8_STAGE(PG8_SA(1, 1), a1 + hstepA, voffA);
            PG8_WAIT_V(8); PG8_WAIT_L(0); PG8_BAR; PG8_MMA(0, 0, At, B0); PG8_MMA(0, 1, At, B1); PG8_BAR; PG8_SCHED;
            PG8_LDA(At, 0, 1); PG8_STAGE(PG8_SB(0, 0), b2, voffB); PG8_STAGE(PG8_SB(0, 1), b2 + hstepB, voffB); PG8_STAGE(PG8_SA(0, 0), a2, voffA);
            PG8_WAIT_V(8); PG8_WAIT_L(0); PG8_BAR; PG8_MMA(1, 0, At, B0); PG8_MMA(1, 1, At, B1); PG8_BAR; PG8_SCHED;
            PG8_LDB(B0, 1, 0); PG8_LDB(B1, 1, 1); PG8_SCHED; PG8_LDA(At, 1, 0); PG8_STAGE(PG8_SA(0, 1), a2 + hstepA, voffA);
            PG8_WAIT_V(8); PG8_WAIT_L(0); PG8_BAR; PG8_MMA(0, 0, At, B0); PG8_MMA(0, 1, At, B1); PG8_BAR; PG8_SCHED;
            PG8_LDA(At, 1, 1); PG8_STAGE(PG8_SB(1, 0), b3, voffB); PG8_STAGE(PG8_SB(1, 1), b3 + hstepB, voffB); PG8_STAGE(PG8_SA(1, 0), a3, voffA);
            PG8_WAIT_V(8); PG8_WAIT_L(0); PG8_BAR; PG8_MMA(1, 0, At, B0); PG8_MMA(1, 1, At, B1); PG8_BAR; PG8_SCHED;
            } else {
            PG8_LDB(B0, 0, 0); PG8_SCHED; PG8_LDA(At, 0, 0); PG8_STAGE(PG8_SA(1, 1), a1 + hstepA, voffA);
            PG8_WAIT_L(8); PG8_BAR; PG8_WAIT_L(0); PG8_MMA(0, 0, At, B0); PG8_BAR; PG8_SCHED;
            PG8_LDB(B1, 0, 1); PG8_STAGE(PG8_SB(0, 0), b2, voffB);
            PG8_BAR; PG8_WAIT_L(0); PG8_MMA(0, 1, At, B1); PG8_BAR;
            PG8_LDA(At, 0, 1); PG8_STAGE(PG8_SA(0, 0), a2, voffA);
            PG8_BAR; PG8_WAIT_L(0); PG8_MMA(1, 0, At, B0); PG8_BAR; PG8_SCHED;
            PG8_STAGE(PG8_SB(0, 1), b2 + hstepB, voffB);
            PG8_WAIT_V(6); PG8_BAR; PG8_MMA(1, 1, At, B1); PG8_BAR;
            PG8_LDB(B0, 1, 0); PG8_SCHED; PG8_LDA(At, 1, 0); PG8_STAGE(PG8_SA(0, 1), a2 + hstepA, voffA);
            PG8_WAIT_L(8); PG8_BAR; PG8_WAIT_L(0); PG8_MMA(0, 0, At, B0); PG8_BAR; PG8_SCHED;
            PG8_LDB(B1, 1, 1); PG8_STAGE(PG8_SB(1, 0), b3, voffB);
            PG8_BAR; PG8_WAIT_L(0); PG8_MMA(0, 1, At, B1); PG8_BAR;
            PG8_LDA(At, 1, 1); PG8_STAGE(PG8_SA(1, 0), a3, voffA);
            PG8_BAR; PG8_WAIT_L(0); PG8_MMA(1, 0, At, B0); PG8_BAR; PG8_SCHED;
            PG8_STAGE(PG8_SB(1, 1), b3 + hstepB, voffB);
            PG8_WAIT_V(6); PG8_BAR; PG8_MMA(1, 1, At, B1); PG8_BAR;
            }
        }
        if constexpr (ALIGN_EPI) { if (wr == 0) PG8_BAR; }
        if constexpr (!Epi::AFTER_DRAIN) { E(acc, cur, wr, wc, fr, fq); S.done(cur); }
        if (!has_next) break;
#pragma unroll
        for (int a = 0; a < 2; ++a)
#pragma unroll
            for (int b = 0; b < 2; ++b)
#pragma unroll
                for (int m = 0; m < 4; ++m)
#pragma unroll
                    for (int n = 0; n < 2; ++n) acc[a][b][m][n] = (f32x4){0.f, 0.f, 0.f, 0.f};
        cur = nxt; cA = nA; cB = nB; ++ui;
        if constexpr (ALIGN_EPI) { if (wr == 1) PG8_BAR; }
    }
    PG8_WAIT_V(0);
    if constexpr (!ALIGN_EPI) { if (wr == 0) PG8_BAR; }
    PG8_BAR;
    if constexpr (Epi::AFTER_DRAIN) { E.fused(acc, cur, wr, wc, fr, fq, lds, wid, lane); S.done(cur); }
#undef PG8_SA
#undef PG8_SB
#undef PG8_STAGE
#undef PG8_LDA
#undef PG8_LDB
#undef PG8_MMA
#undef PG8_WAIT_V
#undef PG8_WAIT_L
#undef PG8_BAR
#undef PG8_SCHED
}
}

#ifndef PG8_SP2
#define PG8_SP2 true
#endif
#ifndef PG8_ALIGN
#define PG8_ALIGN true
#endif

namespace pg8 {
struct EpiResF32 {
    static constexpr bool PERM = false, AFTER_DRAIN = false;
    const float* base; float* out; int ldc;
    __device__ __forceinline__ void operator()(const f32x4 (&acc)[2][2][4][2], const Unit& u, int wr, int wc, int fr, int fq) const {
        const int col0 = u.pn * BM + wc * 32 + 4 * fq;
#pragma unroll
        for (int ai = 0; ai < 2; ++ai)
#pragma unroll
            for (int m = 0; m < 4; ++m) { const size_t off = (size_t)(u.pm * BM + ai * HALF + wr * 64 + m * 16 + fr) * ldc + col0;
#pragma unroll
                for (int bj = 0; bj < 2; ++bj)
#pragma unroll
                    for (int n = 0; n < 2; ++n) { const f32x4 b = *(const f32x4*)(base + off + bj * HALF + n * 16); *(f32x4*)(out + off + bj * HALF + n * 16) = b + acc[ai][bj][m][n]; } }
    }
};
}

constexpr int GEMM_LDS = pg8::STAGE_BYTES;

__device__ __forceinline__ void rope_table_elem(float* ct, float* st, int idx) {
    const int pos = idx >> 5, j = idx & 31;
    const float freq = exp2f(-(float)j * (13.287712379549449f / 32.0f));
    const float ang = (float)pos * freq;
    double rev = (double)ang * 0.15915494309189535;
    rev -= floor(rev);
    const float fr = (float)rev;
    ct[idx] = __builtin_amdgcn_cosf(fr);
    st[idx] = __builtin_amdgcn_sinf(fr);
}

__device__ __forceinline__ int win_src_col(int n) {
    if (n < 2560) return n;
    if (n < 3072) return n - 2560 + 3304;
    if (n < 3456) return n - 3072 + 2632;
    if (n < 3712) return n - 3456 + 3016;
    if (n < 3776) return n - 3712 + 2560;
    if (n < 3808) return n - 3776 + 3272;
    if (n < 3816) return n - 3808 + 2624;
    return -1;
}
__device__ __forceinline__ int win_phys2src(int n) {
    const int tile = n >> 8, p = n & 255, bj = p >> 7, wcc = (p >> 5) & 3, i = p & 31;
    const int pairdim = 16 * ((i >> 2) & 1) + 4 * (i >> 3) + (i & 3);
    int logical = n;
    if (tile < 4) logical = ((tile < 2) ? C_QA : C_KA) + 64 * (4 * (tile & 1) + wcc) + 32 * bj + i;
    else if (tile == 8 || tile == 9) logical = C_QI + 64 * (4 * (tile - 8) + wcc) + (bj ? 32 + i : pairdim);
    else if (tile == 14 && bj == 1 && wcc == 0) logical = C_KI + pairdim;
    return win_src_col(logical);
}
__device__ __forceinline__ int wukv_phys2src(int n) {
    const int t = n >> 8, p = n & 255, bj = p >> 7, wcc = (p >> 5) & 3, i = p & 31;
    return 128 * (2 * t + (wcc >> 1)) + 64 * (wcc & 1) + 32 * bj + i;
}
__device__ __forceinline__ void wtrans_tile(LAS float* t, const float* __restrict__ W, int K, int Nold, bf16* __restrict__ WT, int n0, int k0, int mode, const float* __restrict__ gain, int tid) {
    __syncthreads();
    for (int i = tid; i < 4096; i += 512) { const int kk = i >> 6, nn = i & 63; const int n = n0 + nn; const int src = (mode == 1) ? win_phys2src(n) : (mode == 2) ? wukv_phys2src(n) : n;
        float v = (src >= 0) ? W[(size_t)(k0 + kk) * Nold + src] : 0.f; if (gain) v *= gain[k0 + kk];
        t[kk * 65 + nn] = v; }
    __syncthreads();
    for (int i = tid; i < 4096; i += 512) { const int nn = i >> 6, kk = i & 63; WT[(size_t)(n0 + nn) * K + k0 + kk] = (bf16)f2bf(t[kk * 65 + nn]); }
}

__device__ __forceinline__ float wave_sum(float v) {
#pragma unroll
    for (int o = 1; o < 64; o <<= 1) v += __shfl_xor(v, o);
    return v;
}
__device__ __forceinline__ void rmsnorm_x_row(const float* __restrict__ x, const float* __restrict__ g, bf16* __restrict__ xn, int row, int lane) {
    const f32x4_t* xr = (const f32x4_t*)(x + (size_t)row * DMODEL) + lane;
    const f32x4_t* gr = (const f32x4_t*)g + lane;
    f32x4_t v[4]; float s = 0.f;
#pragma unroll
    for (int j = 0; j < 4; ++j) { v[j] = xr[64 * j]; s += (v[j].x * v[j].x + v[j].y * v[j].y) + (v[j].z * v[j].z + v[j].w * v[j].w); }
    const float rs = 1.0f / sqrtf(wave_sum(s) * (1.0f / DMODEL) + RMS_EPS);
    u32x2_t* o = (u32x2_t*)(xn + (size_t)row * DMODEL) + lane;
#pragma unroll
    for (int j = 0; j < 4; ++j) { const f32x4_t gg = gr[64 * j]; u32x2_t w; w.x = pk2(v[j].x * rs * gg.x, v[j].y * rs * gg.y); w.y = pk2(v[j].z * rs * gg.z, v[j].w * rs * gg.w); o[64 * j] = w; }
}


namespace pg8 {
__device__ __forceinline__ float silu_f(float g) { return g / (1.0f + __expf(-g)); }
__device__ __forceinline__ float dot4(const f32x4 a) { return (a[0] * a[0] + a[1] * a[1]) + (a[2] * a[2] + a[3] * a[3]); }
__device__ __forceinline__ u32x4 pack8(const f32x4 a, const f32x4 b) { u32x4 w; w.x = cvt_pk_bf16(a[0], a[1]); w.y = cvt_pk_bf16(a[2], a[3]); w.z = cvt_pk_bf16(b[0], b[1]); w.w = cvt_pk_bf16(b[2], b[3]); return w; }
typedef unsigned u32x2 __attribute__((ext_vector_type(2)));
__device__ __forceinline__ u32x2 pack4(const f32x4 a) { u32x2 w; w.x = cvt_pk_bf16(a[0], a[1]); w.y = cvt_pk_bf16(a[2], a[3]); return w; }

struct EpiProj {
    static constexpr bool PERM = true, AFTER_DRAIN = false;
    bf16_t* P; float* ssq; const float* aq_g; const float* ak_g; const float* rc; const float* rs;
    __device__ __forceinline__ void operator()(const f32x4 (&acc)[2][2][4][2], const Unit& u, int wr, int wc, int fr, int fq) const {
        asm volatile("" : "+v"(fr), "+v"(fq));
        const int tile = u.pn; const int row0 = u.pm * BM + wr * 64 + fr;
        if (tile < 4) {
            const bool isk = tile >= 2; const float* g = isk ? ak_g : aq_g; const float sc = isk ? 1.0f : C2A;
            const int colbase = (isk ? C_KA : C_QA) + 64 * (4 * (tile & 1) + wc) + 8 * fq;
            const f32x4 g1a = *(const f32x4*)(g + 8 * fq), g1b = *(const f32x4*)(g + 8 * fq + 4), g2a = *(const f32x4*)(g + 32 + 8 * fq), g2b = *(const f32x4*)(g + 36 + 8 * fq);
#pragma unroll
            for (int ai = 0; ai < 2; ++ai)
#pragma unroll
                for (int m = 0; m < 4; ++m) {
                    const int row = row0 + ai * HALF + m * 16, pos = row & (SEQ - 1);
                    const f32x4 x1a = acc[ai][0][m][0], x1b = acc[ai][0][m][1], x2a = acc[ai][1][m][0], x2b = acc[ai][1][m][1];
                    float ss = (dot4(x1a) + dot4(x1b)) + (dot4(x2a) + dot4(x2b));
                    ss += __shfl_xor(ss, 16); ss += __shfl_xor(ss, 32);
                    const float rn = sc / sqrtf(ss * (1.0f / 64.0f) + RMS_EPS);
                    const float* cp = rc + pos * 32 + 8 * fq; const float* sp = rs + pos * 32 + 8 * fq;
                    const f32x4 ca = *(const f32x4*)cp, cb = *(const f32x4*)(cp + 4), sa = *(const f32x4*)sp, sb = *(const f32x4*)(sp + 4);
                    const f32x4 a0 = x1a * rn * g1a, a1 = x1b * rn * g1b, b0 = x2a * rn * g2a, b1 = x2b * rn * g2b;
                    bf16_t* dst = P + (size_t)row * NP + colbase;
                    *(u32x4*)dst = pack8(a0 * ca - b0 * sa, a1 * cb - b1 * sb);
                    *(u32x4*)(dst + 32) = pack8(b0 * ca + a0 * sa, b1 * cb + a1 * sb);
                }
        } else if (tile == 8 || tile == 9) {
            const int colbase = C_QI + 64 * (4 * (tile - 8) + wc);
#pragma unroll
            for (int ai = 0; ai < 2; ++ai)
#pragma unroll
                for (int m = 0; m < 4; ++m) {
                    const int row = row0 + ai * HALF + m * 16, pos = row & (SEQ - 1);
                    const float* cp = rc + pos * 32 + 8 * fq; const float* sp = rs + pos * 32 + 8 * fq;
                    const f32x4 c0 = *(const f32x4*)cp, c1 = *(const f32x4*)(cp + 4), s0 = *(const f32x4*)sp, s1 = *(const f32x4*)(sp + 4);
                    const f32x4 c = (f32x4){c0[0], c0[2], c1[0], c1[2]}, s = (f32x4){s0[0], s0[2], s1[0], s1[2]};
                    const f32x4 x1 = acc[ai][0][m][0], x2 = acc[ai][0][m][1];
                    bf16_t* dst = P + (size_t)row * NP + colbase;
                    *(u32x2*)(dst + 4 * fq) = pack4(x1 * c - x2 * s);
                    *(u32x2*)(dst + 16 + 4 * fq) = pack4(x2 * c + x1 * s);
                    *(u32x4*)(dst + 32 + 8 * fq) = pack8(acc[ai][1][m][0], acc[ai][1][m][1]);
                }
        } else if (tile == 14) {
#pragma unroll
            for (int ai = 0; ai < 2; ++ai)
#pragma unroll
                for (int m = 0; m < 4; ++m) {
                    const int row = row0 + ai * HALF + m * 16, pos = row & (SEQ - 1);
                    bf16_t* dst = P + (size_t)row * NP + tile * BM;
                    float ss = dot4(acc[ai][0][m][0]) + dot4(acc[ai][0][m][1]);
                    ss += __shfl_xor(ss, 16); ss += __shfl_xor(ss, 32);
                    if (fq == 0) ssq[(size_t)row * 24 + 16 + wc] = ss;
                    *(u32x4*)(dst + 32 * wc + 8 * fq) = pack8(acc[ai][0][m][0], acc[ai][0][m][1]);
                    if (wc == 0) {
                        const float* cp = rc + pos * 32 + 8 * fq; const float* sp = rs + pos * 32 + 8 * fq;
                        const f32x4 c0 = *(const f32x4*)cp, c1 = *(const f32x4*)(cp + 4), s0 = *(const f32x4*)sp, s1 = *(const f32x4*)(sp + 4);
                        const f32x4 c = (f32x4){c0[0], c0[2], c1[0], c1[2]}, s = (f32x4){s0[0], s0[2], s1[0], s1[2]};
                        const f32x4 x1 = acc[ai][1][m][0], x2 = acc[ai][1][m][1];
                        *(u32x2*)(dst + HALF + 4 * fq) = pack4(x1 * c - x2 * s);
                        *(u32x2*)(dst + HALF + 16 + 4 * fq) = pack4(x2 * c + x1 * s);
                    } else {
                        *(u32x4*)(dst + HALF + 32 * wc + 8 * fq) = pack8(acc[ai][1][m][0], acc[ai][1][m][1]);
                    }
                }
        } else {
            const bool gate = (tile == 6 || tile == 7 || tile == 10 || tile == 11), lat = (tile >= 12);
#pragma unroll
            for (int ai = 0; ai < 2; ++ai)
#pragma unroll
                for (int m = 0; m < 4; ++m) {
                    const int row = row0 + ai * HALF + m * 16;
                    bf16_t* dst = P + (size_t)row * NP + tile * BM + 32 * wc + 8 * fq;
#pragma unroll
                    for (int bj = 0; bj < 2; ++bj) {
                        f32x4 v0 = acc[ai][bj][m][0], v1 = acc[ai][bj][m][1];
                        if (lat) { float ss = dot4(v0) + dot4(v1); ss += __shfl_xor(ss, 16); ss += __shfl_xor(ss, 32);
                            if (fq == 0) ssq[(size_t)row * 24 + (tile == 12 ? 4 * bj : 8 + 4 * bj) + wc] = ss; }
                        if (gate) { v0 = (f32x4){silu_f(v0[0]), silu_f(v0[1]), silu_f(v0[2]), silu_f(v0[3])}; v1 = (f32x4){silu_f(v1[0]), silu_f(v1[1]), silu_f(v1[2]), silu_f(v1[3])}; }
                        *(u32x4*)(dst + bj * HALF) = pack8(v0, v1);
                    }
                }
        }
    }
};

struct EpiKV {
    static constexpr bool PERM = true, AFTER_DRAIN = false;
    bf16_t* KB; bf16_t* VB; const bf16_t* P; const float* ssq; const float* bk_g; const float* rc; const float* rs;
    __device__ __forceinline__ float row_rkv(int row) const {
        const f32x4 q0 = *(const f32x4*)(ssq + (size_t)row * 24 + 12), q1 = *(const f32x4*)(ssq + (size_t)row * 24 + 16);
        return 1.0f / sqrtf((((q0[0] + q0[1]) + (q0[2] + q0[3])) + ((q1[0] + q1[1]) + (q1[2] + q1[3]))) * (1.0f / 256.0f) + RMS_EPS);
    }
    __device__ __forceinline__ void operator()(const f32x4 (&acc)[2][2][4][2], const Unit& u, int wr, int wc, int fr, int fq) const {
        asm volatile("" : "+v"(fr), "+v"(fq));
        const int head = 2 * u.pn + (wc >> 1); const int row0 = u.pm * BM + wr * 64 + fr;
        if (wc & 1) {
#pragma unroll
            for (int ai = 0; ai < 2; ++ai)
#pragma unroll
                for (int m = 0; m < 4; ++m) {
                    const int row = row0 + ai * HALF + m * 16;
                    const float rkv = row_rkv(row);
                    bf16_t* dst = VB + (size_t)row * 512 + 64 * head + 8 * fq;
#pragma unroll
                    for (int bj = 0; bj < 2; ++bj) *(u32x4*)(dst + 32 * bj) = pack8(acc[ai][bj][m][0] * rkv, acc[ai][bj][m][1] * rkv);
                    asm volatile("" ::: "memory");
                }
        } else {
#pragma unroll
            for (int ai = 0; ai < 2; ++ai)
#pragma unroll
                for (int m = 0; m < 4; ++m) {
                    const int row = row0 + ai * HALF + m * 16, pos = row & (SEQ - 1);
                    const float rkv = row_rkv(row);
                    const u32x2 k1 = *(const u32x2*)(P + (size_t)row * NP + C_KR + 4 * fq), k2 = *(const u32x2*)(P + (size_t)row * NP + C_KR + 16 + 4 * fq);
                    const f32x4 x1 = (f32x4){bflo(k1.x), bfhi(k1.x), bflo(k1.y), bfhi(k1.y)}, x2 = (f32x4){bflo(k2.x), bfhi(k2.x), bflo(k2.y), bfhi(k2.y)};
                    float ssn = (dot4(acc[ai][0][m][0]) + dot4(acc[ai][0][m][1])) + (dot4(acc[ai][1][m][0]) + dot4(acc[ai][1][m][1]));
                    float ssr = dot4(x1) + dot4(x2);
                    ssn += __shfl_xor(ssn, 16); ssn += __shfl_xor(ssn, 32); ssr += __shfl_xor(ssr, 16); ssr += __shfl_xor(ssr, 32);
                    const float rk = 1.0f / sqrtf((ssn * rkv * rkv + ssr) * (1.0f / 96.0f) + RMS_EPS);
                    bf16_t* dst = KB + (size_t)row * 768 + 96 * head;
                    const float sn = rkv * rk;
#pragma unroll
                    for (int bj = 0; bj < 2; ++bj) { const f32x4 g0 = *(const f32x4*)(bk_g + 32 * bj + 8 * fq), g1 = *(const f32x4*)(bk_g + 32 * bj + 8 * fq + 4);
                        *(u32x4*)(dst + 32 * bj + 8 * fq) = pack8(acc[ai][bj][m][0] * sn * g0, acc[ai][bj][m][1] * sn * g1); }
                    const f32x4 gr1 = *(const f32x4*)(bk_g + 64 + 4 * fq), gr2 = *(const f32x4*)(bk_g + 80 + 4 * fq);
                    const float* cp = rc + pos * 32 + 8 * fq; const float* sp = rs + pos * 32 + 8 * fq;
                    const f32x4 c0 = *(const f32x4*)cp, c1 = *(const f32x4*)(cp + 4), s0 = *(const f32x4*)sp, s1 = *(const f32x4*)(sp + 4);
                    const f32x4 c = (f32x4){c0[0], c0[2], c1[0], c1[2]}, s = (f32x4){s0[0], s0[2], s1[0], s1[2]};
                    const f32x4 a = x1 * rk * gr1, b = x2 * rk * gr2;
                    *(u32x2*)(dst + 64 + 4 * fq) = pack4(a * c - b * s);
                    *(u32x2*)(dst + 80 + 4 * fq) = pack4(b * c + a * s);
                    asm volatile("" ::: "memory");
                }
        }
    }
};
}

constexpr int IDX_QPITCH = 1040;
constexpr int IDX_LDS = 32 * IDX_QPITCH + 2 * 8 * 32 * 4 + 8 * 32 * 4;
constexpr int TOPK = 256;

__device__ __forceinline__ unsigned sortable_key(float x) { const unsigned u = __builtin_bit_cast(unsigned, x + 0.0f); return (u & 0x80000000u) ? ~u : (u | 0x80000000u); }

__device__ __forceinline__ void indexer_unit(LAS unsigned char* lds, const bf16* __restrict__ proj, unsigned long long* __restrict__ mask, int b, int qb) {
    const int tid = opaque_tid(), lane = tid & 63, w = __builtin_amdgcn_readfirstlane(tid >> 6), r32 = lane & 31, hi = lane >> 5;
    const int L = 64 * ((qb >> 1) + 1), nt32 = L >> 5;
    const int nloc = (nt32 - w + 7) >> 3;
    unsigned long long* mbase = mask + ((size_t)(b * 64 + qb) * 64) * 16;
    if (L <= TOPK) {
        for (int i = 0; i < nloc; ++i) { const int j = w + 8 * i; if (lane < 16) mbase[(size_t)j * 16 + lane] = ~0ull; }
        return;
    }
    const size_t row0 = (size_t)b * SEQ + 32 * qb;
    __syncthreads();
    for (int c = tid; c < 32 * 64; c += 512) { const int r = c >> 6, ch = c & 63;
        *(LAS u32x4_t*)(lds + r * IDX_QPITCH + ch * 16) = *(const u32x4_t*)(proj + (row0 + r) * NP + C_QI + ch * 8); }
    LAS float* wl = (LAS float*)(lds + 32 * IDX_QPITCH + 2048);
    if (tid < 256) { const int q = tid & 31, hh = tid >> 5; wl[hh * 32 + q] = bf2f(proj[(row0 + q) * NP + C_WI + hh]); }
    __syncthreads();
    unsigned key[8][16];
    const LAS unsigned char* qrow = lds + r32 * IDX_QPITCH + hi * 16;
#pragma unroll
    for (int i = 0; i < 8; ++i) {
        if (i < nloc) {
            const int j = w + 8 * i;
            const bf16* kp = proj + ((size_t)b * SEQ + 32 * j + r32) * NP + C_KI + 8 * hi;
            bf16x8_t kf[4];
#pragma unroll
            for (int s = 0; s < 4; ++s) kf[s] = *(const bf16x8_t*)(kp + 16 * s);
            f32x16_t tot;
#pragma unroll
            for (int r = 0; r < 16; ++r) tot[r] = 0.f;
#pragma unroll 1
            for (int h = 0; h < 8; ++h) {
                const float wh = wl[h * 32 + r32];
                f32x16_t acc;
#pragma unroll
                for (int r = 0; r < 16; ++r) acc[r] = 0.f;
#pragma unroll
                for (int s = 0; s < 4; ++s) { const bf16x8_t qf = *(const LAS bf16x8_t*)(qrow + (64 * h + 16 * s) * 2); acc = __builtin_amdgcn_mfma_f32_32x32x16_bf16(kf[s], qf, acc, 0, 0, 0); }
#pragma unroll
                for (int r = 0; r < 16; ++r) tot[r] = fmaf(wh, fmaxf(acc[r], 0.f), tot[r]);
            }
#pragma unroll
            for (int r = 0; r < 16; ++r) key[i][r] = sortable_key(tot[r]);
            __builtin_amdgcn_sched_barrier(0);
        } else {
#pragma unroll
            for (int r = 0; r < 16; ++r) key[i][r] = 0u;
        }
    }
    LAS int* cnts = (LAS int*)(lds + 32 * IDX_QPITCH);
    int step = 0;
#define IDX_REDUCE(cntvar, totvar) do { int c_ = (cntvar); c_ += __shfl_xor(c_, 32); const int buf_ = (step & 1) * 256; ++step; \
        if (lane < 32) cnts[buf_ + w * 32 + lane] = c_; __syncthreads(); int t_ = 0; _Pragma("unroll") for (int ww = 0; ww < 8; ++ww) t_ += cnts[buf_ + ww * 32 + r32]; (totvar) = t_; } while (0)
    unsigned T = 0u;
    for (int bit = 31; bit >= 0; --bit) {
        const unsigned cand = T | (1u << bit);
        int cnt = 0;
#pragma unroll
        for (int i = 0; i < 8; ++i) if (i < nloc) {
#pragma unroll
            for (int r = 0; r < 16; ++r) cnt += (key[i][r] >= cand) ? 1 : 0; }
        int tot; IDX_REDUCE(cnt, tot);
        if (tot >= TOPK) T = cand;
    }
    int cgt = 0, ceq = 0;
#pragma unroll
    for (int i = 0; i < 8; ++i) if (i < nloc) {
#pragma unroll
        for (int r = 0; r < 16; ++r) { cgt += (key[i][r] > T) ? 1 : 0; ceq += (key[i][r] == T) ? 1 : 0; } }
    int tgt, teq; IDX_REDUCE(cgt, tgt); IDX_REDUCE(ceq, teq);
    const int need = TOPK - tgt;
    int X = 1 << 20;
    if (__any(teq > need)) {
        X = 0;
        for (int bit = 10; bit >= 0; --bit) {
            const int cand = X | (1 << bit);
            int cnt = 0;
#pragma unroll
            for (int i = 0; i < 8; ++i) if (i < nloc) {
                const int ti = cand - 32 * (w + 8 * i) - 4 * hi;
#pragma unroll
                for (int r = 0; r < 16; ++r) cnt += (key[i][r] == T && ((r & 3) + 8 * (r >> 2)) < ti) ? 1 : 0; }
            int tot; IDX_REDUCE(cnt, tot);
            if (tot < need) X = cand;
        }
    }
#undef IDX_REDUCE
#pragma unroll
    for (int i = 0; i < 8; ++i) if (i < nloc) {
        const int j = w + 8 * i;
        const int xi = X - 32 * j - 4 * hi;
        unsigned long long mine = 0ull;
#pragma unroll
        for (int r = 0; r < 16; ++r) {
            const bool sel = (key[i][r] > T) || (key[i][r] == T && ((r & 3) + 8 * (r >> 2)) <= xi);
            const unsigned long long bal = __ballot(sel);
            if (lane == r) mine = bal; }
        if (lane < 16) mbase[(size_t)j * 16 + lane] = mine;
    }
}

struct AttnArgs { const bf16* Q; const bf16* K; const bf16* V; const bf16* G; bf16* O; const unsigned long long* mask; const float* ssq; const float* qg; const float* rc; const float* rs;
                  int qpitch, qhs, kpitch, khs, vpitch, vhs, gpitch, ocol; };
namespace fa {
using bf16x8=__attribute__((ext_vector_type(8)))short;
using s16x4=__attribute__((ext_vector_type(4)))short;
using f32x16=__attribute__((ext_vector_type(16)))float;
using u32x4=__attribute__((ext_vector_type(4)))unsigned;
constexpr int SEQ=2048,D=64;
constexpr int NW=8,QBLK=32,QB=QBLK*NW,KVBLK=64,NQB=SEQ/QB;
__device__ __forceinline__ int crow(int r,int hi){return (r&3)+8*(r>>2)+4*hi;}
#define SBAR() __builtin_amdgcn_sched_barrier(0)
__device__ __forceinline__ void allneg(f32x16&p0,f32x16&p1){
  const float NEG=-INFINITY;
  #pragma unroll
  for(int r=0;r<16;++r){p0[r]=NEG;p1[r]=NEG;}
}

constexpr int NSLOT=3, SLOTB=8192, SLOTKMAX=12288;
constexpr int LDS_K=0, LDS_V=NSLOT*SLOTKMAX, LDS_WS=LDS_V+NSLOT*SLOTB, LDS_OST=LDS_WS+NW*64*4, LDS_BYTES=LDS_OST+NW*4096;
__device__ __forceinline__ void glds16(const void*gsrc,unsigned lds_dst){unsigned keep;
  asm volatile("s_mov_b32 %0, m0\n\ts_mov_b32 m0, %2\n\ts_nop 0\n\tglobal_load_lds_dwordx4 %1, off\n\ts_mov_b32 m0, %0":"=&s"(keep):"v"(gsrc),"s"(lds_dst):"memory");}
__device__ __forceinline__ float max3f(float a,float b,float c){float r;asm("v_max3_f32 %0, %1, %2, %3":"=v"(r):"v"(a),"v"(b),"v"(c));return r;}
__device__ __forceinline__ float max2f(float a,float b){float r;asm("v_max_f32_e32 %0, %1, %2":"=v"(r):"v"(a),"v"(b));return r;}
__device__ __forceinline__ float fadd_s(float a,float b){float r;asm("v_add_f32_e32 %0, %1, %2":"=v"(r):"v"(a),"v"(b));return r;}
__device__ __forceinline__ float fsub_s(float a,float b){float r;asm("v_sub_f32_e32 %0, %1, %2":"=v"(r):"v"(a),"v"(b));return r;}
typedef float f32x2_t __attribute__((ext_vector_type(2))); typedef __bf16 bf16x2_t __attribute__((ext_vector_type(2)));
__device__ __forceinline__ unsigned cvtpk_s(float lo,float hi){f32x2_t v={lo,hi};bf16x2_t b=__builtin_convertvector(v,bf16x2_t);return __builtin_bit_cast(unsigned,b);}
#define WAIT_BAR(N) asm volatile("s_waitcnt vmcnt(" #N ") lgkmcnt(0)\n\ts_barrier":::"memory")

template<int NS> __device__ __forceinline__ void qkt(f32x16&p0,f32x16&p1,const char*Kslot,const bf16x8*qr,int r32,int hi){
  const char*kb=Kslot+hi*1024+r32*16;
  #pragma unroll
  for(int d0=0;d0<NS;++d0){
    const bf16x8 b0=*reinterpret_cast<const bf16x8*>(kb+d0*2048);
    const bf16x8 b1=*reinterpret_cast<const bf16x8*>(kb+d0*2048+512);
    if(d0==0){p0=__builtin_amdgcn_mfma_f32_32x32x16_bf16(b0,qr[0],f32x16{},0,0,0);p1=__builtin_amdgcn_mfma_f32_32x32x16_bf16(b1,qr[0],f32x16{},0,0,0);}
    else{p0=__builtin_amdgcn_mfma_f32_32x32x16_bf16(b0,qr[d0],p0,0,0,0);p1=__builtin_amdgcn_mfma_f32_32x32x16_bf16(b1,qr[d0],p1,0,0,0);}}
}
typedef __attribute__((address_space(3))) const char* lds_cptr;
typedef short v4i16_t __attribute__((ext_vector_type(4)));
template<int NS> __device__ __forceinline__ void kloadN(bf16x8*kf,lds_cptr kp){
  #pragma unroll
  for(int d0=0;d0<NS;++d0){ kf[2*d0]=*(const __attribute__((address_space(3))) bf16x8*)(kp+d0*2048); kf[2*d0+1]=*(const __attribute__((address_space(3))) bf16x8*)(kp+d0*2048+512); }
}
__device__ __forceinline__ void kload2(bf16x8*kf,lds_cptr kp,int j){ kf[2*j]=*(const __attribute__((address_space(3))) bf16x8*)(kp+j*2048); kf[2*j+1]=*(const __attribute__((address_space(3))) bf16x8*)(kp+j*2048+512); }
__device__ __forceinline__ s16x4 vtr(lds_cptr p){ return __builtin_bit_cast(s16x4,__builtin_amdgcn_ds_read_tr16_b64_v4i16((__attribute__((address_space(3))) v4i16_t*)p)); }
__device__ __forceinline__ float rowmax(const f32x16&p0,const f32x16&p1){
  float a=max3f(p0[0],p0[1],p1[0]),b=max3f(p0[2],p0[3],p1[1]);a=max3f(a,p1[2],p1[3]);
  #pragma unroll
  for(int r=4;r<16;r+=4){a=max3f(a,p0[r],p0[r+1]);b=max3f(b,p0[r+2],p0[r+3]);a=max3f(a,p1[r],p1[r+1]);b=max3f(b,p1[r+2],p1[r+3]);}
  const float m=max2f(a,b);
  auto rr=__builtin_amdgcn_permlane32_swap(__float_as_uint(m),__float_as_uint(m),false,false);
  return max2f(__uint_as_float(rr[0]),__uint_as_float(rr[1]));
}
__device__ __forceinline__ void pv(f32x16*o,int vb,bf16x8 pa0,bf16x8 pa1,bf16x8 pa2,bf16x8 pa3){
  #pragma unroll
  for(int d0=0;d0<2;++d0){s16x4 lo[4],hi[4];
    #pragma unroll
    for(int ks=0;ks<4;++ks){
      asm volatile("ds_read_b64_tr_b16 %0,%1 offset:%c2":"=&v"(lo[ks]):"v"(vb),"i"(d0*4096+ks*1024):"memory");
      asm volatile("ds_read_b64_tr_b16 %0,%1 offset:%c2":"=&v"(hi[ks]):"v"(vb),"i"(d0*4096+ks*1024+512):"memory");}
    asm volatile("s_waitcnt lgkmcnt(0)":::"memory");SBAR();
    #define PK(k) (bf16x8){lo[k][0],lo[k][1],lo[k][2],lo[k][3],hi[k][0],hi[k][1],hi[k][2],hi[k][3]}
    o[d0]=__builtin_amdgcn_mfma_f32_32x32x16_bf16(pa0,PK(0),o[d0],0,0,0);
    o[d0]=__builtin_amdgcn_mfma_f32_32x32x16_bf16(pa1,PK(1),o[d0],0,0,0);
    o[d0]=__builtin_amdgcn_mfma_f32_32x32x16_bf16(pa2,PK(2),o[d0],0,0,0);
    o[d0]=__builtin_amdgcn_mfma_f32_32x32x16_bf16(pa3,PK(3),o[d0],0,0,0);
    #undef PK
  }
}

#ifndef ATTN_STORE16
#define ATTN_STORE16(p,v) (*(u32x4*)(p)=(v))
#endif
template<int THRL,bool SEL,int NS,bool QN> __device__ __forceinline__ void attn_unit(int b,int h,int qb,const AttnArgs&a,char*shm){
  const int tid=opaque_tid(),lane=tid&63,r32=lane&31,hi=lane>>5; const int wid=__builtin_amdgcn_readfirstlane(tid>>6);
  const long rowbase=(long)b*SEQ; const int q0=qb*QB;
  const long qpitch=a.qpitch,kpitch=a.kpitch,vpitch=a.vpitch;
  const bf16*Qw=a.Q+(rowbase+q0+wid*QBLK)*qpitch+h*a.qhs;
  const bf16*Kh=a.K+rowbase*kpitch+h*a.khs,*Vh=a.V+rowbase*vpitch+h*a.vhs;
  typedef const __attribute__((address_space(4))) unsigned long long* cmask_t;
  const cmask_t mrow=SEL?(cmask_t)(a.mask+((size_t)(b*64+(q0>>5)+wid)*64)*16):(cmask_t)nullptr;
  unsigned long long mk[32];
  const unsigned lds0=(unsigned)(uintptr_t)shm;
  float*wsf=(float*)(shm+LDS_WS)+wid*64;
  const bf16*ksrc=Kh+(long)lane*kpitch+wid*8;
  const bf16*vsrc=Vh+(long)(16*(wid&3)+(lane>>2))*vpitch+(wid>>2)*32+(lane&3)*8;
  const unsigned kdst=lds0+LDS_K+wid*1024, vdst=lds0+LDS_V+wid*1024;
  const bf16*ksrc2=Kh+(long)lane*kpitch+(8+(wid&3))*8; const unsigned kdst2=lds0+LDS_K+(8+(wid&3))*1024;
  #define KS(sl) (((sl)>>2)*NS)
  #define DMA_K(t,slot) do{ glds16(ksrc+(long)(t)*KVBLK*kpitch,(unsigned)__builtin_amdgcn_readfirstlane(kdst+KS(slot))); if constexpr(NS==6) glds16(ksrc2+(long)(t)*KVBLK*kpitch,(unsigned)__builtin_amdgcn_readfirstlane(kdst2+KS(slot))); }while(0)
  #define WB2() do{ if constexpr(NS==6){WAIT_BAR(3);}else{WAIT_BAR(2);} }while(0)
  #define DMA_V(t,slot) glds16(vsrc+(long)(t)*KVBLK*vpitch,(unsigned)__builtin_amdgcn_readfirstlane(vdst+(slot)))
  const int vb0=(int)(lds0+LDS_V)+((lane>>4)&1)*32+(lane&3)*8+(4*hi+((lane&15)>>2))*64;
  const char*Kbase=shm+LDS_K; bf16x8 kf[2*NS];
  const lds_cptr shm3=(lds_cptr)shm; const lds_cptr kp0=shm3+LDS_K+hi*1024+r32*16; const lds_cptr vp0=shm3+LDS_V+((lane>>4)&1)*32+(lane&3)*8+(4*hi+((lane&15)>>2))*64;
  const int NT=(q0+QB)/KVBLK;
  DMA_K(0,0);DMA_V(0,0);DMA_K(1,SLOTB);
  bf16x8 qr[NS];
  #pragma unroll
  for(int d0=0;d0<NS;++d0)qr[d0]=*reinterpret_cast<const bf16x8*>(&Qw[(long)r32*qpitch+d0*16+hi*8]);
  if constexpr(QN){
    static_assert(NS==6,"QN is the 96-dim head group");
    const long row=rowbase+q0+wid*QBLK+r32; const int pos=q0+wid*QBLK+r32;
    float qv[6][8]; float ss=0.f;
    #pragma unroll
    for(int d0=0;d0<6;++d0){
      #pragma unroll
      for(int j=0;j<8;++j){ qv[d0][j]=bf2f((unsigned short)qr[d0][j]); ss+=qv[d0][j]*qv[d0][j]; } }
    ss+=__shfl_xor(ss,32);
    const float*sq=a.ssq+row*24; float msq=0.f;
    #pragma unroll
    for(int i=0;i<12;++i)msq+=sq[i];
    msq=msq*(1.0f/384.0f)+1e-6f;
    const float rn=C2B/sqrtf(ss*(1.0f/96.0f)+1e-6f*msq);
    const float*gq=a.qg+8*hi;
    #pragma unroll
    for(int d0=0;d0<4;++d0){
      #pragma unroll
      for(int j=0;j<8;++j)qv[d0][j]*=rn*gq[16*d0+j]; }
    const float*cp=a.rc+pos*32+16*hi,*sp=a.rs+pos*32+16*hi;
    #pragma unroll
    for(int j=0;j<8;++j){ const float x1=qv[4][j]*rn*gq[64+j],x2=qv[5][j]*rn*gq[80+j],c=cp[2*j],s=sp[2*j]; qv[4][j]=x1*c-x2*s; qv[5][j]=x2*c+x1*s; }
    #pragma unroll
    for(int d0=0;d0<6;++d0){ u32x4 w;
      #pragma unroll
      for(int e=0;e<4;++e)w[e]=pk2(qv[d0][2*e],qv[d0][2*e+1]);
      qr[d0]=__builtin_bit_cast(bf16x8,w); }
  }
  float l_reg=0.f;f32x16 o[2];o[0]=f32x16{};o[1]=f32x16{};
  const int qrel=wid*QBLK+r32;
  #define CMASK(P0,P1,t) do{int jb_=(t)-(NT-4); if(jb_>(wid>>1))allneg(P0,P1);}while(0)
  #define MKLOAD(t) do{ if constexpr(SEL){ const cmask_t mw_=mrow+(long)(t)*32; _Pragma("unroll") for(int r=0;r<32;++r)mk[r]=mw_[r]; } }while(0)
  #define MKZ(X,B,WB) do{ if constexpr(SEL){ _Pragma("unroll") for(int r=0;r<4;++r)X[(B)+r]=__builtin_amdgcn_inverse_ballot_w64(mk[(WB)+(B)+r])?X[(B)+r]:0.f; } }while(0)
  #define START(P0,P1) do{ _Pragma("unroll") for(int r=0;r<16;++r)P0[r]=__builtin_amdgcn_exp2f(P0[r]); }while(0)
  #define RESC() do{}while(0)
  f32x16 pA0,pA1,pB0,pB1;
  int sl_prev=0,sl_cur=0,sl_next=SLOTB;
  #define ROT() do{sl_prev=sl_cur;sl_cur=sl_next;sl_next=(sl_next==(NSLOT-1)*SLOTB)?0:sl_next+SLOTB;}while(0)
  MKLOAD(0);
  DMA_K(2,2*SLOTB);
  if constexpr(NS==6){WAIT_BAR(5);}else{WAIT_BAR(3);}
  qkt<NS>(pA0,pA1,Kbase,qr,r32,hi);asm volatile("s_nop 15\n\ts_nop 7":"+v"(pA0),"+v"(pA1));CMASK(pA0,pA1,0);
  START(pA0,pA1);
  _Pragma("unroll") for(int r=0;r<16;++r)pA1[r]=__builtin_amdgcn_exp2f(pA1[r]);
  MKZ(pA0,0,0);MKZ(pA0,4,0);MKZ(pA0,8,0);MKZ(pA0,12,0);MKZ(pA1,0,16);MKZ(pA1,4,16);MKZ(pA1,8,16);MKZ(pA1,12,16);
  WAIT_BAR(0);
  DMA_K(3,0);DMA_V(1,SLOTB);
  ROT();
  kloadN<NS>(kf,kp0+KS(sl_cur));
  WB2();
  s16x4 vlo[8],vhi[8]; u32x4 pw0,pw1,pw2,pw3;
  #define PKW(P,B) cvtpk_s(P[B],P[B+1])
  #define PAF(k) __builtin_bit_cast(bf16x8,pw##k)
  #define VFR(i) (bf16x8){vlo[i][0],vlo[i][1],vlo[i][2],vlo[i][3],vhi[i][0],vhi[i][1],vhi[i][2],vhi[i][3]}
  #define PIN(x) asm volatile("":"+v"(x))
  #define MX3(a,b,c) __builtin_fmaxf(__builtin_fmaxf((a),(b)),(c))
  #define GAPA(MF,A0,A1,A2,A3,W0,W1,PW) do{ MF; sacc+=A0; sacc+=A1; sacc+=A2; sacc+=A3; PIN(sacc); W0; W1; PIN(PW); SBAR(); }while(0)
  #define EX(v) __builtin_amdgcn_exp2f(v)
  #define GAPB(MF,X,B,WB) do{ MF; X[B]=EX(X[B]); X[B+1]=EX(X[B+1]); X[B+2]=EX(X[B+2]); X[B+3]=EX(X[B+3]); MKZ(X,B,WB); PIN(X); SBAR(); }while(0)
  #define VRD(i) do{ vlo[i]=vtr(vp_+(((i)>>2)*4096+((i)&3)*1024)); vhi[i]=vtr(vp_+(((i)>>2)*4096+((i)&3)*1024+512)); }while(0)
  #define KRD(G,j) do{ if(G){ kload2(kf,kp0+KS(sl_next),j); SBAR(); } }while(0)
  #define KRD6(G,j) do{ if constexpr(NS==6){ KRD(G,j); } }while(0)
  #define STEP(C0,C1,P0,P1,t,GK,GV,GL) do{ SBAR(); MKLOAD(t); \
    const lds_cptr vp_=vp0+sl_prev; \
    VRD(0); SBAR(); float sacc=(P0[0]+P0[1]); \
    GAPA(C0=__builtin_amdgcn_mfma_f32_32x32x16_bf16(kf[0],qr[0],f32x16{},0,0,0), P0[2],P0[3],P0[4],P0[5],     pw0[0]=PKW(P0,0), pw0[1]=PKW(P0,2), pw0); \
    VRD(4); SBAR(); GAPA(C1=__builtin_amdgcn_mfma_f32_32x32x16_bf16(kf[1],qr[0],f32x16{},0,0,0), P0[6],P0[7],P0[8],P0[9],     pw0[2]=PKW(P0,4), pw0[3]=PKW(P0,6), pw0); \
    VRD(1); SBAR(); GAPA(C0=__builtin_amdgcn_mfma_f32_32x32x16_bf16(kf[2],qr[1],C0,0,0,0),   P0[10],P0[11],P0[12],P0[13], pw1[0]=PKW(P0,8), pw1[1]=PKW(P0,10), pw1); \
    VRD(5); SBAR(); GAPA(C1=__builtin_amdgcn_mfma_f32_32x32x16_bf16(kf[3],qr[1],C1,0,0,0),   P0[14],P0[15],P1[0],P1[1],   pw1[2]=PKW(P0,12),pw1[3]=PKW(P0,14), pw1); \
    VRD(2); SBAR(); GAPA(C0=__builtin_amdgcn_mfma_f32_32x32x16_bf16(kf[4],qr[2],C0,0,0,0),   P1[2],P1[3],P1[4],P1[5],     pw2[0]=PKW(P1,0), pw2[1]=PKW(P1,2), pw2); \
    VRD(6); SBAR(); GAPA(C1=__builtin_amdgcn_mfma_f32_32x32x16_bf16(kf[5],qr[2],C1,0,0,0),   P1[6],P1[7],P1[8],P1[9],     pw2[2]=PKW(P1,4), pw2[3]=PKW(P1,6), pw2); \
    VRD(3); SBAR(); GAPA(C0=__builtin_amdgcn_mfma_f32_32x32x16_bf16(kf[6],qr[3],C0,0,0,0),   P1[10],P1[11],P1[12],P1[13], pw3[0]=PKW(P1,8), pw3[1]=PKW(P1,10), pw3); \
    VRD(7); SBAR(); GAPA(C1=__builtin_amdgcn_mfma_f32_32x32x16_bf16(kf[7],qr[3],C1,0,0,0),   P1[14],P1[15],0.f,0.f,       pw3[2]=PKW(P1,12),pw3[3]=PKW(P1,14), pw3); \
    if constexpr(NS==6){ C0=__builtin_amdgcn_mfma_f32_32x32x16_bf16(kf[8],qr[4],C0,0,0,0); C1=__builtin_amdgcn_mfma_f32_32x32x16_bf16(kf[9],qr[4],C1,0,0,0); \
      C0=__builtin_amdgcn_mfma_f32_32x32x16_bf16(kf[10],qr[5],C0,0,0,0); C1=__builtin_amdgcn_mfma_f32_32x32x16_bf16(kf[11],qr[5],C1,0,0,0); SBAR(); } \
    l_reg+=sacc; \
    if(GK){DMA_K((t)+3,sl_cur);} if(GV){DMA_V((t)+1,sl_next);} \
    CMASK(C0,C1,t); \
    SBAR(); \
    GAPB(o[0]=__builtin_amdgcn_mfma_f32_32x32x16_bf16(PAF(0),VFR(0),o[0],0,0,0), C0,0,0); \
    GAPB(o[1]=__builtin_amdgcn_mfma_f32_32x32x16_bf16(PAF(0),VFR(4),o[1],0,0,0), C0,4,0); \
    KRD(GL,0); GAPB(o[0]=__builtin_amdgcn_mfma_f32_32x32x16_bf16(PAF(1),VFR(1),o[0],0,0,0), C0,8,0); \
    KRD(GL,1); GAPB(o[1]=__builtin_amdgcn_mfma_f32_32x32x16_bf16(PAF(1),VFR(5),o[1],0,0,0), C0,12,0); \
    KRD(GL,2); GAPB(o[0]=__builtin_amdgcn_mfma_f32_32x32x16_bf16(PAF(2),VFR(2),o[0],0,0,0), C1,0,16); \
    KRD(GL,3); GAPB(o[1]=__builtin_amdgcn_mfma_f32_32x32x16_bf16(PAF(2),VFR(6),o[1],0,0,0), C1,4,16); \
    KRD6(GL,4); GAPB(o[0]=__builtin_amdgcn_mfma_f32_32x32x16_bf16(PAF(3),VFR(3),o[0],0,0,0), C1,8,16); \
    KRD6(GL,5); GAPB(o[1]=__builtin_amdgcn_mfma_f32_32x32x16_bf16(PAF(3),VFR(7),o[1],0,0,0), C1,12,16); \
    }while(0)
  int t=1;
  #undef CMASK
  #define CMASK(P0,P1,t) do{}while(0)
  for(;t+5<NT;t+=2){
    STEP(pB0,pB1,pA0,pA1,t,true,true,true);     WB2(); RESC(); ROT();
    STEP(pA0,pA1,pB0,pB1,t+1,true,true,true);   WB2(); RESC(); ROT();
  }
  #undef CMASK
  #define CMASK(P0,P1,t) do{int jb_=(t)-(NT-4); if(jb_>(wid>>1))allneg(P0,P1);}while(0)
  #define ENDW(tt) do{ if((tt)+3<NT){WB2();} else if((tt)+2<NT){WAIT_BAR(1);} else {WAIT_BAR(0);} }while(0)
  for(;t+1<NT;t+=2){
    STEP(pB0,pB1,pA0,pA1,t,(t+3<NT),(t+1<NT),(t+1<NT));       ENDW(t);   RESC(); ROT();
    STEP(pA0,pA1,pB0,pB1,t+1,(t+4<NT),(t+2<NT),(t+2<NT));     ENDW(t+1); RESC(); ROT();
  }
  STEP(pB0,pB1,pA0,pA1,NT-1,false,false,false); RESC();
  { float sacc=pB0[0]+pB0[1]; _Pragma("unroll") for(int r=2;r<16;++r)sacc+=pB0[r]; _Pragma("unroll") for(int r=0;r<16;++r)sacc+=pB1[r]; l_reg+=sacc;
    pw0=(u32x4){PKW(pB0,0),PKW(pB0,2),PKW(pB0,4),PKW(pB0,6)};pw1=(u32x4){PKW(pB0,8),PKW(pB0,10),PKW(pB0,12),PKW(pB0,14)};pw2=(u32x4){PKW(pB1,0),PKW(pB1,2),PKW(pB1,4),PKW(pB1,6)};pw3=(u32x4){PKW(pB1,8),PKW(pB1,10),PKW(pB1,12),PKW(pB1,14)};
    SBAR(); pv(o,vb0+sl_cur,PAF(0),PAF(1),PAF(2),PAF(3)); }
  #undef PKW
  #undef PAF
  #undef VFR
  #undef PIN
  #undef MX3
  #undef GAPA
  #undef GAPB
  #undef EX
  #undef VRD
  #undef KRD
  #undef KRD6
  #undef STEP
  #undef ENDW
  {auto rr=__builtin_amdgcn_permlane32_swap(__float_as_uint(l_reg),__float_as_uint(l_reg),false,false);l_reg=__uint_as_float(rr[0])+__uint_as_float(rr[1]);}
  if(hi==0)wsf[32+r32]=l_reg;asm volatile("s_waitcnt lgkmcnt(0)":::"memory");
  float rli[16];
  #pragma unroll
  for(int r=0;r<16;++r)rli[r]=__builtin_amdgcn_rcpf(wsf[32+crow(r,hi)]);
  bf16*Ow=a.O+(rowbase+q0+wid*QBLK)*1024+a.ocol+h*D;
  const bf16*Gw=a.G+(rowbase+q0+wid*QBLK)*(long)a.gpitch+h*D;
  { bf16*stg=(bf16*)(shm+LDS_OST)+wid*2048;
    #pragma unroll
    for(int r=0;r<16;++r){const int orow=crow(r,hi);
      #pragma unroll
      for(int d0=0;d0<2;++d0)stg[orow*64+d0*32+r32]=(bf16)f2bf(o[d0][r]*rli[r]);}
    asm volatile("s_waitcnt lgkmcnt(0)":::"memory");
    #pragma unroll
    for(int i=0;i<4;++i){const int row=i*8+(lane>>3),ch=lane&7; const u32x4 v=*(const u32x4*)(stg+row*64+ch*8);
      const u32x4 g=*(const u32x4*)(Gw+(long)row*a.gpitch+ch*8); u32x4 w;
      #pragma unroll
      for(int e=0;e<4;++e) w[e]=pk2(bflo(v[e])*bflo(g[e]),bfhi(v[e])*bfhi(g[e]));
      ATTN_STORE16(Ow+(long)row*1024+ch*8,w);} }
  asm volatile("s_waitcnt lgkmcnt(0)\n\ts_barrier":::"memory");
  #undef DMA_K
  #undef KS
  #undef WB2
  #undef DMA_V
  #undef CMASK
  #undef MKLOAD
  #undef MKZ
  #undef START
  #undef RESC
  #undef ROT
}
constexpr int ATTN_LDS_BYTES=LDS_BYTES;
#undef SBAR
#undef WAIT_BAR
}
#define XB_TMO      128
#define XB_XCNT(j)  (256  + 64 * (j))
#define XB_XSUB(j)  (1280 + 64 * (j))
#define XB_XGEN(j)  (2304 + 64 * (j))
#define XB_TOP      3328
#define XB_TOPGEN   3392
#define XCD_BAR_WORDS 3456
#define XB_SPIN_CAP (1u << 18)

__device__ __forceinline__ unsigned xb_ld(unsigned* p)              { return __hip_atomic_load(p, __ATOMIC_RELAXED, __HIP_MEMORY_SCOPE_AGENT); }
__device__ __forceinline__ unsigned xb_add(unsigned* p, unsigned v) { return __hip_atomic_fetch_add(p, v, __ATOMIC_RELAXED, __HIP_MEMORY_SCOPE_AGENT); }
__device__ __forceinline__ unsigned xb_xcc_id() { return (unsigned)__builtin_amdgcn_s_getreg((3 << 11) | 20) & 0xFu; }
#define XB_SPIN(cond, bar) do { unsigned _sp = 0; while (cond) { __builtin_amdgcn_s_sleep(1); \
    if ((++_sp & 255u) == 0u) { if (xb_ld(&(bar)[XB_TMO])) break; if (_sp > XB_SPIN_CAP) { atomicAdd(&(bar)[XB_TMO], 1u); break; } } } } while (0)

struct XcdBarrier {
    unsigned* bar; unsigned x;
    volatile LAS unsigned* st;
};

__device__ __forceinline__ XcdBarrier xcd_barrier_post(unsigned* bar, volatile LAS unsigned* st) {
    XcdBarrier b; b.bar = bar; b.x = xb_xcc_id(); b.st = st;
    if (threadIdx.x == 0) (void)xb_add(&bar[XB_XCNT(b.x)], 1u);
    return b;
}
__device__ __forceinline__ void xcd_barrier_complete(unsigned* bar, unsigned x, unsigned& nloc, unsigned& nx) {
    const unsigned G = gridDim.x * gridDim.y * gridDim.z;
    unsigned sum, cnt, mine, sp = 0u;
    for (;;) {
        sum = 0u; cnt = 0u; mine = 0u;
#pragma unroll
        for (unsigned j = 0; j < 16; ++j) { const unsigned c = xb_ld(&bar[XB_XCNT(j)]); sum += c; cnt += (c > 0u) ? 1u : 0u; mine = (j == x) ? c : mine; }
        if (sum == G) break;
        __builtin_amdgcn_s_sleep(1);
        if ((++sp & 255u) == 0u) { if (xb_ld(&bar[XB_TMO])) break; if (sp > XB_SPIN_CAP) { atomicAdd(&bar[XB_TMO], 1u); break; } }
    }
    nloc = mine > 0u ? mine : 1u; nx = cnt > 0u ? cnt : 1u;
}

__device__ __forceinline__ void xcd_barrier(const XcdBarrier& b) {
    asm volatile("s_waitcnt vmcnt(0)" ::: "memory");
    __syncthreads();
    if (threadIdx.x == 0) {
        unsigned* bar = b.bar;
        __builtin_amdgcn_s_waitcnt(0);
        unsigned nloc = b.st[0], nx = b.st[1];
        if (nloc == 0u) { xcd_barrier_complete(bar, b.x, nloc, nx); b.st[0] = nloc; b.st[1] = nx; }
        const unsigned old = xb_add(&bar[XB_XSUB(b.x)], 1u);
        const unsigned gen = old / nloc;
        if (old + 1u == (gen + 1u) * nloc) {
            __builtin_amdgcn_fence(__ATOMIC_RELEASE, "agent");
            asm volatile("s_waitcnt vmcnt(0)" ::: "memory");
            const unsigned og = xb_add(&bar[XB_TOP], 1u);
            const unsigned tg = og / nx;
            if (og + 1u == (tg + 1u) * nx) xb_add(&bar[XB_TOPGEN], 1u);
            else XB_SPIN(xb_ld(&bar[XB_TOPGEN]) == tg, bar);
            __builtin_amdgcn_fence(__ATOMIC_ACQUIRE, "agent");
            xb_add(&bar[XB_XGEN(b.x)], 1u);
            asm volatile("s_waitcnt vmcnt(0)" ::: "memory");
        } else {
            XB_SPIN(xb_ld(&bar[XB_XGEN(b.x)]) == gen, bar);
            __builtin_amdgcn_fence(__ATOMIC_ACQUIRE, "agent");
            asm volatile("s_waitcnt vmcnt(0)" ::: "memory");
        }
    }
    __syncthreads();
}

constexpr int NWAVES = 8;
constexpr int RING_BYTES = 131072;
constexpr int LDSCTL_OFF = RING_BYTES, MISC_OFF = LDSCTL_OFF + 320;
constexpr int LDS_BYTES = 147456;
constexpr int CW_BAR = 4096;
constexpr size_t CTL_ZERO_BYTES = 64 * 1024;
static_assert((CW_BAR + XCD_BAR_WORDS) * 4 <= (int)CTL_ZERO_BYTES, "barrier words inside the memset region");

struct MegaArgs { const float* in[12]; float* out; unsigned char* ws; };

__global__ void __launch_bounds__(NWAVES * 64, 2) mega_fwd(MegaArgs args) {
    extern __shared__ __attribute__((aligned(16))) unsigned char lds_raw[];
    LAS unsigned char* lds = (LAS unsigned char*)lds_raw;
    const int tid = opaque_tid(), lane = tid & 63; const int wave = __builtin_amdgcn_readfirstlane(tid >> 6);
    const int G = gridDim.x, bx = blockIdx.x, vcu = (G % 8 == 0) ? (bx % 8) * (G / 8) + bx / 8 : bx;
    unsigned char* const ws = args.ws;
#define WSP(T, off) ((T*)(ws + (off)))
    float* const GAINS = WSP(float, WS_GAINS);

    for (int u = tid; u < (LDS_BYTES - LDSCTL_OFF) / 4; u += NWAVES * 64) ((LAS unsigned*)(lds + LDSCTL_OFF))[u] = 0u;
    __syncthreads();
    XcdBarrier bar = xcd_barrier_post((unsigned*)(ws + WS_CTL) + CW_BAR, (volatile LAS unsigned*)(lds + MISC_OFF) + 8);

    const int gw = vcu * NWAVES + wave, NGW = G * NWAVES;

    {
        float* RC = WSP(float, WS_ROPE); float* RS = RC + SEQ * 32;
        for (int i = vcu * 512 + tid; i < SEQ * 32; i += G * 512) rope_table_elem(RC, RS, i);
        if (vcu == 0 && tid < 320) { const int i = tid; GAINS[i] = (i < 64) ? args.in[3][i] : (i < 128) ? args.in[4][i - 64] : (i < 224) ? args.in[9][i - 128] : args.in[10][i - 224]; }
        constexpr int T_IN = (NP / 64) * 16, T_UQ = 12 * 6, T_UKV = 16 * 4, T_OUT = 16 * 16;
        LAS float* tile = (LAS float*)lds;
        for (int it = vcu; it < T_IN + T_UQ + T_UKV + T_OUT; it += G) {
            int r = it;
            if (r < T_IN) { wtrans_tile(tile, args.in[2], 1024, D_IN_OLD, WSP(bf16, WS_WIN), (r % (NP / 64)) * 64, (r / (NP / 64)) * 64, 1, nullptr, tid); continue; } r -= T_IN;
            if (r < T_UQ) { wtrans_tile(tile, args.in[7], 384, 768, WSP(bf16, WS_WUQ), (r % 12) * 64, (r / 12) * 64, 0, args.in[5], tid); continue; } r -= T_UQ;
            if (r < T_UKV) { wtrans_tile(tile, args.in[8], 256, 1024, WSP(bf16, WS_WUKV), (r % 16) * 64, (r / 16) * 64, 2, args.in[6], tid); continue; } r -= T_UKV;
            wtrans_tile(tile, args.in[11], 1024, 1024, WSP(bf16, WS_WOUT), (r % 16) * 64, (r / 16) * 64, 0, nullptr, tid);
        }
        for (int m = gw; m < MTOK; m += NGW) rmsnorm_x_row(args.in[0], args.in[1], WSP(bf16, WS_XN), m, lane);
    }
    xcd_barrier(bar);

    {
        pg8::Gemm g{WSP(bf16, WS_XN), WSP(bf16, WS_WIN), MTOK, NP, 1024, 1024}; pg8::StaticOrder S; S.init(MTOK, NP, G, bx);
        pg8::EpiProj E{WSP(bf16, WS_PROJ), WSP(float, WS_SSQ), GAINS, GAINS + 64, WSP(float, WS_ROPE), WSP(float, WS_ROPE) + SEQ * 32};
        pg8::gemm_phase<pg8::EpiProj, pg8::StaticOrder, true, true>(lds, g, S, E);
    }
    xcd_barrier(bar);

    {
        pg8::Gemm g{WSP(bf16, WS_PROJ) + C_CQ, WSP(bf16, WS_WUQ), MTOK, 768, 384, NP}; pg8::StaticOrder S; S.init(MTOK, 768, G, bx);
        pg8::EpiBf16<0> E{WSP(bf16, WS_QB), 768, nullptr, 0, 0, 1.f};
        pg8::gemm_phase<pg8::EpiBf16<0>, pg8::StaticOrder, true, true>(lds, g, S, E);
    }
    {
        pg8::Gemm g{WSP(bf16, WS_PROJ) + C_CKV, WSP(bf16, WS_WUKV), MTOK, 1024, 256, NP}; pg8::StaticOrder S; S.init(MTOK, 1024, G, bx);
        pg8::EpiKV E{WSP(bf16, WS_KB), WSP(bf16, WS_VB), WSP(bf16, WS_PROJ), WSP(float, WS_SSQ), GAINS + 224, WSP(float, WS_ROPE), WSP(float, WS_ROPE) + SEQ * 32};
        pg8::gemm_phase<pg8::EpiKV, pg8::StaticOrder, true, true>(lds, g, S, E);
    }
    for (int p = vcu; p < 512; p += G) {
        const int b = p & 15, qq = p >> 4;
        indexer_unit(lds, WSP(bf16, WS_PROJ), WSP(unsigned long long, WS_MASK), b, 63 - qq);
        indexer_unit(lds, WSP(bf16, WS_PROJ), WSP(unsigned long long, WS_MASK), b, qq);
    }
    xcd_barrier(bar);

    {
        bf16* PROJ = WSP(bf16, WS_PROJ); bf16* MIXED = WSP(bf16, WS_MIXED);
        const AttnArgs aA{PROJ + C_QA, PROJ + C_KA, PROJ + C_VA, PROJ + C_GA, MIXED, WSP(unsigned long long, WS_MASK), nullptr, nullptr, nullptr, nullptr, NP, 64, NP, 64, NP, 64, NP, 0};
        const AttnArgs aB{WSP(bf16, WS_QB), WSP(bf16, WS_KB), WSP(bf16, WS_VB), PROJ + C_GB, MIXED, nullptr, WSP(float, WS_SSQ), GAINS + 128, WSP(float, WS_ROPE), WSP(float, WS_ROPE) + SEQ * 32, 768, 96, 768, 96, 512, 64, NP, 512};
        for (int p = vcu; p < 512; p += G) {
            const int s = p & 3, h = (p >> 2) & 7, b = p >> 5;
            fa::attn_unit<8, true, 4, false>(b, h, 7 - s, aA, (char*)lds_raw);
            fa::attn_unit<8, true, 4, false>(b, h, s, aA, (char*)lds_raw);
            fa::attn_unit<8, false, 6, true>(b, h, 7 - s, aB, (char*)lds_raw);
            fa::attn_unit<8, false, 6, true>(b, h, s, aB, (char*)lds_raw);
        }
    }
    xcd_barrier(bar);

    {
        pg8::Gemm g{WSP(bf16, WS_MIXED), WSP(bf16, WS_WOUT), MTOK, 1024, 1024, 1024}; pg8::StaticOrder S; S.init(MTOK, 1024, G, bx);
        pg8::EpiResF32 E{args.in[0], args.out, 1024};
        pg8::gemm_phase<pg8::EpiResF32, pg8::StaticOrder, true, true>(lds, g, S, E);
    }
}

extern "C" void kernel_launch(void* const* d_in, const int* in_sizes, int n_in, void* d_out, int out_size, void* d_ws, size_t ws_size, hipStream_t stream) {
    static int grid = 0;
    if (grid == 0) {
        if (n_in != 12 || in_sizes[0] != MTOK * DMODEL || out_size != MTOK * DMODEL || ws_size < WS_END) {
            fprintf(stderr, "kernel_launch: unexpected shapes / workspace (n_in %d, in0 %d, out %d, ws %zu)\n", n_in, n_in > 0 ? in_sizes[0] : -1, out_size, ws_size); grid = -1; return; }
        int dev = 0, cus = 0, per_cu = 0;
        if (hipGetDevice(&dev) != hipSuccess || hipDeviceGetAttribute(&cus, hipDeviceAttributeMultiprocessorCount, dev) != hipSuccess) { grid = -1; return; }
        if (hipFuncSetAttribute((const void*)mega_fwd, hipFuncAttributeMaxDynamicSharedMemorySize, LDS_BYTES) != hipSuccess) { fprintf(stderr, "kernel_launch: hipFuncSetAttribute failed\n"); grid = -1; return; }
        if (hipOccupancyMaxActiveBlocksPerMultiprocessor(&per_cu, (const void*)mega_fwd, NWAVES * 64, LDS_BYTES) != hipSuccess || per_cu < 1) {
            fprintf(stderr, "kernel_launch: occupancy query says %d workgroups per CU\n", per_cu); (void)hipGetLastError(); grid = -1; return; }
        grid = cus;
    }
    if (grid < 0) return;
    (void)hipMemsetAsync((char*)d_ws + WS_CTL, 0, CTL_ZERO_BYTES, stream);
    MegaArgs a{};
    for (int i = 0; i < 12; ++i) a.in[i] = (const float*)d_in[i];
    a.out = (float*)d_out; a.ws = (unsigned char*)d_ws;
    hipLaunchKernelGGL(mega_fwd, dim3(grid), dim3(NWAVES * 64), LDS_BYTES, stream, a);
}
```

```cpp
#include <hip/hip_runtime.h>
#include <cstdint>
#include <cstdio>

constexpr int BATCH = 16, SEQ = 2048, DMODEL = 1024, MTOK = BATCH * SEQ;
constexpr int NP = 3840;
constexpr int C_QA = 0, C_KA = 512, C_VA = 1024, C_GA = 1536, C_QI = 2048, C_GB = 2560, C_CQ = 3072, C_CKV = 3456, C_KI = 3712, C_KR = 3776, C_WI = 3808;
constexpr int D_IN_OLD = 3816;
constexpr float RMS_EPS = 1e-6f;
constexpr float LOG2E = 1.4426950408889634f;
constexpr float C2A = 0.125f * LOG2E;
constexpr float C2B = 0.10206207261596575f * LOG2E;

constexpr size_t MiB = 1u << 20;
constexpr size_t WS_CTL = 0;
constexpr size_t WS_WIN = 2 * MiB;
constexpr size_t WS_WUQ = 10 * MiB;
constexpr size_t WS_WUKV = 11 * MiB;
constexpr size_t WS_WOUT = 12 * MiB;
constexpr size_t WS_ROPE = 14 * MiB;
constexpr size_t WS_GAINS = 15 * MiB;
constexpr size_t WS_XN = 16 * MiB;
constexpr size_t WS_MIXED = WS_XN;
constexpr size_t WS_PROJ = 80 * MiB;
constexpr size_t WS_QB = 320 * MiB;
constexpr size_t WS_VB = 368 * MiB;
constexpr size_t WS_SSQ = 400 * MiB;
constexpr size_t WS_KB = 432 * MiB;
constexpr size_t WS_MASK = 480 * MiB;
constexpr size_t WS_END = 488 * MiB;

typedef unsigned short bf16;
typedef short bf16x8_t __attribute__((ext_vector_type(8)));
typedef short s16x4_t __attribute__((ext_vector_type(4)));
typedef float f32x16_t __attribute__((ext_vector_type(16)));
typedef float f32x4_t __attribute__((ext_vector_type(4)));
typedef unsigned u32x4_t __attribute__((ext_vector_type(4)));
typedef unsigned u32x2_t __attribute__((ext_vector_type(2)));
#define LAS __attribute__((address_space(3)))

__device__ __forceinline__ unsigned f2bf(float f) { unsigned u = __builtin_bit_cast(unsigned, f); return (u + 0x7fffu + ((u >> 16) & 1u)) >> 16; }
__device__ __forceinline__ unsigned pk2(float lo, float hi) { return f2bf(lo) | (f2bf(hi) << 16); }
__device__ __forceinline__ float bflo(unsigned u) { return __builtin_bit_cast(float, u << 16); }
__device__ __forceinline__ float bfhi(unsigned u) { return __builtin_bit_cast(float, u & 0xffff0000u); }
__device__ __forceinline__ float bf2f(bf16 b) { return __builtin_bit_cast(float, (unsigned)b << 16); }
__device__ __forceinline__ int crow(int r, int hi) { return (r & 3) + 8 * (r >> 2) + 4 * hi; }

__device__ __forceinline__ int opaque_tid() { int t = (int)threadIdx.x; asm volatile("" : "+v"(t)); return t; }

namespace pg8 {
#define PG8_LAS __attribute__((address_space(3)))
typedef unsigned short bf16_t;
typedef short bf16x8 __attribute__((ext_vector_type(8)));
typedef float f32x4 __attribute__((ext_vector_type(4)));
typedef unsigned u32x4 __attribute__((ext_vector_type(4)));
constexpr int BM = 256, BK = 64, HALF = 128, HTB = HALF * BK * 2  , STAGE_BYTES = 8 * HTB, NXCD = 8, WGM = 8;

__host__ __device__ __forceinline__ int lds_byte(int r, int c) { const int st = (r >> 4) * 2 + (c >> 5), rr = r & 15, cc = c & 31, ob = rr * 64 + cc * 2; return st * 1024 + (ob ^ (((ob >> 9) & 1) << 5)); }
__host__ __device__ __forceinline__ void stage_rc(int b, int& R, int& C) { const int st = b / 1024, sb = b % 1024, swz = sb ^ (((sb >> 9) & 1) << 5); R = (st >> 1) * 16 + swz / 64; C = (st & 1) * 32 + (swz % 64) / 2; }
__host__ __device__ __forceinline__ int perm32(int rho) { const int n = rho >> 4, i = rho & 15; return 8 * (i >> 2) + 4 * n + (i & 3); }

struct Unit { int pm, pn; };
struct Gemm { const bf16_t* A; const bf16_t* Bt; int M, N, K, lda; };

struct StaticOrder {
    int nM, nN, nwg, G, c;
    __host__ __device__ void init(int M, int N, int G_, int c_) { nM = M / BM; nN = N / BM; nwg = nM * nN; G = G_; c = c_; }
    __host__ __device__ bool next(int i, Unit& u) const {
        const long L = (long)i * G + c; if (L >= nwg) return false;
        int wgid = (int)L; { const int q = nwg / NXCD, r = nwg % NXCD, xcd = wgid % NXCD, off = wgid / NXCD; wgid = (xcd < r ? xcd * (q + 1) : r * (q + 1) + (xcd - r) * q) + off; }
        const int nig = WGM * nN, gid = wgid / nig, fm = gid * WGM, gsz = (nM - fm) < WGM ? (nM - fm) : WGM;
        u.pm = fm + ((wgid % nig) % gsz); u.pn = (wgid % nig) / gsz; return true;
    }
    __device__ __forceinline__ void a_ready(const Unit&) const {}
    __device__ __forceinline__ void done(const Unit&) const {}
};

__device__ __forceinline__ unsigned cvt_pk_bf16(float lo, float hi) { unsigned r; asm volatile("v_cvt_pk_bf16_f32 %0, %1, %2" : "=v"(r) : "v"(lo), "v"(hi)); return r; }
typedef float f32x2 __attribute__((ext_vector_type(2)));
__device__ __forceinline__ f32x2 gelu_pk(f32x2 v) {
    const f32x2 av = __builtin_elementwise_abs(v), d = av * 0.2316418882f + 1.0f;
    f32x2 t; t.x = __builtin_amdgcn_rcpf(d.x); t.y = __builtin_amdgcn_rcpf(d.y);
    f32x2 q = t * 0.5307027145f + (-0.7265760135f); q = q * t + 0.7107068705f; q = q * t + (-0.142248368f); q = q * t + 0.127414796f; q = q * t;
    const f32x2 s = (v * v) * (-0.72134752044f);
    f32x2 e; e.x = __builtin_amdgcn_exp2f(s.x); e.y = __builtin_amdgcn_exp2f(s.y);
    const f32x2 m = v * (q * e), r = v - m;
    f32x2 o; o.x = v.x < 0.f ? m.x : r.x; o.y = v.y < 0.f ? m.y : r.y; return o;
}

template <int ACT  > struct EpiBf16 {
    static constexpr bool PERM = true, AFTER_DRAIN = false; static_assert(ACT == 0 || ACT == 1, "EpiBf16: ACT is 0 (none) or 1 (gelu_pk)");
    bf16_t* O; int ldc; const float* bias; int split_cols; size_t split_stride; float scale0;
    __device__ __forceinline__ void operator()(const f32x4 (&acc)[2][2][4][2], const Unit& u, int wr, int wc, int fr, int fq) const {
        const int row0 = u.pm * BM + wr * 64 + fr; int colt = u.pn * BM; bf16_t* base = O;
        float sc = 1.f; if (split_cols) { const int t = colt / split_cols; base += (size_t)t * split_stride; colt -= t * split_cols; if (t == 0) sc = scale0; }
        const int col0 = colt + wc * 32 + 8 * fq, bcol0 = u.pn * BM + wc * 32 + 8 * fq;
        f32x4 bv[2][2];
#pragma unroll
        for (int bj = 0; bj < 2; ++bj)
#pragma unroll
            for (int n = 0; n < 2; ++n) bv[bj][n] = bias ? *(const f32x4*)(bias + bcol0 + bj * HALF + 4 * n) : (f32x4){0.f, 0.f, 0.f, 0.f};
#pragma unroll
        for (int ai = 0; ai < 2; ++ai)
#pragma unroll
            for (int m = 0; m < 4; ++m) { bf16_t* rowp = base + (size_t)(row0 + ai * HALF + m * 16) * ldc + col0;
#pragma unroll
                for (int bj = 0; bj < 2; ++bj) { f32x4 v0 = acc[ai][bj][m][0] + bv[bj][0], v1 = acc[ai][bj][m][1] + bv[bj][1];
                    if (ACT == 1) { f32x2 a = gelu_pk((f32x2){v0[0], v0[1]}), b = gelu_pk((f32x2){v0[2], v0[3]}), c = gelu_pk((f32x2){v1[0], v1[1]}), d = gelu_pk((f32x2){v1[2], v1[3]});
                        v0 = (f32x4){a.x, a.y, b.x, b.y}; v1 = (f32x4){c.x, c.y, d.x, d.y}; }
                    v0 = v0 * sc; v1 = v1 * sc; u32x4 w; w.x = cvt_pk_bf16(v0[0], v0[1]); w.y = cvt_pk_bf16(v0[2], v0[3]); w.z = cvt_pk_bf16(v1[0], v1[1]); w.w = cvt_pk_bf16(v1[2], v1[3]);
                    *(u32x4*)(rowp + bj * HALF) = w; } }
    }
};
template <class Epi, class Sched, bool ALIGN_EPI = false, bool SP2 = false>
__device__ __forceinline__ void gemm_phase(PG8_LAS unsigned char* lds, const Gemm g, const Sched& S, const Epi& E) {
    const int tid = opaque_tid(), wid = __builtin_amdgcn_readfirstlane(tid >> 6), lane = tid & 63, wr = wid >> 2, wc = wid & 3, fr = lane & 15, fq = lane >> 4;
    int Kq = g.K, ldq = g.lda; asm volatile("" : "+s"(Kq), "+s"(ldq));
    const int K = Kq, nt = K / BK, lda = ldq;
    unsigned voffA[2], voffB[2];
#pragma unroll
    for (int i = 0; i < 2; ++i) { int R, C; stage_rc(tid * 16 + i * 8192, R, C); const int Rb = Epi::PERM ? ((R & ~31) + perm32(R & 31)) : R;
        voffA[i] = (unsigned)(R * lda + C) * 2u; voffB[i] = (unsigned)(Rb * K + C) * 2u; }
    const size_t kstep = (size_t)(BK * 2);
    const size_t hstepA = (size_t)HALF * lda * 2, hstepB = (size_t)HALF * K * 2;
    const size_t tstepA = 2 * hstepA, tstepB = 2 * hstepB;
    const unsigned ldsw = (unsigned)wid * 1024u;
    const int aoff = lds_byte(wr * 64 + fr, fq * 8), boff = lds_byte(wc * 32 + fr, fq * 8);
#define PG8_SA(b, h) (((b) * 2 + (h)) * HTB)
#define PG8_SB(b, h) ((4 + (b) * 2 + (h)) * HTB)
#define PG8_STAGE(bufoff, gbase, voff) do { _Pragma("unroll") for (int _i = 0; _i < 2; ++_i) \
        __builtin_amdgcn_global_load_lds((const unsigned*)((const char*)(gbase) + (voff)[_i]), (PG8_LAS unsigned*)(lds + (bufoff) + ldsw + _i * 8192), 16, 0, 0); } while (0)
#define PG8_LDA(dst, b, h) do { _Pragma("unroll") for (int m = 0; m < 4; ++m) _Pragma("unroll") for (int k = 0; k < 2; ++k) dst[m][k] = *(const PG8_LAS bf16x8*)(lds + PG8_SA(b, h) + aoff + m * 2048 + k * 1024); } while (0)
#define PG8_LDB(dst, b, h) do { _Pragma("unroll") for (int n = 0; n < 2; ++n) _Pragma("unroll") for (int k = 0; k < 2; ++k) dst[n][k] = *(const PG8_LAS bf16x8*)(lds + PG8_SB(b, h) + boff + n * 2048 + k * 1024); } while (0)
#define PG8_MMA(ai, bj, At, Bt) do { __builtin_amdgcn_s_setprio(1); _Pragma("unroll") for (int m = 0; m < 4; ++m) _Pragma("unroll") for (int n = 0; n < 2; ++n) _Pragma("unroll") for (int k = 0; k < 2; ++k) \
        acc[ai][bj][m][n] = __builtin_amdgcn_mfma_f32_16x16x32_bf16(Bt[n][k], At[m][k], acc[ai][bj][m][n], 0, 0, 0); __builtin_amdgcn_s_setprio(0); } while (0)
#define PG8_WAIT_V(n) asm volatile("s_waitcnt vmcnt(" #n ")" ::: "memory")
#define PG8_WAIT_L(n) asm volatile("s_waitcnt lgkmcnt(" #n ")" ::: "memory")
#define PG8_BAR __builtin_amdgcn_s_barrier()
#define PG8_SCHED __builtin_amdgcn_sched_barrier(0)
    Unit cur, nxt; int ui = 0;
    if (!S.next(0, cur)) return;
    f32x4 acc[2][2][4][2];
#pragma unroll
    for (int a = 0; a < 2; ++a)
#pragma unroll
        for (int b = 0; b < 2; ++b)
#pragma unroll
            for (int m = 0; m < 4; ++m)
#pragma unroll
                for (int n = 0; n < 2; ++n) acc[a][b][m][n] = (f32x4){0.f, 0.f, 0.f, 0.f};
    bf16x8 At[4][2], B0[2][2], B1[2][2];
    const char* cA = (const char*)g.A + (size_t)cur.pm * tstepA; const char* cB = (const char*)g.Bt + (size_t)cur.pn * tstepB;
    S.a_ready(cur);
    if constexpr (SP2) {
        PG8_STAGE(PG8_SB(0, 0), cB, voffB); PG8_STAGE(PG8_SB(0, 1), cB + hstepB, voffB); PG8_STAGE(PG8_SA(0, 0), cA, voffA); PG8_STAGE(PG8_SA(0, 1), cA + hstepA, voffA);
        if (wr == 1) PG8_BAR;
        PG8_WAIT_V(2); PG8_BAR;
        PG8_STAGE(PG8_SB(1, 0), cB + kstep, voffB); PG8_STAGE(PG8_SA(1, 0), cA + kstep, voffA); PG8_STAGE(PG8_SB(1, 1), cB + hstepB + kstep, voffB);
        PG8_WAIT_V(6); PG8_BAR;
    } else {
        PG8_STAGE(PG8_SB(0, 0), cB, voffB); PG8_STAGE(PG8_SA(0, 0), cA, voffA); PG8_STAGE(PG8_SB(0, 1), cB + hstepB, voffB); PG8_STAGE(PG8_SA(0, 1), cA + hstepA, voffA);
        if (wr == 1) PG8_BAR;
        PG8_WAIT_V(4); PG8_BAR;
        PG8_STAGE(PG8_SB(1, 0), cB + kstep, voffB); PG8_STAGE(PG8_SA(1, 0), cA + kstep, voffA); PG8_STAGE(PG8_SB(1, 1), cB + hstepB + kstep, voffB);
        PG8_WAIT_V(6); PG8_BAR;
    }
    for (;;) {
        const bool has_next = S.next(ui + 1, nxt);
        const char* nA = has_next ? (const char*)g.A + (size_t)nxt.pm * tstepA : cA; const char* nB = has_next ? (const char*)g.Bt + (size_t)nxt.pn * tstepB : cB;
        for (int t = 0; t < nt; t += 2) {
            const bool last = (t == nt - 2);
            const char* a1 = cA + (size_t)(t + 1) * kstep;
            const char* a2 = last ? nA : cA + (size_t)(t + 2) * kstep; const char* b2 = last ? nB : cB + (size_t)(t + 2) * kstep;
            const char* a3 = a2 + kstep; const char* b3 = b2 + kstep;
            if (last && has_next) S.a_ready(nxt);
            if constexpr (SP2) {
            PG8_LDB(B0, 0, 0); PG8_LDB(B1, 0, 1); PG8_SCHED; PG8_LDA(At, 0, 0); PG8_STAGE(PG8_SA(1, 1), a1 + hstepA, voffA);
            PG8_WAIT_V(8); PG8_WAIT_L(0); PG8_BAR; PG8_MMA(0, 0, At, B0); PG8_MMA(0, 1, At, B1); PG8_BAR; PG8_SCHED;
            PG8_LDA(At, 0, 1); PG8_STAGE(PG8_SB(0, 0), b2, voffB); PG8_STAGE(PG8_SB(0, 1), b2 + hstepB, voffB); PG8_STAGE(PG8_SA(0, 0), a2, voffA);
            PG8_WAIT_V(8); PG8_WAIT_L(0); PG8_BAR; PG8_MMA(1, 0, At, B0); PG8_MMA(1, 1, At, B1); PG8_BAR; PG8_SCHED;
            PG8_LDB(B0, 1, 0); PG8_LDB(B1, 1, 1); PG8_SCHED; PG8_LDA(At, 1, 0); PG8_STAGE(PG8_SA(0, 1), a2 + hstepA, voffA);
            PG8_WAIT_V(8); PG8_WAIT_L(0); PG8_BAR; PG8_MMA(0, 0, At, B0); PG8_MMA(0, 1, At, B1); PG8_BAR; PG8_SCHED;
            PG8_LDA(At, 1, 1); PG8_STAGE(PG8_SB(1, 0), b3, voffB); PG8_STAGE(PG8_SB(1, 1), b3 + hstepB, voffB); PG8_STAGE(PG8_SA(1, 0), a3, voffA);
            PG8_WAIT_V(8); PG8_WAIT_L(0); PG8_BAR; PG8_MMA(1, 0, At, B0); PG8_MMA(1, 1, At, B1); PG8_BAR; PG8_SCHED;
            } else {
            PG8_LDB(B0, 0, 0); PG8_SCHED; PG8_LDA(At, 0, 0); PG8_STAGE(PG8_SA(1, 1), a1 + hstepA, voffA);
            PG8_WAIT_L(8); PG8_BAR; PG8_WAIT_L(0); PG8_MMA(0, 0, At, B0); PG8_BAR; PG8_SCHED;
            PG8_LDB(B1, 0, 1); PG8_STAGE(PG8_SB(0, 0), b2, voffB);
            PG8_BAR; PG8_WAIT_L(0); PG8_MMA(0, 1, At, B1); PG8_BAR;
            PG8_LDA(At, 0, 1); PG8_STAGE(PG8_SA(0, 0), a2, voffA);
            PG8_BAR; PG8_WAIT_L(0); PG8_MMA(1, 0, At, B0); PG8_BAR; PG8_SCHED;
            PG8_STAGE(PG8_SB(0, 1), b2 + hstepB, voffB);
            PG8_WAIT_V(6); PG8_BAR; PG8_MMA(1, 1, At, B1); PG8_BAR;
            PG8_LDB(B0, 1, 0); PG8_SCHED; PG8_LDA(At, 1, 0); PG8_STAGE(PG8_SA(0, 1), a2 + hstepA, voffA);
            PG8_WAIT_L(8); PG8_BAR; PG8_WAIT_L(0); PG8_MMA(0, 0, At, B0); PG8_BAR; PG8_SCHED;
            PG8_LDB(B1, 1, 1); PG8_STAGE(PG8_SB(1, 0), b3, voffB);
            PG8_BAR; PG8_WAIT_L(0); PG8_MMA(0, 1, At, B1); PG8_BAR;
            PG8_LDA(At, 1, 1); PG8_STAGE(PG8_SA(1, 0), a3, voffA);
            PG8_BAR; PG8_WAIT_L(0); PG8_MMA(1, 0, At, B0); PG8_BAR; PG8_SCHED;
            PG8_STAGE(PG8_SB(1, 1), b3 + hstepB, voffB);
            PG8_WAIT_V(6); PG8_BAR; PG8_MMA(1, 1, At, B1); PG8_BAR;
            }
        }
        if constexpr (ALIGN_EPI) { if (wr == 0) PG8_BAR; }
        if constexpr (!Epi::AFTER_DRAIN) { E(acc, cur, wr, wc, fr, fq); S.done(cur); }
        if (!has_next) break;
#pragma unroll
        for (int a = 0; a < 2; ++a)
#pragma unroll
            for (int b = 0; b < 2; ++b)
#pragma unroll
                for (int m = 0; m < 4; ++m)
#pragma unroll
                    for (int n = 0; n < 2; ++n) acc[a][b][m][n] = (f32x4){0.f, 0.f, 0.f, 0.f};
        cur = nxt; cA = nA; cB = nB; ++ui;
        if constexpr (ALIGN_EPI) { if (wr == 1) PG8_BAR; }
    }
    PG8_WAIT_V(0);
    if constexpr (!ALIGN_EPI) { if (wr == 0) PG8_BAR; }
    PG8_BAR;
    if constexpr (Epi::AFTER_DRAIN) { E.fused(acc, cur, wr, wc, fr, fq, lds, wid, lane); S.done(cur); }
#undef PG8_SA
#undef PG8_SB
#undef PG8_STAGE
#undef PG8_LDA
#undef PG8_LDB
#undef PG8_MMA
#undef PG8_WAIT_V
#undef PG8_WAIT_L
#undef PG8_BAR
#undef PG8_SCHED
}
}

#ifndef PG8_SP2
#define PG8_SP2 true
#endif
#ifndef PG8_ALIGN
#define PG8_ALIGN true
#endif

namespace pg8 {
struct EpiResF32 {
    static constexpr bool PERM = false, AFTER_DRAIN = false;
    const float* base; float* out; int ldc;
    __device__ __forceinline__ void operator()(const f32x4 (&acc)[2][2][4][2], const Unit& u, int wr, int wc, int fr, int fq) const {
        const int col0 = u.pn * BM + wc * 32 + 4 * fq;
#pragma unroll
        for (int ai = 0; ai < 2; ++ai)
#pragma unroll
            for (int m = 0; m < 4; ++m) { const size_t off = (size_t)(u.pm * BM + ai * HALF + wr * 64 + m * 16 + fr) * ldc + col0;
#pragma unroll
                for (int bj = 0; bj < 2; ++bj)
#pragma unroll
                    for (int n = 0; n < 2; ++n) { const f32x4 b = *(const f32x4*)(base + off + bj * HALF + n * 16); *(f32x4*)(out + off + bj * HALF + n * 16) = b + acc[ai][bj][m][n]; } }
    }
};
}

constexpr int GEMM_LDS = pg8::STAGE_BYTES;

__device__ __forceinline__ void rope_table_elem(float* ct, float* st, int idx) {
    const int pos = idx >> 5, j = idx & 31;
    const float freq = exp2f(-(float)j * (13.287712379549449f / 32.0f));
    const float ang = (float)pos * freq;
    double rev = (double)ang * 0.15915494309189535;
    rev -= floor(rev);
    const float fr = (float)rev;
    ct[idx] = __builtin_amdgcn_cosf(fr);
    st[idx] = __builtin_amdgcn_sinf(fr);
}

__device__ __forceinline__ int win_src_col(int n) {
    if (n < 2560) return n;
    if (n < 3072) return n - 2560 + 3304;
    if (n < 3456) return n - 3072 + 2632;
    if (n < 3712) return n - 3456 + 3016;
    if (n < 3776) return n - 3712 + 2560;
    if (n < 3808) return n - 3776 + 3272;
    if (n < 3816) return n - 3808 + 2624;
    return -1;
}
__device__ __forceinline__ int win_phys2src(int n) {
    const int tile = n >> 8, p = n & 255, bj = p >> 7, wcc = (p >> 5) & 3, i = p & 31;
    const int pairdim = 16 * ((i >> 2) & 1) + 4 * (i >> 3) + (i & 3);
    int logical = n;
    if (tile < 4) logical = ((tile < 2) ? C_QA : C_KA) + 64 * (4 * (tile & 1) + wcc) + 32 * bj + i;
    else if (tile == 8 || tile == 9) logical = C_QI + 64 * (4 * (tile - 8) + wcc) + (bj ? 32 + i : pairdim);
    else if (tile == 14 && bj == 1 && wcc == 0) logical = C_KI + pairdim;
    return win_src_col(logical);
}
__device__ __forceinline__ int wukv_phys2src(int n) {
    const int t = n >> 8, p = n & 255, bj = p >> 7, wcc = (p >> 5) & 3, i = p & 31;
    return 128 * (2 * t + (wcc >> 1)) + 64 * (wcc & 1) + 32 * bj + i;
}
__device__ __forceinline__ void wtrans_tile(LAS float* t, const float* __restrict__ W, int K, int Nold, bf16* __restrict__ WT, int n0, int k0, int mode, const float* __restrict__ gain, int tid) {
    __syncthreads();
    for (int i = tid; i < 4096; i += 512) { const int kk = i >> 6, nn = i & 63; const int n = n0 + nn; const int src = (mode == 1) ? win_phys2src(n) : (mode == 2) ? wukv_phys2src(n) : n;
        float v = (src >= 0) ? W[(size_t)(k0 + kk) * Nold + src] : 0.f; if (gain) v *= gain[k0 + kk];
        t[kk * 65 + nn] = v; }
    __syncthreads();
    for (int i = tid; i < 4096; i += 512) { const int nn = i >> 6, kk = i & 63; WT[(size_t)(n0 + nn) * K + k0 + kk] = (bf16)f2bf(t[kk * 65 + nn]); }
}

__device__ __forceinline__ float wave_sum(float v) {
#pragma unroll
    for (int o = 1; o < 64; o <<= 1) v += __shfl_xor(v, o);
    return v;
}
__device__ __forceinline__ void rmsnorm_x_row(const float* __restrict__ x, const float* __restrict__ g, bf16* __restrict__ xn, int row, int lane) {
    const f32x4_t* xr = (const f32x4_t*)(x + (size_t)row * DMODEL) + lane;
    const f32x4_t* gr = (const f32x4_t*)g + lane;
    f32x4_t v[4]; float s = 0.f;
#pragma unroll
    for (int j = 0; j < 4; ++j) { v[j] = xr[64 * j]; s += (v[j].x * v[j].x + v[j].y * v[j].y) + (v[j].z * v[j].z + v[j].w * v[j].w); }
    const float rs = 1.0f / sqrtf(wave_sum(s) * (1.0f / DMODEL) + RMS_EPS);
    u32x2_t* o = (u32x2_t*)(xn + (size_t)row * DMODEL) + lane;
#pragma unroll
    for (int j = 0; j < 4; ++j) { const f32x4_t gg = gr[64 * j]; u32x2_t w; w.x = pk2(v[j].x * rs * gg.x, v[j].y * rs * gg.y); w.y = pk2(v[j].z * rs * gg.z, v[j].w * rs * gg.w); o[64 * j] = w; }
}


namespace pg8 {
__device__ __forceinline__ float silu_f(float g) { return g * __builtin_amdgcn_rcpf(1.0f + __builtin_amdgcn_exp2f(g * -1.4426950408889634f)); }
__device__ __forceinline__ float fq_sum(float v) {
    const auto a = __builtin_amdgcn_permlane16_swap(__float_as_uint(v), __float_as_uint(v), false, false);
    v = __uint_as_float(a[0]) + __uint_as_float(a[1]);
    const auto b = __builtin_amdgcn_permlane32_swap(__float_as_uint(v), __float_as_uint(v), false, false);
    return __uint_as_float(b[0]) + __uint_as_float(b[1]);
}
__device__ __forceinline__ float dot4(const f32x4 a) { return (a[0] * a[0] + a[1] * a[1]) + (a[2] * a[2] + a[3] * a[3]); }
__device__ __forceinline__ u32x4 pack8(const f32x4 a, const f32x4 b) { u32x4 w; w.x = cvt_pk_bf16(a[0], a[1]); w.y = cvt_pk_bf16(a[2], a[3]); w.z = cvt_pk_bf16(b[0], b[1]); w.w = cvt_pk_bf16(b[2], b[3]); return w; }
typedef unsigned u32x2 __attribute__((ext_vector_type(2)));
__device__ __forceinline__ u32x2 pack4(const f32x4 a) { u32x2 w; w.x = cvt_pk_bf16(a[0], a[1]); w.y = cvt_pk_bf16(a[2], a[3]); return w; }

struct EpiProj {
    static constexpr bool PERM = true, AFTER_DRAIN = false;
    bf16_t* P; float* ssq; const float* aq_g; const float* ak_g; const float* rc; const float* rs;
    __device__ __forceinline__ void operator()(const f32x4 (&acc)[2][2][4][2], const Unit& u, int wr, int wc, int fr, int fq) const {
        asm volatile("" : "+v"(fr), "+v"(fq));
        const int tile = u.pn; const int row0 = u.pm * BM + wr * 64 + fr;
        if (tile < 4) {
            const bool isk = tile >= 2; const float* g = isk ? ak_g : aq_g; const float sc = isk ? 1.0f : C2A;
            const int colbase = (isk ? C_KA : C_QA) + 64 * (4 * (tile & 1) + wc) + 8 * fq;
            const f32x4 g1a = *(const f32x4*)(g + 8 * fq), g1b = *(const f32x4*)(g + 8 * fq + 4), g2a = *(const f32x4*)(g + 32 + 8 * fq), g2b = *(const f32x4*)(g + 36 + 8 * fq);
#pragma unroll
            for (int ai = 0; ai < 2; ++ai)
#pragma unroll
                for (int m = 0; m < 4; ++m) {
                    const int row = row0 + ai * HALF + m * 16, pos = row & (SEQ - 1);
                    const f32x4 x1a = acc[ai][0][m][0], x1b = acc[ai][0][m][1], x2a = acc[ai][1][m][0], x2b = acc[ai][1][m][1];
                    float ss = (dot4(x1a) + dot4(x1b)) + (dot4(x2a) + dot4(x2b));
                    ss = fq_sum(ss);
                    const float rn = sc * __builtin_amdgcn_rsqf(ss * (1.0f / 64.0f) + RMS_EPS);
                    const float* cp = rc + pos * 32 + 8 * fq; const float* sp = rs + pos * 32 + 8 * fq;
                    const f32x4 ca = *(const f32x4*)cp, cb = *(const f32x4*)(cp + 4), sa = *(const f32x4*)sp, sb = *(const f32x4*)(sp + 4);
                    const f32x4 a0 = x1a * rn * g1a, a1 = x1b * rn * g1b, b0 = x2a * rn * g2a, b1 = x2b * rn * g2b;
                    bf16_t* dst = P + (size_t)row * NP + colbase;
                    *(u32x4*)dst = pack8(a0 * ca - b0 * sa, a1 * cb - b1 * sb);
                    *(u32x4*)(dst + 32) = pack8(b0 * ca + a0 * sa, b1 * cb + a1 * sb);
                }
        } else if (tile == 8 || tile == 9) {
            const int colbase = C_QI + 64 * (4 * (tile - 8) + wc);
#pragma unroll
            for (int ai = 0; ai < 2; ++ai)
#pragma unroll
                for (int m = 0; m < 4; ++m) {
                    const int row = row0 + ai * HALF + m * 16, pos = row & (SEQ - 1);
                    const float* cp = rc + pos * 32 + 8 * fq; const float* sp = rs + pos * 32 + 8 * fq;
                    const f32x4 c0 = *(const f32x4*)cp, c1 = *(const f32x4*)(cp + 4), s0 = *(const f32x4*)sp, s1 = *(const f32x4*)(sp + 4);
                    const f32x4 c = (f32x4){c0[0], c0[2], c1[0], c1[2]}, s = (f32x4){s0[0], s0[2], s1[0], s1[2]};
                    const f32x4 x1 = acc[ai][0][m][0], x2 = acc[ai][0][m][1];
                    bf16_t* dst = P + (size_t)row * NP + colbase;
                    *(u32x2*)(dst + 4 * fq) = pack4(x1 * c - x2 * s);
                    *(u32x2*)(dst + 16 + 4 * fq) = pack4(x2 * c + x1 * s);
                    *(u32x4*)(dst + 32 + 8 * fq) = pack8(acc[ai][1][m][0], acc[ai][1][m][1]);
                }
        } else if (tile == 14) {
#pragma unroll
            for (int ai = 0; ai < 2; ++ai)
#pragma unroll
                for (int m = 0; m < 4; ++m) {
                    const int row = row0 + ai * HALF + m * 16, pos = row & (SEQ - 1);
                    bf16_t* dst = P + (size_t)row * NP + tile * BM;
                    float ss = dot4(acc[ai][0][m][0]) + dot4(acc[ai][0][m][1]);
                    ss = fq_sum(ss);
                    if (fq == 0) ssq[(size_t)row * 24 + 16 + wc] = ss;
                    *(u32x4*)(dst + 32 * wc + 8 * fq) = pack8(acc[ai][0][m][0], acc[ai][0][m][1]);
                    if (wc == 0) {
                        const float* cp = rc + pos * 32 + 8 * fq; const float* sp = rs + pos * 32 + 8 * fq;
                        const f32x4 c0 = *(const f32x4*)cp, c1 = *(const f32x4*)(cp + 4), s0 = *(const f32x4*)sp, s1 = *(const f32x4*)(sp + 4);
                        const f32x4 c = (f32x4){c0[0], c0[2], c1[0], c1[2]}, s = (f32x4){s0[0], s0[2], s1[0], s1[2]};
                        const f32x4 x1 = acc[ai][1][m][0], x2 = acc[ai][1][m][1];
                        *(u32x2*)(dst + HALF + 4 * fq) = pack4(x1 * c - x2 * s);
                        *(u32x2*)(dst + HALF + 16 + 4 * fq) = pack4(x2 * c + x1 * s);
                    } else {
                        *(u32x4*)(dst + HALF + 32 * wc + 8 * fq) = pack8(acc[ai][1][m][0], acc[ai][1][m][1]);
                    }
                }
        } else {
            const bool gate = (tile == 6 || tile == 7 || tile == 10 || tile == 11), lat = (tile >= 12);
#pragma unroll
            for (int ai = 0; ai < 2; ++ai)
#pragma unroll
                for (int m = 0; m < 4; ++m) {
                    const int row = row0 + ai * HALF + m * 16;
                    bf16_t* dst = P + (size_t)row * NP + tile * BM + 32 * wc + 8 * fq;
#pragma unroll
                    for (int bj = 0; bj < 2; ++bj) {
                        f32x4 v0 = acc[ai][bj][m][0], v1 = acc[ai][bj][m][1];
                        if (lat) { float ss = dot4(v0) + dot4(v1); ss = fq_sum(ss);
                            if (fq == 0) ssq[(size_t)row * 24 + (tile == 12 ? 4 * bj : 8 + 4 * bj) + wc] = ss; }
                        if (gate) { v0 = (f32x4){silu_f(v0[0]), silu_f(v0[1]), silu_f(v0[2]), silu_f(v0[3])}; v1 = (f32x4){silu_f(v1[0]), silu_f(v1[1]), silu_f(v1[2]), silu_f(v1[3])}; }
                        *(u32x4*)(dst + bj * HALF) = pack8(v0, v1);
                    }
                }
        }
    }
};

struct EpiKV {
    static constexpr bool PERM = true, AFTER_DRAIN = false;
    bf16_t* KB; bf16_t* VB; const bf16_t* P; const float* ssq; const float* bk_g; const float* rc; const float* rs;
    __device__ __forceinline__ float row_rkv(int row) const {
        const f32x4 q0 = *(const f32x4*)(ssq + (size_t)row * 24 + 12), q1 = *(const f32x4*)(ssq + (size_t)row * 24 + 16);
        return __builtin_amdgcn_rsqf((((q0[0] + q0[1]) + (q0[2] + q0[3])) + ((q1[0] + q1[1]) + (q1[2] + q1[3]))) * (1.0f / 256.0f) + RMS_EPS);
    }
    __device__ __forceinline__ void operator()(const f32x4 (&acc)[2][2][4][2], const Unit& u, int wr, int wc, int fr, int fq) const {
        asm volatile("" : "+v"(fr), "+v"(fq));
        const int head = 2 * u.pn + (wc >> 1); const int row0 = u.pm * BM + wr * 64 + fr;
        if (wc & 1) {
#pragma unroll
            for (int ai = 0; ai < 2; ++ai)
#pragma unroll
                for (int m = 0; m < 4; ++m) {
                    const int row = row0 + ai * HALF + m * 16;
                    const float rkv = row_rkv(row);
                    bf16_t* dst = VB + (size_t)row * 512 + 64 * head + 8 * fq;
#pragma unroll
                    for (int bj = 0; bj < 2; ++bj) *(u32x4*)(dst + 32 * bj) = pack8(acc[ai][bj][m][0] * rkv, acc[ai][bj][m][1] * rkv);
                    asm volatile("" ::: "memory");
                }
        } else {
#pragma unroll
            for (int ai = 0; ai < 2; ++ai)
#pragma unroll
                for (int m = 0; m < 4; ++m) {
                    const int row = row0 + ai * HALF + m * 16, pos = row & (SEQ - 1);
                    const float rkv = row_rkv(row);
                    const u32x2 k1 = *(const u32x2*)(P + (size_t)row * NP + C_KR + 4 * fq), k2 = *(const u32x2*)(P + (size_t)row * NP + C_KR + 16 + 4 * fq);
                    const f32x4 x1 = (f32x4){bflo(k1.x), bfhi(k1.x), bflo(k1.y), bfhi(k1.y)}, x2 = (f32x4){bflo(k2.x), bfhi(k2.x), bflo(k2.y), bfhi(k2.y)};
                    float ssn = (dot4(acc[ai][0][m][0]) + dot4(acc[ai][0][m][1])) + (dot4(acc[ai][1][m][0]) + dot4(acc[ai][1][m][1]));
                    float ssr = dot4(x1) + dot4(x2);
                    ssn = fq_sum(ssn); ssr = fq_sum(ssr);
                    const float rk = __builtin_amdgcn_rsqf((ssn * rkv * rkv + ssr) * (1.0f / 96.0f) + RMS_EPS);
                    bf16_t* dst = KB + (size_t)row * 768 + 96 * head;
                    const float sn = rkv * rk;
#pragma unroll
                    for (int bj = 0; bj < 2; ++bj) { const f32x4 g0 = *(const f32x4*)(bk_g + 32 * bj + 8 * fq), g1 = *(const f32x4*)(bk_g + 32 * bj + 8 * fq + 4);
                        *(u32x4*)(dst + 32 * bj + 8 * fq) = pack8(acc[ai][bj][m][0] * sn * g0, acc[ai][bj][m][1] * sn * g1); }
                    const f32x4 gr1 = *(const f32x4*)(bk_g + 64 + 4 * fq), gr2 = *(const f32x4*)(bk_g + 80 + 4 * fq);
                    const float* cp = rc + pos * 32 + 8 * fq; const float* sp = rs + pos * 32 + 8 * fq;
                    const f32x4 c0 = *(const f32x4*)cp, c1 = *(const f32x4*)(cp + 4), s0 = *(const f32x4*)sp, s1 = *(const f32x4*)(sp + 4);
                    const f32x4 c = (f32x4){c0[0], c0[2], c1[0], c1[2]}, s = (f32x4){s0[0], s0[2], s1[0], s1[2]};
                    const f32x4 a = x1 * rk * gr1, b = x2 * rk * gr2;
                    *(u32x2*)(dst + 64 + 4 * fq) = pack4(a * c - b * s);
                    *(u32x2*)(dst + 80 + 4 * fq) = pack4(b * c + a * s);
                    asm volatile("" ::: "memory");
                }
        }
    }
};
}

constexpr int IDX_KPITCH = 2048 * 4 + 16;
constexpr int IDX_QPITCH = 1040;
constexpr int IDX_KEYS = 0, IDX_QT = 16 * IDX_KPITCH, IDX_W = IDX_QT + 16 * IDX_QPITCH, IDX_M = IDX_W + 16 * 8 * 4, IDX_MP = 65, IDX_END = IDX_M + 32 * IDX_MP * 4;
constexpr int TOPK = 256;
typedef float f32x4i_t __attribute__((ext_vector_type(4)));

__device__ __forceinline__ unsigned wave_sum_u32(unsigned v) {
    v += (unsigned)__builtin_amdgcn_update_dpp(0, (int)v, 0xB1, 0xF, 0xF, false);
    v += (unsigned)__builtin_amdgcn_update_dpp(0, (int)v, 0x4E, 0xF, 0xF, false);
    v += (unsigned)__builtin_amdgcn_update_dpp(0, (int)v, 0x141, 0xF, 0xF, false);
    v += (unsigned)__builtin_amdgcn_update_dpp(0, (int)v, 0x140, 0xF, 0xF, false);
    const auto a = __builtin_amdgcn_permlane16_swap(v, v, false, false); v = a[0] + a[1];
    const auto b = __builtin_amdgcn_permlane32_swap(v, v, false, false); return b[0] + b[1];
}
__device__ __forceinline__ unsigned wave_incl_scan_u32(unsigned v) {
    v += (unsigned)__builtin_amdgcn_update_dpp(0, (int)v, 0x111, 0xF, 0xF, false);
    v += (unsigned)__builtin_amdgcn_update_dpp(0, (int)v, 0x112, 0xF, 0xF, false);
    v += (unsigned)__builtin_amdgcn_update_dpp(0, (int)v, 0x114, 0xF, 0xF, false);
    v += (unsigned)__builtin_amdgcn_update_dpp(0, (int)v, 0x118, 0xF, 0xF, false);
    v += (unsigned)__builtin_amdgcn_update_dpp(0, (int)v, 0x142, 0xA, 0xF, false);
    v += (unsigned)__builtin_amdgcn_update_dpp(0, (int)v, 0x143, 0xC, 0xF, false);
    return v;
}
__device__ __forceinline__ unsigned sortable_key(float x) { const unsigned u = __builtin_bit_cast(unsigned, x + 0.0f); return (u & 0x80000000u) ? ~u : (u | 0x80000000u); }

__device__ __forceinline__ void indexer_unit(LAS unsigned char* lds, const bf16* __restrict__ proj, unsigned long long* __restrict__ mask, int b, int qb) {
    const int tid = opaque_tid(), lane = tid & 63, w = __builtin_amdgcn_readfirstlane(tid >> 6);
    const int L = 64 * ((qb >> 1) + 1), nt32 = L >> 5;
    unsigned long long* mbase = mask + ((size_t)(b * 64 + qb) * 64) * 16;
    if (L <= TOPK) {
        for (int j = w; j < nt32; j += 8) if (lane < 16) mbase[(size_t)j * 16 + lane] = ~0ull;
        return;
    }
    const int ni = L >> 6, nt16 = L >> 4;
    LAS unsigned* Mw = (LAS unsigned*)(lds + IDX_M);
    for (int sub = 0; sub < 2; ++sub) {
        const size_t row0 = (size_t)b * SEQ + 32 * qb + 16 * sub;
        __syncthreads();
        for (int c = tid; c < 16 * 64; c += 512) { const int r = c >> 6, ch = c & 63;
            *(LAS u32x4_t*)(lds + IDX_QT + r * IDX_QPITCH + ch * 16) = *(const u32x4_t*)(proj + (row0 + r) * NP + C_QI + ch * 8); }
        if (tid < 128) { const int q = tid & 15, hh = tid >> 4; ((LAS float*)(lds + IDX_W))[hh * 16 + q] = bf2f(proj[(row0 + q) * NP + C_WI + hh]); }
        __syncthreads();
        {
            const int q = lane & 15, g = lane >> 4;
            const LAS unsigned char* qrow = lds + IDX_QT + q * IDX_QPITCH + g * 16;
            const LAS float* wl = (const LAS float*)(lds + IDX_W) + q;
            bf16x8_t qf[8][2]; float wv[8];
#pragma unroll
            for (int h = 0; h < 8; ++h) { qf[h][0] = *(const LAS bf16x8_t*)(qrow + (64 * h) * 2); qf[h][1] = *(const LAS bf16x8_t*)(qrow + (64 * h + 32) * 2); wv[h] = wl[h * 16]; }
            const bf16* kp = proj + ((size_t)b * SEQ + q) * NP + C_KI + 8 * g;
            bf16x8_t kn0 = *(const bf16x8_t*)(kp + (size_t)(16 * w) * NP), kn1 = *(const bf16x8_t*)(kp + (size_t)(16 * w) * NP + 32);
            for (int j = w; j < nt16; j += 8) {
                const bf16x8_t kf0 = kn0, kf1 = kn1;
                if (j + 8 < nt16) { kn0 = *(const bf16x8_t*)(kp + (size_t)(16 * (j + 8)) * NP); kn1 = *(const bf16x8_t*)(kp + (size_t)(16 * (j + 8)) * NP + 32); }
                f32x4i_t tot = (f32x4i_t){0.f, 0.f, 0.f, 0.f};
#pragma unroll
                for (int h = 0; h < 8; ++h) {
                    f32x4i_t acc = (f32x4i_t){0.f, 0.f, 0.f, 0.f};
                    acc = __builtin_amdgcn_mfma_f32_16x16x32_bf16(kf0, qf[h][0], acc, 0, 0, 0);
                    acc = __builtin_amdgcn_mfma_f32_16x16x32_bf16(kf1, qf[h][1], acc, 0, 0, 0);
#pragma unroll
                    for (int r = 0; r < 4; ++r) tot[r] = fmaf(wv[h], fmaxf(acc[r], 0.f), tot[r]);
                }
                u32x4_t kk; kk.x = sortable_key(tot[0]); kk.y = sortable_key(tot[1]); kk.z = sortable_key(tot[2]); kk.w = sortable_key(tot[3]);
                *(LAS u32x4_t*)(lds + IDX_KEYS + q * IDX_KPITCH + (16 * j + 4 * g) * 4) = kk;
            }
            const int Lr = (L + 255) & ~255;
            for (int c = tid; c < 16 * ((Lr - L) >> 2); c += 512) { const int r = c / ((Lr - L) >> 2), ch = c % ((Lr - L) >> 2);
                *(LAS u32x4_t*)(lds + IDX_KEYS + r * IDX_KPITCH + (L + 4 * ch) * 4) = (u32x4_t){0u, 0u, 0u, 0u}; }
        }
        __syncthreads();
#pragma unroll 1
        for (int qi = 0; qi < 2; ++qi) {
            const int q = 2 * w + qi;
            const LAS unsigned* krow = (const LAS unsigned*)(lds + IDX_KEYS + q * IDX_KPITCH) + lane;
            unsigned key[32];
#pragma unroll
            for (int i4 = 0; i4 < 8; ++i4) {
                if (4 * i4 < ni) {
#pragma unroll
                    for (int i = 4 * i4; i < 4 * i4 + 4; ++i) key[i] = krow[64 * i];
                } else {
#pragma unroll
                    for (int i = 4 * i4; i < 4 * i4 + 4; ++i) key[i] = 0u;
                } }
            LAS unsigned* hist = (LAS unsigned*)(lds + IDX_QT) + w * 336;
            unsigned T = 0u; int need = TOPK, ceq = 0; const unsigned dummy = 256u + (unsigned)lane;
#pragma unroll
            for (int pass = 0; pass < 4; ++pass) {
                const int shift = 24 - 8 * pass;
                ((LAS u32x4_t*)hist)[lane] = (u32x4_t){0u, 0u, 0u, 0u};
                asm volatile("s_waitcnt lgkmcnt(0)" ::: "memory");
#pragma unroll
                for (int i4 = 0; i4 < 8; ++i4) if (4 * i4 < ni) {
#pragma unroll
                    for (int i = 4 * i4; i < 4 * i4 + 4; ++i) {
                        const unsigned k = key[i];
                        const bool mt = (pass == 0) ? true : ((k >> ((shift + 8) & 31)) == (T >> ((shift + 8) & 31)));
                        __hip_atomic_fetch_add(hist + (mt ? ((k >> shift) & 255u) : dummy), 1u, __ATOMIC_RELAXED, __HIP_MEMORY_SCOPE_WORKGROUP);
                    } }
                asm volatile("s_waitcnt lgkmcnt(0)" ::: "memory");
                const int base = 4 * (63 - lane);
                const u32x4_t h4 = *(const LAS u32x4_t*)(hist + base);
                const unsigned s = (h4.x + h4.y) + (h4.z + h4.w);
                const unsigned pin = wave_incl_scan_u32(s);
                const unsigned long long bm = __ballot(pin >= (unsigned)need);
                const int ls = __builtin_amdgcn_readfirstlane(__builtin_ctzll(bm | 0x8000000000000000ull));
                unsigned c = pin - s; int dig; unsigned kn, ce;
                if (c + h4.w >= (unsigned)need) { dig = base + 3; kn = (unsigned)need - c; ce = h4.w; }
                else { c += h4.w;
                    if (c + h4.z >= (unsigned)need) { dig = base + 2; kn = (unsigned)need - c; ce = h4.z; }
                    else { c += h4.z;
                        if (c + h4.y >= (unsigned)need) { dig = base + 1; kn = (unsigned)need - c; ce = h4.y; }
                        else { c += h4.y; dig = base; kn = (unsigned)need - c; ce = h4.x; } } }
                const unsigned digit = (unsigned)__builtin_amdgcn_readlane(dig, ls);
                need = __builtin_amdgcn_readlane((int)kn, ls); ceq = __builtin_amdgcn_readlane((int)ce, ls);
                T |= digit << shift;
            }
            const int cge = (ceq == need) ? TOPK : TOPK + 1;
            int taken = 0; unsigned mlo = 0u, mhi = 0u;
#define IDX_SELSTEP(I) { unsigned long long sel; \
                if (cge == TOPK) sel = __ballot(key[I] >= T && key[I] != 0u); \
                else { const bool eq = key[I] == T; const unsigned long long em = __ballot(eq); \
                       const int rank = taken + (int)__builtin_amdgcn_mbcnt_hi((unsigned)(em >> 32), __builtin_amdgcn_mbcnt_lo((unsigned)em, 0u)); \
                       sel = __ballot(key[I] > T || (eq && rank < need)); taken += __popcll(em); } \
                const unsigned slo = (unsigned)sel, shi = (unsigned)(sel >> 32); \
                asm volatile("v_writelane_b32 %0, %1, %2" : "+v"(mlo) : "s"(slo), "n"(I)); asm volatile("v_writelane_b32 %0, %1, %2" : "+v"(mhi) : "s"(shi), "n"(I)); }
#define IDX_SELGRP(G) if (4 * (G) < ni) { IDX_SELSTEP(4 * (G)) IDX_SELSTEP(4 * (G) + 1) IDX_SELSTEP(4 * (G) + 2) IDX_SELSTEP(4 * (G) + 3) }
            IDX_SELGRP(0) IDX_SELGRP(1) IDX_SELGRP(2) IDX_SELGRP(3) IDX_SELGRP(4) IDX_SELGRP(5) IDX_SELGRP(6) IDX_SELGRP(7)
#undef IDX_SELGRP
#undef IDX_SELSTEP
            if (lane < 32) { LAS unsigned* mrow = Mw + (16 * sub + q) * IDX_MP; mrow[2 * lane] = mlo; mrow[2 * lane + 1] = mhi; }
        }
    }
    __syncthreads();
    {
        const int q = lane & 31, hi = lane >> 5;
        for (int j = w; j < nt32; j += 8) {
            const unsigned h2 = Mw[q * IDX_MP + j] >> (4 * hi);
            unsigned long long mine = 0ull;
#pragma unroll
            for (int r = 0; r < 16; ++r) { const unsigned long long bal = __ballot(((h2 >> ((r & 3) + 8 * (r >> 2))) & 1u) != 0u); if (lane == r) mine = bal; }
            if (lane < 16) mbase[(size_t)j * 16 + lane] = mine;
        }
    }
}

struct AttnArgs { const bf16* Q; const bf16* K; const bf16* V; const bf16* G; bf16* O; const unsigned long long* mask; const float* ssq; const float* qg; const float* rc; const float* rs;
                  int qpitch, qhs, kpitch, khs, vpitch, vhs, gpitch, ocol; };
namespace fa {
using bf16x8=__attribute__((ext_vector_type(8)))short;
using s16x4=__attribute__((ext_vector_type(4)))short;
using f32x16=__attribute__((ext_vector_type(16)))float;
using u32x4=__attribute__((ext_vector_type(4)))unsigned;
constexpr int SEQ=2048,D=64;
constexpr int NW=8,QBLK=32,QB=QBLK*NW,KVBLK=64,NQB=SEQ/QB;
__device__ __forceinline__ int crow(int r,int hi){return (r&3)+8*(r>>2)+4*hi;}
#define SBAR() __builtin_amdgcn_sched_barrier(0)
__device__ __forceinline__ void allneg(f32x16&p0,f32x16&p1){
  const float NEG=-INFINITY;
  #pragma unroll
  for(int r=0;r<16;++r){p0[r]=NEG;p1[r]=NEG;}
}

constexpr int NSLOT=3, SLOTB=8192, SLOTKMAX=12288;
constexpr int LDS_K=0, LDS_V=NSLOT*SLOTKMAX, LDS_WS=LDS_V+NSLOT*SLOTB, LDS_OST=LDS_WS+NW*64*4, LDS_BYTES=LDS_OST+NW*4096;
__device__ __forceinline__ void glds16(const void*gsrc,unsigned lds_dst){unsigned keep;
  asm volatile("s_mov_b32 %0, m0\n\ts_mov_b32 m0, %2\n\ts_nop 0\n\tglobal_load_lds_dwordx4 %1, off\n\ts_mov_b32 m0, %0":"=&s"(keep):"v"(gsrc),"s"(lds_dst):"memory");}
__device__ __forceinline__ float max3f(float a,float b,float c){float r;asm("v_max3_f32 %0, %1, %2, %3":"=v"(r):"v"(a),"v"(b),"v"(c));return r;}
__device__ __forceinline__ float max2f(float a,float b){float r;asm("v_max_f32_e32 %0, %1, %2":"=v"(r):"v"(a),"v"(b));return r;}
__device__ __forceinline__ float fadd_s(float a,float b){float r;asm("v_add_f32_e32 %0, %1, %2":"=v"(r):"v"(a),"v"(b));return r;}
__device__ __forceinline__ float fsub_s(float a,float b){float r;asm("v_sub_f32_e32 %0, %1, %2":"=v"(r):"v"(a),"v"(b));return r;}
typedef float f32x2_t __attribute__((ext_vector_type(2))); typedef __bf16 bf16x2_t __attribute__((ext_vector_type(2)));
__device__ __forceinline__ unsigned cvtpk_s(float lo,float hi){f32x2_t v={lo,hi};bf16x2_t b=__builtin_convertvector(v,bf16x2_t);return __builtin_bit_cast(unsigned,b);}
#define WAIT_BAR(N) asm volatile("s_waitcnt vmcnt(" #N ") lgkmcnt(0)\n\ts_barrier":::"memory")

template<int NS> __device__ __forceinline__ void qkt(f32x16&p0,f32x16&p1,const char*Kslot,const bf16x8*qr,int r32,int hi){
  const char*kb=Kslot+hi*1024+r32*16;
  #pragma unroll
  for(int d0=0;d0<NS;++d0){
    const bf16x8 b0=*reinterpret_cast<const bf16x8*>(kb+d0*2048);
    const bf16x8 b1=*reinterpret_cast<const bf16x8*>(kb+d0*2048+512);
    if(d0==0){p0=__builtin_amdgcn_mfma_f32_32x32x16_bf16(b0,qr[0],f32x16{},0,0,0);p1=__builtin_amdgcn_mfma_f32_32x32x16_bf16(b1,qr[0],f32x16{},0,0,0);}
    else{p0=__builtin_amdgcn_mfma_f32_32x32x16_bf16(b0,qr[d0],p0,0,0,0);p1=__builtin_amdgcn_mfma_f32_32x32x16_bf16(b1,qr[d0],p1,0,0,0);}}
}
typedef __attribute__((address_space(3))) const char* lds_cptr;
typedef short v4i16_t __attribute__((ext_vector_type(4)));
template<int NS> __device__ __forceinline__ void kloadN(bf16x8*kf,lds_cptr kp){
  #pragma unroll
  for(int d0=0;d0<NS;++d0){ kf[2*d0]=*(const __attribute__((address_space(3))) bf16x8*)(kp+d0*2048); kf[2*d0+1]=*(const __attribute__((address_space(3))) bf16x8*)(kp+d0*2048+512); }
}
__device__ __forceinline__ void kload2(bf16x8*kf,lds_cptr kp,int j){ kf[2*j]=*(const __attribute__((address_space(3))) bf16x8*)(kp+j*2048); kf[2*j+1]=*(const __attribute__((address_space(3))) bf16x8*)(kp+j*2048+512); }
__device__ __forceinline__ s16x4 vtr(lds_cptr p){ return __builtin_bit_cast(s16x4,__builtin_amdgcn_ds_read_tr16_b64_v4i16((__attribute__((address_space(3))) v4i16_t*)p)); }
__device__ __forceinline__ float rowmax(const f32x16&p0,const f32x16&p1){
  float a=max3f(p0[0],p0[1],p1[0]),b=max3f(p0[2],p0[3],p1[1]);a=max3f(a,p1[2],p1[3]);
  #pragma unroll
  for(int r=4;r<16;r+=4){a=max3f(a,p0[r],p0[r+1]);b=max3f(b,p0[r+2],p0[r+3]);a=max3f(a,p1[r],p1[r+1]);b=max3f(b,p1[r+2],p1[r+3]);}
  const float m=max2f(a,b);
  auto rr=__builtin_amdgcn_permlane32_swap(__float_as_uint(m),__float_as_uint(m),false,false);
  return max2f(__uint_as_float(rr[0]),__uint_as_float(rr[1]));
}
__device__ __forceinline__ void pv(f32x16*o,int vb,bf16x8 pa0,bf16x8 pa1,bf16x8 pa2,bf16x8 pa3){
  #pragma unroll
  for(int d0=0;d0<2;++d0){s16x4 lo[4],hi[4];
    #pragma unroll
    for(int ks=0;ks<4;++ks){
      asm volatile("ds_read_b64_tr_b16 %0,%1 offset:%c2":"=&v"(lo[ks]):"v"(vb),"i"(d0*4096+ks*1024):"memory");
      asm volatile("ds_read_b64_tr_b16 %0,%1 offset:%c2":"=&v"(hi[ks]):"v"(vb),"i"(d0*4096+ks*1024+512):"memory");}
    asm volatile("s_waitcnt lgkmcnt(0)":::"memory");SBAR();
    #define PK(k) (bf16x8){lo[k][0],lo[k][1],lo[k][2],lo[k][3],hi[k][0],hi[k][1],hi[k][2],hi[k][3]}
    o[d0]=__builtin_amdgcn_mfma_f32_32x32x16_bf16(pa0,PK(0),o[d0],0,0,0);
    o[d0]=__builtin_amdgcn_mfma_f32_32x32x16_bf16(pa1,PK(1),o[d0],0,0,0);
    o[d0]=__builtin_amdgcn_mfma_f32_32x32x16_bf16(pa2,PK(2),o[d0],0,0,0);
    o[d0]=__builtin_amdgcn_mfma_f32_32x32x16_bf16(pa3,PK(3),o[d0],0,0,0);
    #undef PK
  }
}

#ifndef ATTN_STORE16
#define ATTN_STORE16(p,v) (*(u32x4*)(p)=(v))
#endif
template<int THRL,bool SEL,int NS,bool QN> __device__ __forceinline__ void attn_unit(int b,int h,int qb,const AttnArgs&a,char*shm){
  const int tid=opaque_tid(),lane=tid&63,r32=lane&31,hi=lane>>5; const int wid=__builtin_amdgcn_readfirstlane(tid>>6);
  const long rowbase=(long)b*SEQ; const int q0=qb*QB;
  const long qpitch=a.qpitch,kpitch=a.kpitch,vpitch=a.vpitch;
  const bf16*Qw=a.Q+(rowbase+q0+wid*QBLK)*qpitch+h*a.qhs;
  const bf16*Kh=a.K+rowbase*kpitch+h*a.khs,*Vh=a.V+rowbase*vpitch+h*a.vhs;
  typedef const __attribute__((address_space(4))) unsigned long long* cmask_t;
  const cmask_t mrow=SEL?(cmask_t)(a.mask+((size_t)(b*64+(q0>>5)+wid)*64)*16):(cmask_t)nullptr;
  unsigned long long mk[32];
  const unsigned lds0=(unsigned)(uintptr_t)shm;
  float*wsf=(float*)(shm+LDS_WS)+wid*64;
  const bf16*ksrc=Kh+(long)lane*kpitch+wid*8;
  const bf16*vsrc=Vh+(long)(16*(wid&3)+(lane>>2))*vpitch+(wid>>2)*32+(lane&3)*8;
  const unsigned kdst=lds0+LDS_K+wid*1024, vdst=lds0+LDS_V+wid*1024;
  const bf16*ksrc2=Kh+(long)lane*kpitch+(8+(wid&3))*8; const unsigned kdst2=lds0+LDS_K+(8+(wid&3))*1024;
  #define KS(sl) (((sl)>>2)*NS)
  #define DMA_K(t,slot) do{ glds16(ksrc+(long)(t)*KVBLK*kpitch,(unsigned)__builtin_amdgcn_readfirstlane(kdst+KS(slot))); if constexpr(NS==6) glds16(ksrc2+(long)(t)*KVBLK*kpitch,(unsigned)__builtin_amdgcn_readfirstlane(kdst2+KS(slot))); }while(0)
  #define WB2() do{ if constexpr(NS==6){WAIT_BAR(3);}else{WAIT_BAR(2);} }while(0)
  #define DMA_V(t,slot) glds16(vsrc+(long)(t)*KVBLK*vpitch,(unsigned)__builtin_amdgcn_readfirstlane(vdst+(slot)))
  const int vb0=(int)(lds0+LDS_V)+((lane>>4)&1)*32+(lane&3)*8+(4*hi+((lane&15)>>2))*64;
  const char*Kbase=shm+LDS_K; bf16x8 kf[2*NS];
  const lds_cptr shm3=(lds_cptr)shm; const lds_cptr kp0=shm3+LDS_K+hi*1024+r32*16; const lds_cptr vp0=shm3+LDS_V+((lane>>4)&1)*32+(lane&3)*8+(4*hi+((lane&15)>>2))*64;
  const int NT=(q0+QB)/KVBLK;
  DMA_K(0,0);DMA_V(0,0);DMA_K(1,SLOTB);
  bf16x8 qr[NS];
  #pragma unroll
  for(int d0=0;d0<NS;++d0)qr[d0]=*reinterpret_cast<const bf16x8*>(&Qw[(long)r32*qpitch+d0*16+hi*8]);
  if constexpr(QN){
    static_assert(NS==6,"QN is the 96-dim head group");
    const long row=rowbase+q0+wid*QBLK+r32; const int pos=q0+wid*QBLK+r32;
    float qv[6][8]; float ss=0.f;
    #pragma unroll
    for(int d0=0;d0<6;++d0){
      #pragma unroll
      for(int j=0;j<8;++j){ qv[d0][j]=bf2f((unsigned short)qr[d0][j]); ss+=qv[d0][j]*qv[d0][j]; } }
    ss+=__shfl_xor(ss,32);
    const float*sq=a.ssq+row*24; float msq=0.f;
    #pragma unroll
    for(int i=0;i<12;++i)msq+=sq[i];
    msq=msq*(1.0f/384.0f)+1e-6f;
    const float rn=C2B*__builtin_amdgcn_rsqf(ss*(1.0f/96.0f)+1e-6f*msq);
    const float*gq=a.qg+8*hi;
    #pragma unroll
    for(int d0=0;d0<4;++d0){
      #pragma unroll
      for(int j=0;j<8;++j)qv[d0][j]*=rn*gq[16*d0+j]; }
    const float*cp=a.rc+pos*32+16*hi,*sp=a.rs+pos*32+16*hi;
    #pragma unroll
    for(int j=0;j<8;++j){ const float x1=qv[4][j]*rn*gq[64+j],x2=qv[5][j]*rn*gq[80+j],c=cp[2*j],s=sp[2*j]; qv[4][j]=x1*c-x2*s; qv[5][j]=x2*c+x1*s; }
    #pragma unroll
    for(int d0=0;d0<6;++d0){ u32x4 w;
      #pragma unroll
      for(int e=0;e<4;++e)w[e]=pk2(qv[d0][2*e],qv[d0][2*e+1]);
      qr[d0]=__builtin_bit_cast(bf16x8,w); }
  }
  float l_reg=0.f;f32x16 o[2];o[0]=f32x16{};o[1]=f32x16{};
  const int qrel=wid*QBLK+r32;
  #define CMASK(P0,P1,t) do{int jb_=(t)-(NT-4); if(jb_>(wid>>1))allneg(P0,P1);}while(0)
  #define MKLOAD(t) do{ if constexpr(SEL){ const cmask_t mw_=mrow+(long)(t)*32; _Pragma("unroll") for(int r=0;r<32;++r)mk[r]=mw_[r]; } }while(0)
  #define MKZ(X,B,WB) do{ if constexpr(SEL){ _Pragma("unroll") for(int r=0;r<4;++r)X[(B)+r]=__builtin_amdgcn_inverse_ballot_w64(mk[(WB)+(B)+r])?X[(B)+r]:0.f; } }while(0)
  #define START(P0,P1) do{ _Pragma("unroll") for(int r=0;r<16;++r)P0[r]=__builtin_amdgcn_exp2f(P0[r]); }while(0)
  #define RESC() do{}while(0)
  f32x16 pA0,pA1,pB0,pB1;
  int sl_prev=0,sl_cur=0,sl_next=SLOTB;
  #define ROT() do{sl_prev=sl_cur;sl_cur=sl_next;sl_next=(sl_next==(NSLOT-1)*SLOTB)?0:sl_next+SLOTB;}while(0)
  MKLOAD(0);
  DMA_K(2,2*SLOTB);
  if constexpr(NS==6){WAIT_BAR(5);}else{WAIT_BAR(3);}
  qkt<NS>(pA0,pA1,Kbase,qr,r32,hi);asm volatile("s_nop 15\n\ts_nop 7":"+v"(pA0),"+v"(pA1));CMASK(pA0,pA1,0);
  START(pA0,pA1);
  _Pragma("unroll") for(int r=0;r<16;++r)pA1[r]=__builtin_amdgcn_exp2f(pA1[r]);
  MKZ(pA0,0,0);MKZ(pA0,4,0);MKZ(pA0,8,0);MKZ(pA0,12,0);MKZ(pA1,0,16);MKZ(pA1,4,16);MKZ(pA1,8,16);MKZ(pA1,12,16);
  WAIT_BAR(0);
  DMA_K(3,0);DMA_V(1,SLOTB);
  ROT();
  kloadN<NS>(kf,kp0+KS(sl_cur));
  WB2();
  s16x4 vlo[8],vhi[8]; u32x4 pw0,pw1,pw2,pw3;
  #define PKW(P,B) cvtpk_s(P[B],P[B+1])
  #define PAF(k) __builtin_bit_cast(bf16x8,pw##k)
  #define VFR(i) (bf16x8){vlo[i][0],vlo[i][1],vlo[i][2],vlo[i][3],vhi[i][0],vhi[i][1],vhi[i][2],vhi[i][3]}
  #define PIN(x) asm volatile("":"+v"(x))
  #define MX3(a,b,c) __builtin_fmaxf(__builtin_fmaxf((a),(b)),(c))
  #define GAPA(MF,A0,A1,A2,A3,W0,W1,PW) do{ MF; sacc+=A0; sacc+=A1; sacc+=A2; sacc+=A3; PIN(sacc); W0; W1; PIN(PW); SBAR(); }while(0)
  #define EX(v) __builtin_amdgcn_exp2f(v)
  #define GAPB(MF,X,B,WB) do{ MF; X[B]=EX(X[B]); X[B+1]=EX(X[B+1]); X[B+2]=EX(X[B+2]); X[B+3]=EX(X[B+3]); MKZ(X,B,WB); PIN(X); SBAR(); }while(0)
  #define VRD(i) do{ vlo[i]=vtr(vp_+(((i)>>2)*4096+((i)&3)*1024)); vhi[i]=vtr(vp_+(((i)>>2)*4096+((i)&3)*1024+512)); }while(0)
  #define KRD(G,j) do{ if(G){ kload2(kf,kp0+KS(sl_next),j); SBAR(); } }while(0)
  #define KRD6(G,j) do{ if constexpr(NS==6){ KRD(G,j); } }while(0)
  #define STEP(C0,C1,P0,P1,t,GK,GV,GL) do{ SBAR(); MKLOAD(t); \
    const lds_cptr vp_=vp0+sl_prev; \
    VRD(0); SBAR(); float sacc=(P0[0]+P0[1]); \
    GAPA(C0=__builtin_amdgcn_mfma_f32_32x32x16_bf16(kf[0],qr[0],f32x16{},0,0,0), P0[2],P0[3],P0[4],P0[5],     pw0[0]=PKW(P0,0), pw0[1]=PKW(P0,2), pw0); \
    VRD(4); SBAR(); GAPA(C1=__builtin_amdgcn_mfma_f32_32x32x16_bf16(kf[1],qr[0],f32x16{},0,0,0), P0[6],P0[7],P0[8],P0[9],     pw0[2]=PKW(P0,4), pw0[3]=PKW(P0,6), pw0); \
    VRD(1); SBAR(); GAPA(C0=__builtin_amdgcn_mfma_f32_32x32x16_bf16(kf[2],qr[1],C0,0,0,0),   P0[10],P0[11],P0[12],P0[13], pw1[0]=PKW(P0,8), pw1[1]=PKW(P0,10), pw1); \
    VRD(5); SBAR(); GAPA(C1=__builtin_amdgcn_mfma_f32_32x32x16_bf16(kf[3],qr[1],C1,0,0,0),   P0[14],P0[15],P1[0],P1[1],   pw1[2]=PKW(P0,12),pw1[3]=PKW(P0,14), pw1); \
    VRD(2); SBAR(); GAPA(C0=__builtin_amdgcn_mfma_f32_32x32x16_bf16(kf[4],qr[2],C0,0,0,0),   P1[2],P1[3],P1[4],P1[5],     pw2[0]=PKW(P1,0), pw2[1]=PKW(P1,2), pw2); \
    VRD(6); SBAR(); GAPA(C1=__builtin_amdgcn_mfma_f32_32x32x16_bf16(kf[5],qr[2],C1,0,0,0),   P1[6],P1[7],P1[8],P1[9],     pw2[2]=PKW(P1,4), pw2[3]=PKW(P1,6), pw2); \
    VRD(3); SBAR(); GAPA(C0=__builtin_amdgcn_mfma_f32_32x32x16_bf16(kf[6],qr[3],C0,0,0,0),   P1[10],P1[11],P1[12],P1[13], pw3[0]=PKW(P1,8), pw3[1]=PKW(P1,10), pw3); \
    VRD(7); SBAR(); GAPA(C1=__builtin_amdgcn_mfma_f32_32x32x16_bf16(kf[7],qr[3],C1,0,0,0),   P1[14],P1[15],0.f,0.f,       pw3[2]=PKW(P1,12),pw3[3]=PKW(P1,14), pw3); \
    if constexpr(NS==6){ C0=__builtin_amdgcn_mfma_f32_32x32x16_bf16(kf[8],qr[4],C0,0,0,0); C1=__builtin_amdgcn_mfma_f32_32x32x16_bf16(kf[9],qr[4],C1,0,0,0); \
      C0=__builtin_amdgcn_mfma_f32_32x32x16_bf16(kf[10],qr[5],C0,0,0,0); C1=__builtin_amdgcn_mfma_f32_32x32x16_bf16(kf[11],qr[5],C1,0,0,0); SBAR(); } \
    l_reg+=sacc; \
    if(GK){DMA_K((t)+3,sl_cur);} if(GV){DMA_V((t)+1,sl_next);} \
    CMASK(C0,C1,t); \
    SBAR(); \
    GAPB(o[0]=__builtin_amdgcn_mfma_f32_32x32x16_bf16(PAF(0),VFR(0),o[0],0,0,0), C0,0,0); \
    GAPB(o[1]=__builtin_amdgcn_mfma_f32_32x32x16_bf16(PAF(0),VFR(4),o[1],0,0,0), C0,4,0); \
    KRD(GL,0); GAPB(o[0]=__builtin_amdgcn_mfma_f32_32x32x16_bf16(PAF(1),VFR(1),o[0],0,0,0), C0,8,0); \
    KRD(GL,1); GAPB(o[1]=__builtin_amdgcn_mfma_f32_32x32x16_bf16(PAF(1),VFR(5),o[1],0,0,0), C0,12,0); \
    KRD(GL,2); GAPB(o[0]=__builtin_amdgcn_mfma_f32_32x32x16_bf16(PAF(2),VFR(2),o[0],0,0,0), C1,0,16); \
    KRD(GL,3); GAPB(o[1]=__builtin_amdgcn_mfma_f32_32x32x16_bf16(PAF(2),VFR(6),o[1],0,0,0), C1,4,16); \
    KRD6(GL,4); GAPB(o[0]=__builtin_amdgcn_mfma_f32_32x32x16_bf16(PAF(3),VFR(3),o[0],0,0,0), C1,8,16); \
    KRD6(GL,5); GAPB(o[1]=__builtin_amdgcn_mfma_f32_32x32x16_bf16(PAF(3),VFR(7),o[1],0,0,0), C1,12,16); \
    }while(0)
  int t=1;
  #undef CMASK
  #define CMASK(P0,P1,t) do{}while(0)
  for(;t+5<NT;t+=2){
    STEP(pB0,pB1,pA0,pA1,t,true,true,true);     WB2(); RESC(); ROT();
    STEP(pA0,pA1,pB0,pB1,t+1,true,true,true);   WB2(); RESC(); ROT();
  }
  #undef CMASK
  #define CMASK(P0,P1,t) do{int jb_=(t)-(NT-4); if(jb_>(wid>>1))allneg(P0,P1);}while(0)
  #define ENDW(tt) do{ if((tt)+3<NT){WB2();} else if((tt)+2<NT){WAIT_BAR(1);} else {WAIT_BAR(0);} }while(0)
  for(;t+1<NT;t+=2){
    STEP(pB0,pB1,pA0,pA1,t,(t+3<NT),(t+1<NT),(t+1<NT));       ENDW(t);   RESC(); ROT();
    STEP(pA0,pA1,pB0,pB1,t+1,(t+4<NT),(t+2<NT),(t+2<NT));     ENDW(t+1); RESC(); ROT();
  }
  STEP(pB0,pB1,pA0,pA1,NT-1,false,false,false); RESC();
  { float sacc=pB0[0]+pB0[1]; _Pragma("unroll") for(int r=2;r<16;++r)sacc+=pB0[r]; _Pragma("unroll") for(int r=0;r<16;++r)sacc+=pB1[r]; l_reg+=sacc;
    pw0=(u32x4){PKW(pB0,0),PKW(pB0,2),PKW(pB0,4),PKW(pB0,6)};pw1=(u32x4){PKW(pB0,8),PKW(pB0,10),PKW(pB0,12),PKW(pB0,14)};pw2=(u32x4){PKW(pB1,0),PKW(pB1,2),PKW(pB1,4),PKW(pB1,6)};pw3=(u32x4){PKW(pB1,8),PKW(pB1,10),PKW(pB1,12),PKW(pB1,14)};
    SBAR(); pv(o,vb0+sl_cur,PAF(0),PAF(1),PAF(2),PAF(3)); }
  #undef PKW
  #undef PAF
  #undef VFR
  #undef PIN
  #undef MX3
  #undef GAPA
  #undef GAPB
  #undef EX
  #undef VRD
  #undef KRD
  #undef KRD6
  #undef STEP
  #undef ENDW
  {auto rr=__builtin_amdgcn_permlane32_swap(__float_as_uint(l_reg),__float_as_uint(l_reg),false,false);l_reg=__uint_as_float(rr[0])+__uint_as_float(rr[1]);}
  if(hi==0)wsf[32+r32]=l_reg;asm volatile("s_waitcnt lgkmcnt(0)":::"memory");
  float rli[16];
  #pragma unroll
  for(int r=0;r<16;++r)rli[r]=__builtin_amdgcn_rcpf(wsf[32+crow(r,hi)]);
  bf16*Ow=a.O+(rowbase+q0+wid*QBLK)*1024+a.ocol+h*D;
  const bf16*Gw=a.G+(rowbase+q0+wid*QBLK)*(long)a.gpitch+h*D;
  { bf16*stg=(bf16*)(shm+LDS_OST)+wid*2048;
    #pragma unroll
    for(int r=0;r<16;++r){const int orow=crow(r,hi);
      #pragma unroll
      for(int d0=0;d0<2;++d0)stg[orow*64+d0*32+r32]=(bf16)f2bf(o[d0][r]*rli[r]);}
    asm volatile("s_waitcnt lgkmcnt(0)":::"memory");
    #pragma unroll
    for(int i=0;i<4;++i){const int row=i*8+(lane>>3),ch=lane&7; const u32x4 v=*(const u32x4*)(stg+row*64+ch*8);
      const u32x4 g=*(const u32x4*)(Gw+(long)row*a.gpitch+ch*8); u32x4 w;
      #pragma unroll
      for(int e=0;e<4;++e) w[e]=pk2(bflo(v[e])*bflo(g[e]),bfhi(v[e])*bfhi(g[e]));
      ATTN_STORE16(Ow+(long)row*1024+ch*8,w);} }
  asm volatile("s_waitcnt lgkmcnt(0)\n\ts_barrier":::"memory");
  #undef DMA_K
  #undef KS
  #undef WB2
  #undef DMA_V
  #undef CMASK
  #undef MKLOAD
  #undef MKZ
  #undef START
  #undef RESC
  #undef ROT
}
constexpr int ATTN_LDS_BYTES=LDS_BYTES;
#undef SBAR
#undef WAIT_BAR
}
#define XB_TMO      128
#define XB_XCNT(j)  (256  + 64 * (j))
#define XB_XSUB(j)  (1280 + 64 * (j))
#define XB_XGEN(j)  (2304 + 64 * (j))
#define XB_TOP      3328
#define XB_TOPGEN   3392
#define XCD_BAR_WORDS 3456
#define XB_SPIN_CAP (1u << 18)

__device__ __forceinline__ unsigned xb_ld(unsigned* p)              { return __hip_atomic_load(p, __ATOMIC_RELAXED, __HIP_MEMORY_SCOPE_AGENT); }
__device__ __forceinline__ unsigned xb_add(unsigned* p, unsigned v) { return __hip_atomic_fetch_add(p, v, __ATOMIC_RELAXED, __HIP_MEMORY_SCOPE_AGENT); }
__device__ __forceinline__ unsigned xb_xcc_id() { return (unsigned)__builtin_amdgcn_s_getreg((3 << 11) | 20) & 0xFu; }
#define XB_SPIN(cond, bar) do { unsigned _sp = 0; while (cond) { __builtin_amdgcn_s_sleep(1); \
    if ((++_sp & 255u) == 0u) { if (xb_ld(&(bar)[XB_TMO])) break; if (_sp > XB_SPIN_CAP) { atomicAdd(&(bar)[XB_TMO], 1u); break; } } } } while (0)

struct XcdBarrier {
    unsigned* bar; unsigned x;
    volatile LAS unsigned* st;
};

__device__ __forceinline__ XcdBarrier xcd_barrier_post(unsigned* bar, volatile LAS unsigned* st) {
    XcdBarrier b; b.bar = bar; b.x = xb_xcc_id(); b.st = st;
    if (threadIdx.x == 0) (void)xb_add(&bar[XB_XCNT(b.x)], 1u);
    return b;
}
__device__ __forceinline__ void xcd_barrier_complete(unsigned* bar, unsigned x, unsigned& nloc, unsigned& nx) {
    const unsigned G = gridDim.x * gridDim.y * gridDim.z;
    unsigned sum, cnt, mine, sp = 0u;
    for (;;) {
        sum = 0u; cnt = 0u; mine = 0u;
#pragma unroll
        for (unsigned j = 0; j < 16; ++j) { const unsigned c = xb_ld(&bar[XB_XCNT(j)]); sum += c; cnt += (c > 0u) ? 1u : 0u; mine = (j == x) ? c : mine; }
        if (sum == G) break;
        __builtin_amdgcn_s_sleep(1);
        if ((++sp & 255u) == 0u) { if (xb_ld(&bar[XB_TMO])) break; if (sp > XB_SPIN_CAP) { atomicAdd(&bar[XB_TMO], 1u); break; } }
    }
    nloc = mine > 0u ? mine : 1u; nx = cnt > 0u ? cnt : 1u;
}

__device__ __forceinline__ void xcd_barrier(const XcdBarrier& b) {
    asm volatile("s_waitcnt vmcnt(0)" ::: "memory");
    __syncthreads();
    if (threadIdx.x == 0) {
        unsigned* bar = b.bar;
        __builtin_amdgcn_s_waitcnt(0);
        unsigned nloc = b.st[0], nx = b.st[1];
        if (nloc == 0u) { xcd_barrier_complete(bar, b.x, nloc, nx); b.st[0] = nloc; b.st[1] = nx; }
        const unsigned old = xb_add(&bar[XB_XSUB(b.x)], 1u);
        const unsigned gen = old / nloc;
        if (old + 1u == (gen + 1u) * nloc) {
            __builtin_amdgcn_fence(__ATOMIC_RELEASE, "agent");
            asm volatile("s_waitcnt vmcnt(0)" ::: "memory");
            const unsigned og = xb_add(&bar[XB_TOP], 1u);
            const unsigned tg = og / nx;
            if (og + 1u == (tg + 1u) * nx) xb_add(&bar[XB_TOPGEN], 1u);
            else XB_SPIN(xb_ld(&bar[XB_TOPGEN]) == tg, bar);
            __builtin_amdgcn_fence(__ATOMIC_ACQUIRE, "agent");
            xb_add(&bar[XB_XGEN(b.x)], 1u);
            asm volatile("s_waitcnt vmcnt(0)" ::: "memory");
        } else {
            XB_SPIN(xb_ld(&bar[XB_XGEN(b.x)]) == gen, bar);
            __builtin_amdgcn_fence(__ATOMIC_ACQUIRE, "agent");
            asm volatile("s_waitcnt vmcnt(0)" ::: "memory");
        }
    }
    __syncthreads();
}

constexpr int NWAVES = 8;
constexpr int RING_BYTES = 157696;
constexpr int LDSCTL_OFF = RING_BYTES, MISC_OFF = LDSCTL_OFF + 320;
constexpr int LDS_BYTES = 158720;
static_assert(IDX_END <= RING_BYTES && fa::ATTN_LDS_BYTES <= RING_BYTES && pg8::STAGE_BYTES <= RING_BYTES, "phase scratch fits");
constexpr int CW_BAR = 4096;
constexpr size_t CTL_ZERO_BYTES = 64 * 1024;
static_assert((CW_BAR + XCD_BAR_WORDS) * 4 <= (int)CTL_ZERO_BYTES, "barrier words inside the memset region");

struct MegaArgs { const float* in[12]; float* out; unsigned char* ws; };

__global__ void __launch_bounds__(NWAVES * 64, 2) mega_fwd(MegaArgs args) {
    extern __shared__ __attribute__((aligned(16))) unsigned char lds_raw[];
    LAS unsigned char* lds = (LAS unsigned char*)lds_raw;
    const int tid = opaque_tid(), lane = tid & 63; const int wave = __builtin_amdgcn_readfirstlane(tid >> 6);
    const int G = gridDim.x, bx = blockIdx.x, vcu = (G % 8 == 0) ? (bx % 8) * (G / 8) + bx / 8 : bx;
    unsigned char* const ws = args.ws;
#define WSP(T, off) ((T*)(ws + (off)))
    float* const GAINS = WSP(float, WS_GAINS);

    for (int u = tid; u < (LDS_BYTES - LDSCTL_OFF) / 4; u += NWAVES * 64) ((LAS unsigned*)(lds + LDSCTL_OFF))[u] = 0u;
    __syncthreads();
    XcdBarrier bar = xcd_barrier_post((unsigned*)(ws + WS_CTL) + CW_BAR, (volatile LAS unsigned*)(lds + MISC_OFF) + 8);

    const int gw = vcu * NWAVES + wave, NGW = G * NWAVES;

    {
        float* RC = WSP(float, WS_ROPE); float* RS = RC + SEQ * 32;
        for (int i = vcu * 512 + tid; i < SEQ * 32; i += G * 512) rope_table_elem(RC, RS, i);
        if (vcu == 0 && tid < 320) { const int i = tid; GAINS[i] = (i < 64) ? args.in[3][i] : (i < 128) ? args.in[4][i - 64] : (i < 224) ? args.in[9][i - 128] : args.in[10][i - 224]; }
        constexpr int T_IN = (NP / 64) * 16, T_UQ = 12 * 6, T_UKV = 16 * 4, T_OUT = 16 * 16;
        LAS float* tile = (LAS float*)lds;
        for (int it = vcu; it < T_IN + T_UQ + T_UKV + T_OUT; it += G) {
            int r = it;
            if (r < T_IN) { wtrans_tile(tile, args.in[2], 1024, D_IN_OLD, WSP(bf16, WS_WIN), (r % (NP / 64)) * 64, (r / (NP / 64)) * 64, 1, nullptr, tid); continue; } r -= T_IN;
            if (r < T_UQ) { wtrans_tile(tile, args.in[7], 384, 768, WSP(bf16, WS_WUQ), (r % 12) * 64, (r / 12) * 64, 0, args.in[5], tid); continue; } r -= T_UQ;
            if (r < T_UKV) { wtrans_tile(tile, args.in[8], 256, 1024, WSP(bf16, WS_WUKV), (r % 16) * 64, (r / 16) * 64, 2, args.in[6], tid); continue; } r -= T_UKV;
            wtrans_tile(tile, args.in[11], 1024, 1024, WSP(bf16, WS_WOUT), (r % 16) * 64, (r / 16) * 64, 0, nullptr, tid);
        }
        for (int m = gw; m < MTOK; m += NGW) rmsnorm_x_row(args.in[0], args.in[1], WSP(bf16, WS_XN), m, lane);
    }
    xcd_barrier(bar);

    {
        pg8::Gemm g{WSP(bf16, WS_XN), WSP(bf16, WS_WIN), MTOK, NP, 1024, 1024}; pg8::StaticOrder S; S.init(MTOK, NP, G, bx);
        pg8::EpiProj E{WSP(bf16, WS_PROJ), WSP(float, WS_SSQ), GAINS, GAINS + 64, WSP(float, WS_ROPE), WSP(float, WS_ROPE) + SEQ * 32};
        pg8::gemm_phase<pg8::EpiProj, pg8::StaticOrder, true, true>(lds, g, S, E);
    }
    xcd_barrier(bar);

    {
        pg8::Gemm g{WSP(bf16, WS_PROJ) + C_CQ, WSP(bf16, WS_WUQ), MTOK, 768, 384, NP}; pg8::StaticOrder S; S.init(MTOK, 768, G, bx);
        pg8::EpiBf16<0> E{WSP(bf16, WS_QB), 768, nullptr, 0, 0, 1.f};
        pg8::gemm_phase<pg8::EpiBf16<0>, pg8::StaticOrder, true, true>(lds, g, S, E);
    }
    {
        pg8::Gemm g{WSP(bf16, WS_PROJ) + C_CKV, WSP(bf16, WS_WUKV), MTOK, 1024, 256, NP}; pg8::StaticOrder S; S.init(MTOK, 1024, G, bx);
        pg8::EpiKV E{WSP(bf16, WS_KB), WSP(bf16, WS_VB), WSP(bf16, WS_PROJ), WSP(float, WS_SSQ), GAINS + 224, WSP(float, WS_ROPE), WSP(float, WS_ROPE) + SEQ * 32};
        pg8::gemm_phase<pg8::EpiKV, pg8::StaticOrder, true, true>(lds, g, S, E);
    }
    for (int p = vcu; p < 512; p += G) {
        const int b = p & 15, qq = p >> 4;
        indexer_unit(lds, WSP(bf16, WS_PROJ), WSP(unsigned long long, WS_MASK), b, 63 - qq);
        indexer_unit(lds, WSP(bf16, WS_PROJ), WSP(unsigned long long, WS_MASK), b, qq);
    }
    xcd_barrier(bar);

    {
        bf16* PROJ = WSP(bf16, WS_PROJ); bf16* MIXED = WSP(bf16, WS_MIXED);
        const AttnArgs aA{PROJ + C_QA, PROJ + C_KA, PROJ + C_VA, PROJ + C_GA, MIXED, WSP(unsigned long long, WS_MASK), nullptr, nullptr, nullptr, nullptr, NP, 64, NP, 64, NP, 64, NP, 0};
        const AttnArgs aB{WSP(bf16, WS_QB), WSP(bf16, WS_KB), WSP(bf16, WS_VB), PROJ + C_GB, MIXED, nullptr, WSP(float, WS_SSQ), GAINS + 128, WSP(float, WS_ROPE), WSP(float, WS_ROPE) + SEQ * 32, 768, 96, 768, 96, 512, 64, NP, 512};
        for (int p = vcu; p < 512; p += G) {
            const int s = p & 3, h = (p >> 2) & 7, b = p >> 5;
            fa::attn_unit<8, true, 4, false>(b, h, 7 - s, aA, (char*)lds_raw);
            fa::attn_unit<8, true, 4, false>(b, h, s, aA, (char*)lds_raw);
            fa::attn_unit<8, false, 6, true>(b, h, 7 - s, aB, (char*)lds_raw);
            fa::attn_unit<8, false, 6, true>(b, h, s, aB, (char*)lds_raw);
        }
    }
    xcd_barrier(bar);

    {
        pg8::Gemm g{WSP(bf16, WS_MIXED), WSP(bf16, WS_WOUT), MTOK, 1024, 1024, 1024}; pg8::StaticOrder S; S.init(MTOK, 1024, G, bx);
        pg8::EpiResF32 E{args.in[0], args.out, 1024};
        pg8::gemm_phase<pg8::EpiResF32, pg8::StaticOrder, true, true>(lds, g, S, E);
    }
}

extern "C" void kernel_launch(void* const* d_in, const int* in_sizes, int n_in, void* d_out, int out_size, void* d_ws, size_t ws_size, hipStream_t stream) {
    static int grid = 0;
    if (grid == 0) {
        if (n_in != 12 || in_sizes[0] != MTOK * DMODEL || out_size != MTOK * DMODEL || ws_size < WS_END) {
            fprintf(stderr, "kernel_launch: unexpected shapes / workspace (n_in %d, in0 %d, out %d, ws %zu)\n", n_in, n_in > 0 ? in_sizes[0] : -1, out_size, ws_size); grid = -1; return; }
        int dev = 0, cus = 0, per_cu = 0;
        if (hipGetDevice(&dev) != hipSuccess || hipDeviceGetAttribute(&cus, hipDeviceAttributeMultiprocessorCount, dev) != hipSuccess) { grid = -1; return; }
        if (hipFuncSetAttribute((const void*)mega_fwd, hipFuncAttributeMaxDynamicSharedMemorySize, LDS_BYTES) != hipSuccess) { fprintf(stderr, "kernel_launch: hipFuncSetAttribute failed\n"); grid = -1; return; }
        if (hipOccupancyMaxActiveBlocksPerMultiprocessor(&per_cu, (const void*)mega_fwd, NWAVES * 64, LDS_BYTES) != hipSuccess || per_cu < 1) {
            fprintf(stderr, "kernel_launch: occupancy query says %d workgroups per CU\n", per_cu); (void)hipGetLastError(); grid = -1; return; }
        grid = cus;
    }
    if (grid < 0) return;
    (void)hipMemsetAsync((char*)d_ws + WS_CTL, 0, CTL_ZERO_BYTES, stream);
    MegaArgs a{};
    for (int i = 0; i < 12; ++i) a.in[i] = (const float*)d_in[i];
    a.out = (float*)d_out; a.ws = (unsigned char*)d_ws;
    hipLaunchKernelGGL(mega_fwd, dim3(grid), dim3(NWAVES * 64), LDS_BYTES, stream, a);
}
```

```cpp
#include <hip/hip_runtime.h>
#include <cstdint>
#include <cstdio>

constexpr int BATCH = 16, SEQ = 2048, DMODEL = 1024, MTOK = BATCH * SEQ;
constexpr int NP = 3840;
constexpr int C_QA = 0, C_KA = 512, C_VA = 1024, C_GA = 1536, C_QI = 2048, C_GB = 2560, C_CQ = 3072, C_CKV = 3456, C_KI = 3712, C_KR = 3776, C_WI = 3808;
constexpr int D_IN_OLD = 3816;
constexpr float RMS_EPS = 1e-6f;
constexpr float LOG2E = 1.4426950408889634f;
constexpr float C2A = 0.125f * LOG2E;
constexpr float C2B = 0.10206207261596575f * LOG2E;

constexpr size_t MiB = 1u << 20;
constexpr size_t WS_CTL = 0;
constexpr size_t WS_WIN = 2 * MiB;
constexpr size_t WS_WUQ = 10 * MiB;
constexpr size_t WS_WUKV = 11 * MiB;
constexpr size_t WS_WOUT = 12 * MiB;
constexpr size_t WS_ROPE = 14 * MiB;
constexpr size_t WS_GAINS = 15 * MiB;
constexpr size_t WS_XN = 16 * MiB;
constexpr size_t WS_MIXED = WS_XN;
constexpr size_t WS_PROJ = 80 * MiB;
constexpr size_t WS_QB = 320 * MiB;
constexpr size_t WS_VB = 368 * MiB;
constexpr size_t WS_SSQ = 400 * MiB;
constexpr size_t WS_KB = 432 * MiB;
constexpr size_t WS_MASK = 480 * MiB;
constexpr size_t WS_END = 488 * MiB;

typedef unsigned short bf16;
typedef short bf16x8_t __attribute__((ext_vector_type(8)));
typedef short s16x4_t __attribute__((ext_vector_type(4)));
typedef float f32x16_t __attribute__((ext_vector_type(16)));
typedef float f32x4_t __attribute__((ext_vector_type(4)));
typedef unsigned u32x4_t __attribute__((ext_vector_type(4)));
typedef unsigned u32x2_t __attribute__((ext_vector_type(2)));
#define LAS __attribute__((address_space(3)))

__device__ __forceinline__ unsigned f2bf(float f) { unsigned u = __builtin_bit_cast(unsigned, f); return (u + 0x7fffu + ((u >> 16) & 1u)) >> 16; }
__device__ __forceinline__ unsigned pk2(float lo, float hi) { return f2bf(lo) | (f2bf(hi) << 16); }
__device__ __forceinline__ float bflo(unsigned u) { return __builtin_bit_cast(float, u << 16); }
__device__ __forceinline__ float bfhi(unsigned u) { return __builtin_bit_cast(float, u & 0xffff0000u); }
__device__ __forceinline__ float bf2f(bf16 b) { return __builtin_bit_cast(float, (unsigned)b << 16); }
__device__ __forceinline__ int crow(int r, int hi) { return (r & 3) + 8 * (r >> 2) + 4 * hi; }

__device__ __forceinline__ int opaque_tid() { int t = (int)threadIdx.x; asm volatile("" : "+v"(t)); return t; }

#define SPIN_DUP_BEGIN(t) const unsigned long long t = __builtin_amdgcn_s_memrealtime()
#define SPIN_DUP_END(t) do { const unsigned long long e_ = __builtin_amdgcn_s_memrealtime(); const unsigned long long d_ = e_ - t; while (__builtin_amdgcn_s_memrealtime() - e_ < d_) __builtin_amdgcn_s_sleep(1); } while (0)

namespace pg8 {
#define PG8_LAS __attribute__((address_space(3)))
typedef unsigned short bf16_t;
typedef short bf16x8 __attribute__((ext_vector_type(8)));
typedef float f32x4 __attribute__((ext_vector_type(4)));
typedef unsigned u32x4 __attribute__((ext_vector_type(4)));
constexpr int BM = 256, BK = 64, HALF = 128, HTB = HALF * BK * 2  , STAGE_BYTES = 8 * HTB, NXCD = 8, WGM = 8;

__host__ __device__ __forceinline__ int lds_byte(int r, int c) { const int st = (r >> 4) * 2 + (c >> 5), rr = r & 15, cc = c & 31, ob = rr * 64 + cc * 2; return st * 1024 + (ob ^ (((ob >> 9) & 1) << 5)); }
__host__ __device__ __forceinline__ void stage_rc(int b, int& R, int& C) { const int st = b / 1024, sb = b % 1024, swz = sb ^ (((sb >> 9) & 1) << 5); R = (st >> 1) * 16 + swz / 64; C = (st & 1) * 32 + (swz % 64) / 2; }
__host__ __device__ __forceinline__ int perm32(int rho) { const int n = rho >> 4, i = rho & 15; return 8 * (i >> 2) + 4 * n + (i & 3); }

struct Unit { int pm, pn; };
struct Gemm { const bf16_t* A; const bf16_t* Bt; int M, N, K, lda; };

struct StaticOrder {
    int nM, nN, nwg, G, c;
    __host__ __device__ void init(int M, int N, int G_, int c_) { nM = M / BM; nN = N / BM; nwg = nM * nN; G = G_; c = c_; }
    __host__ __device__ bool next(int i, Unit& u) const {
        const long L = (long)i * G + c; if (L >= nwg) return false;
        int wgid = (int)L; { const int q = nwg / NXCD, r = nwg % NXCD, xcd = wgid % NXCD, off = wgid / NXCD; wgid = (xcd < r ? xcd * (q + 1) : r * (q + 1) + (xcd - r) * q) + off; }
        const int nig = WGM * nN, gid = wgid / nig, fm = gid * WGM, gsz = (nM - fm) < WGM ? (nM - fm) : WGM;
        u.pm = fm + ((wgid % nig) % gsz); u.pn = (wgid % nig) / gsz; return true;
    }
    __device__ __forceinline__ void a_ready(const Unit&) const {}
    __device__ __forceinline__ void done(const Unit&) const {}
};

__device__ __forceinline__ unsigned cvt_pk_bf16(float lo, float hi) { unsigned r; asm volatile("v_cvt_pk_bf16_f32 %0, %1, %2" : "=v"(r) : "v"(lo), "v"(hi)); return r; }
typedef float f32x2 __attribute__((ext_vector_type(2)));
__device__ __forceinline__ f32x2 gelu_pk(f32x2 v) {
    const f32x2 av = __builtin_elementwise_abs(v), d = av * 0.2316418882f + 1.0f;
    f32x2 t; t.x = __builtin_amdgcn_rcpf(d.x); t.y = __builtin_amdgcn_rcpf(d.y);
    f32x2 q = t * 0.5307027145f + (-0.7265760135f); q = q * t + 0.7107068705f; q = q * t + (-0.142248368f); q = q * t + 0.127414796f; q = q * t;
    const f32x2 s = (v * v) * (-0.72134752044f);
    f32x2 e; e.x = __builtin_amdgcn_exp2f(s.x); e.y = __builtin_amdgcn_exp2f(s.y);
    const f32x2 m = v * (q * e), r = v - m;
    f32x2 o; o.x = v.x < 0.f ? m.x : r.x; o.y = v.y < 0.f ? m.y : r.y; return o;
}

template <int ACT  > struct EpiBf16 {
    static constexpr bool PERM = true, AFTER_DRAIN = false; static_assert(ACT == 0 || ACT == 1, "EpiBf16: ACT is 0 (none) or 1 (gelu_pk)");
    bf16_t* O; int ldc; const float* bias; int split_cols; size_t split_stride; float scale0;
    __device__ __forceinline__ void operator()(const f32x4 (&acc)[2][2][4][2], const Unit& u, int wr, int wc, int fr, int fq) const {
        const int row0 = u.pm * BM + wr * 64 + fr; int colt = u.pn * BM; bf16_t* base = O;
        float sc = 1.f; if (split_cols) { const int t = colt / split_cols; base += (size_t)t * split_stride; colt -= t * split_cols; if (t == 0) sc = scale0; }
        const int col0 = colt + wc * 32 + 8 * fq, bcol0 = u.pn * BM + wc * 32 + 8 * fq;
        f32x4 bv[2][2];
#pragma unroll
        for (int bj = 0; bj < 2; ++bj)
#pragma unroll
            for (int n = 0; n < 2; ++n) bv[bj][n] = bias ? *(const f32x4*)(bias + bcol0 + bj * HALF + 4 * n) : (f32x4){0.f, 0.f, 0.f, 0.f};
#pragma unroll
        for (int ai = 0; ai < 2; ++ai)
#pragma unroll
            for (int m = 0; m < 4; ++m) { bf16_t* rowp = base + (size_t)(row0 + ai * HALF + m * 16) * ldc + col0;
#pragma unroll
                for (int bj = 0; bj < 2; ++bj) { f32x4 v0 = acc[ai][bj][m][0] + bv[bj][0], v1 = acc[ai][bj][m][1] + bv[bj][1];
                    if (ACT == 1) { f32x2 a = gelu_pk((f32x2){v0[0], v0[1]}), b = gelu_pk((f32x2){v0[2], v0[3]}), c = gelu_pk((f32x2){v1[0], v1[1]}), d = gelu_pk((f32x2){v1[2], v1[3]});
                        v0 = (f32x4){a.x, a.y, b.x, b.y}; v1 = (f32x4){c.x, c.y, d.x, d.y}; }
                    v0 = v0 * sc; v1 = v1 * sc; u32x4 w; w.x = cvt_pk_bf16(v0[0], v0[1]); w.y = cvt_pk_bf16(v0[2], v0[3]); w.z = cvt_pk_bf16(v1[0], v1[1]); w.w = cvt_pk_bf16(v1[2], v1[3]);
                    *(u32x4*)(rowp + bj * HALF) = w; } }
    }
};
template <class Epi, class Sched, bool ALIGN_EPI = false, bool SP2 = false>
__device__ __forceinline__ void gemm_phase(PG8_LAS unsigned char* lds, const Gemm g, const Sched& S, const Epi& E) {
    const int tid = opaque_tid(), wid = __builtin_amdgcn_readfirstlane(tid >> 6), lane = tid & 63, wr = wid >> 2, wc = wid & 3, fr = lane & 15, fq = lane >> 4;
    int Kq = g.K, ldq = g.lda; asm volatile("" : "+s"(Kq), "+s"(ldq));
    const int K = Kq, nt = K / BK, lda = ldq;
    unsigned voffA[2], voffB[2];
#pragma unroll
    for (int i = 0; i < 2; ++i) { int R, C; stage_rc(tid * 16 + i * 8192, R, C); const int Rb = Epi::PERM ? ((R & ~31) + perm32(R & 31)) : R;
        voffA[i] = (unsigned)(R * lda + C) * 2u; voffB[i] = (unsigned)(Rb * K + C) * 2u; }
    const size_t kstep = (size_t)(BK * 2);
    const size_t hstepA = (size_t)HALF * lda * 2, hstepB = (size_t)HALF * K * 2;
    const size_t tstepA = 2 * hstepA, tstepB = 2 * hstepB;
    const unsigned ldsw = (unsigned)wid * 1024u;
    const int aoff = lds_byte(wr * 64 + fr, fq * 8), boff = lds_byte(wc * 32 + fr, fq * 8);
#define PG8_SA(b, h) (((b) * 2 + (h)) * HTB)
#define PG8_SB(b, h) ((4 + (b) * 2 + (h)) * HTB)
#define PG8_STAGE(bufoff, gbase, voff) do { _Pragma("unroll") for (int _i = 0; _i < 2; ++_i) \
        __builtin_amdgcn_global_load_lds((const unsigned*)((const char*)(gbase) + (voff)[_i]), (PG8_LAS unsigned*)(lds + (bufoff) + ldsw + _i * 8192), 16, 0, 0); } while (0)
#define PG8_LDA(dst, b, h) do { _Pragma("unroll") for (int m = 0; m < 4; ++m) _Pragma("unroll") for (int k = 0; k < 2; ++k) dst[m][k] = *(const PG8_LAS bf16x8*)(lds + PG8_SA(b, h) + aoff + m * 2048 + k * 1024); } while (0)
#define PG8_LDB(dst, b, h) do { _Pragma("unroll") for (int n = 0; n < 2; ++n) _Pragma("unroll") for (int k = 0; k < 2; ++k) dst[n][k] = *(const PG8_LAS bf16x8*)(lds + PG8_SB(b, h) + boff + n * 2048 + k * 1024); } while (0)
#define PG8_MMA(ai, bj, At, Bt) do { __builtin_amdgcn_s_setprio(1); _Pragma("unroll") for (int m = 0; m < 4; ++m) _Pragma("unroll") for (int n = 0; n < 2; ++n) _Pragma("unroll") for (int k = 0; k < 2; ++k) \
        acc[ai][bj][m][n] = __builtin_amdgcn_mfma_f32_16x16x32_bf16(Bt[n][k], At[m][k], acc[ai][bj][m][n], 0, 0, 0); __builtin_amdgcn_s_setprio(0); } while (0)
#define PG8_WAIT_V(n) asm volatile("s_waitcnt vmcnt(" #n ")" ::: "memory")
#define PG8_WAIT_L(n) asm volatile("s_waitcnt lgkmcnt(" #n ")" ::: "memory")
#define PG8_BAR __builtin_amdgcn_s_barrier()
#define PG8_SCHED __builtin_amdgcn_sched_barrier(0)
    Unit cur, nxt; int ui = 0;
    if (!S.next(0, cur)) return;
    f32x4 acc[2][2][4][2];
#pragma unroll
    for (int a = 0; a < 2; ++a)
#pragma unroll
        for (int b = 0; b < 2; ++b)
#pragma unroll
            for (int m = 0; m < 4; ++m)
#pragma unroll
                for (int n = 0; n < 2; ++n) acc[a][b][m][n] = (f32x4){0.f, 0.f, 0.f, 0.f};
    bf16x8 At[4][2], B0[2][2], B1[2][2];
    const char* cA = (const char*)g.A + (size_t)cur.pm * tstepA; const char* cB = (const char*)g.Bt + (size_t)cur.pn * tstepB;
    S.a_ready(cur);
    if constexpr (SP2) {
        PG8_STAGE(PG8_SB(0, 0), cB, voffB); PG8_STAGE(PG8_SB(0, 1), cB + hstepB, voffB); PG8_STAGE(PG8_SA(0, 0), cA, voffA); PG8_STAGE(PG8_SA(0, 1), cA + hstepA, voffA);
        if (wr == 1) PG8_BAR;
        PG8_WAIT_V(2); PG8_BAR;
        PG8_STAGE(PG8_SB(1, 0), cB + kstep, voffB); PG8_STAGE(PG8_SA(1, 0), cA + kstep, voffA); PG8_STAGE(PG8_SB(1, 1), cB + hstepB + kstep, voffB);
        PG8_WAIT_V(6); PG8_BAR;
    } else {
        PG8_STAGE(PG8_SB(0, 0), cB, voffB); PG8_STAGE(PG8_SA(0, 0), cA, voffA); PG8_STAGE(PG8_SB(0, 1), cB + hstepB, voffB); PG8_STAGE(PG8_SA(0, 1), cA + hstepA, voffA);
        if (wr == 1) PG8_BAR;
        PG8_WAIT_V(4); PG8_BAR;
        PG8_STAGE(PG8_SB(1, 0), cB + kstep, voffB); PG8_STAGE(PG8_SA(1, 0), cA + kstep, voffA); PG8_STAGE(PG8_SB(1, 1), cB + hstepB + kstep, voffB);
        PG8_WAIT_V(6); PG8_BAR;
    }
    for (;;) {
        const bool has_next = S.next(ui + 1, nxt);
        const char* nA = has_next ? (const char*)g.A + (size_t)nxt.pm * tstepA : cA; const char* nB = has_next ? (const char*)g.Bt + (size_t)nxt.pn * tstepB : cB;
        for (int t = 0; t < nt; t += 2) {
            const bool last = (t == nt - 2);
            const char* a1 = cA + (size_t)(t + 1) * kstep;
            const char* a2 = last ? nA : cA + (size_t)(t + 2) * kstep; const char* b2 = last ? nB : cB + (size_t)(t + 2) * kstep;
            const char* a3 = a2 + kstep; const char* b3 = b2 + kstep;
            if (last && has_next) S.a_ready(nxt);
            if constexpr (SP2) {
            PG8_LDB(B0, 0, 0); PG8_LDB(B1, 0, 1); PG8_SCHED; PG8_LDA(At, 0, 0); PG8_STAGE(PG8_SA(1, 1), a1 + hstepA, voffA);
            PG8_WAIT_V(8); PG8_WAIT_L(0); PG8_BAR; PG8_MMA(0, 0, At, B0); PG8_MMA(0, 1, At, B1); PG8_BAR; PG8_SCHED;
            PG8_LDA(At, 0, 1); PG8_STAGE(PG8_SB(0, 0), b2, voffB); PG8_STAGE(PG8_SB(0, 1), b2 + hstepB, voffB); PG8_STAGE(PG8_SA(0, 0), a2, voffA);
            PG8_WAIT_V(8); PG8_WAIT_L(0); PG8_BAR; PG8_MMA(1, 0, At, B0); PG8_MMA(1, 1, At, B1); PG8_BAR; PG8_SCHED;
            PG8_LDB(B0, 1, 0); PG8_LDB(B1, 1, 1); PG8_SCHED; PG8_LDA(At, 1, 0); PG8_STAGE(PG8_SA(0, 1), a2 + hstepA, voffA);
            PG8_WAIT_V(8); PG8_WAIT_L(0); PG8_BAR; PG8_MMA(0, 0, At, B0); PG8_MMA(0, 1, At, B1); PG8_BAR; PG8_SCHED;
            PG8_LDA(At, 1, 1); PG8_STAGE(PG8_SB(1, 0), b3, voffB); PG8_STAGE(PG8_SB(1, 1), b3 + hstepB, voffB); PG8_STAGE(PG8_SA(1, 0), a3, voffA);
            PG8_WAIT_V(8); PG8_WAIT_L(0); PG8_BAR; PG8_MMA(1, 0, At, B0); PG8_MMA(1, 1, At, B1); PG8_BAR; PG8_SCHED;
            } else {
            PG8_LDB(B0, 0, 0); PG8_SCHED; PG8_LDA(At, 0, 0); PG8_STAGE(PG8_SA(1, 1), a1 + hstepA, voffA);
            PG8_WAIT_L(8); PG8_BAR; PG8_WAIT_L(0); PG8_MMA(0, 0, At, B0); PG8_BAR; PG8_SCHED;
            PG8_LDB(B1, 0, 1); PG8_STAGE(PG8_SB(0, 0), b2, voffB);
            PG8_BAR; PG8_WAIT_L(0); PG8_MMA(0, 1, At, B1); PG8_BAR;
            PG8_LDA(At, 0, 1); PG8_STAGE(PG8_SA(0, 0), a2, voffA);
            PG8_BAR; PG8_WAIT_L(0); PG8_MMA(1, 0, At, B0); PG8_BAR; PG8_SCHED;
            PG8_STAGE(PG8_SB(0, 1), b2 + hstepB, voffB);
            PG8_WAIT_V(6); PG8_BAR; PG8_MMA(1, 1, At, B1); PG8_BAR;
            PG8_LDB(B0, 1, 0); PG8_SCHED; PG8_LDA(At, 1, 0); PG8_STAGE(PG8_SA(0, 1), a2 + hstepA, voffA);
            PG8_WAIT_L(8); PG8_BAR; PG8_WAIT_L(0); PG8_MMA(0, 0, At, B0); PG8_BAR; PG8_SCHED;
            PG8_LDB(B1, 1, 1); PG8_STAGE(PG8_SB(1, 0), b3, voffB);
            PG8_BAR; PG8_WAIT_L(0); PG8_MMA(0, 1, At, B1); PG8_BAR;
            PG8_LDA(At, 1, 1); PG8_STAGE(PG8_SA(1, 0), a3, voffA);
            PG8_BAR; PG8_WAIT_L(0); PG8_MMA(1, 0, At, B0); PG8_BAR; PG8_SCHED;
            PG8_STAGE(PG8_SB(1, 1), b3 + hstepB, voffB);
            PG8_WAIT_V(6); PG8_BAR; PG8_MMA(1, 1, At, B1); PG8_BAR;
            }
        }
        if constexpr (ALIGN_EPI) { if (wr == 0) PG8_BAR; }
        if constexpr (!Epi::AFTER_DRAIN) { E(acc, cur, wr, wc, fr, fq); S.done(cur); }
        if (!has_next) break;
#pragma unroll
        for (int a = 0; a < 2; ++a)
#pragma unroll
            for (int b = 0; b < 2; ++b)
#pragma unroll
                for (int m = 0; m < 4; ++m)
#pragma unroll
                    for (int n = 0; n < 2; ++n) acc[a][b][m][n] = (f32x4){0.f, 0.f, 0.f, 0.f};
        cur = nxt; cA = nA; cB = nB; ++ui;
        if constexpr (ALIGN_EPI) { if (wr == 1) PG8_BAR; }
    }
    PG8_WAIT_V(0);
    if constexpr (!ALIGN_EPI) { if (wr == 0) PG8_BAR; }
    PG8_BAR;
    if constexpr (Epi::AFTER_DRAIN) { E.fused(acc, cur, wr, wc, fr, fq, lds, wid, lane); S.done(cur); }
#undef PG8_SA
#undef PG8_SB
#undef PG8_STAGE
#undef PG8_LDA
#undef PG8_LDB
#undef PG8_MMA
#undef PG8_WAIT_V
#undef PG8_WAIT_L
#undef PG8_BAR
#undef PG8_SCHED
}
}

#ifndef PG8_SP2
#define PG8_SP2 true
#endif
#ifndef PG8_ALIGN
#define PG8_ALIGN true
#endif

namespace pg8 {
struct EpiResF32 {
    static constexpr bool PERM = false, AFTER_DRAIN = false;
    const float* base; float* out; int ldc;
    __device__ __forceinline__ void operator()(const f32x4 (&acc)[2][2][4][2], const Unit& u, int wr, int wc, int fr, int fq) const {
        const int col0 = u.pn * BM + wc * 32 + 4 * fq;
#pragma unroll
        for (int ai = 0; ai < 2; ++ai)
#pragma unroll
            for (int m = 0; m < 4; ++m) { const size_t off = (size_t)(u.pm * BM + ai * HALF + wr * 64 + m * 16 + fr) * ldc + col0;
#pragma unroll
                for (int bj = 0; bj < 2; ++bj)
#pragma unroll
                    for (int n = 0; n < 2; ++n) { const f32x4 b = *(const f32x4*)(base + off + bj * HALF + n * 16); *(f32x4*)(out + off + bj * HALF + n * 16) = b + acc[ai][bj][m][n]; } }
    }
};
}

constexpr int GEMM_LDS = pg8::STAGE_BYTES;

__device__ __forceinline__ void rope_table_elem(float* ct, float* st, int idx) {
    const int pos = idx >> 5, j = idx & 31;
    const float freq = exp2f(-(float)j * (13.287712379549449f / 32.0f));
    const float ang = (float)pos * freq;
    double rev = (double)ang * 0.15915494309189535;
    rev -= floor(rev);
    const float fr = (float)rev;
    ct[idx] = __builtin_amdgcn_cosf(fr);
    st[idx] = __builtin_amdgcn_sinf(fr);
}

__device__ __forceinline__ int win_src_col(int n) {
    if (n < 2560) return n;
    if (n < 3072) return n - 2560 + 3304;
    if (n < 3456) return n - 3072 + 2632;
    if (n < 3712) return n - 3456 + 3016;
    if (n < 3776) return n - 3712 + 2560;
    if (n < 3808) return n - 3776 + 3272;
    if (n < 3816) return n - 3808 + 2624;
    return -1;
}
__device__ __forceinline__ int win_phys2src(int n) {
    const int tile = n >> 8, p = n & 255, bj = p >> 7, wcc = (p >> 5) & 3, i = p & 31;
    const int pairdim = 16 * ((i >> 2) & 1) + 4 * (i >> 3) + (i & 3);
    int logical = n;
    if (tile < 4) logical = ((tile < 2) ? C_QA : C_KA) + 64 * (4 * (tile & 1) + wcc) + 32 * bj + i;
    else if (tile == 8 || tile == 9) logical = C_QI + 64 * (4 * (tile - 8) + wcc) + (bj ? 32 + i : pairdim);
    else if (tile == 14 && bj == 1 && wcc == 0) logical = C_KI + pairdim;
    return win_src_col(logical);
}
__device__ __forceinline__ int wukv_phys2src(int n) {
    const int t = n >> 8, p = n & 255, bj = p >> 7, wcc = (p >> 5) & 3, i = p & 31;
    return 128 * (2 * t + (wcc >> 1)) + 64 * (wcc & 1) + 32 * bj + i;
}
__device__ __forceinline__ void wtrans_tile(LAS float* t, const float* __restrict__ W, int K, int Nold, bf16* __restrict__ WT, int n0, int k0, int mode, const float* __restrict__ gain, int tid) {
    __syncthreads();
    for (int i = tid; i < 4096; i += 512) { const int kk = i >> 6, nn = i & 63; const int n = n0 + nn; const int src = (mode == 1) ? win_phys2src(n) : (mode == 2) ? wukv_phys2src(n) : n;
        float v = (src >= 0) ? W[(size_t)(k0 + kk) * Nold + src] : 0.f; if (gain) v *= gain[k0 + kk];
        t[kk * 65 + nn] = v; }
    __syncthreads();
    for (int i = tid; i < 4096; i += 512) { const int nn = i >> 6, kk = i & 63; WT[(size_t)(n0 + nn) * K + k0 + kk] = (bf16)f2bf(t[kk * 65 + nn]); }
}

__device__ __forceinline__ float wave_sum(float v) {
#pragma unroll
    for (int o = 1; o < 64; o <<= 1) v += __shfl_xor(v, o);
    return v;
}
__device__ __forceinline__ void rmsnorm_x_row(const float* __restrict__ x, const float* __restrict__ g, bf16* __restrict__ xn, int row, int lane) {
    const f32x4_t* xr = (const f32x4_t*)(x + (size_t)row * DMODEL) + lane;
    const f32x4_t* gr = (const f32x4_t*)g + lane;
    f32x4_t v[4]; float s = 0.f;
#pragma unroll
    for (int j = 0; j < 4; ++j) { v[j] = xr[64 * j]; s += (v[j].x * v[j].x + v[j].y * v[j].y) + (v[j].z * v[j].z + v[j].w * v[j].w); }
    const float rs = 1.0f / sqrtf(wave_sum(s) * (1.0f / DMODEL) + RMS_EPS);
    u32x2_t* o = (u32x2_t*)(xn + (size_t)row * DMODEL) + lane;
#pragma unroll
    for (int j = 0; j < 4; ++j) { const f32x4_t gg = gr[64 * j]; u32x2_t w; w.x = pk2(v[j].x * rs * gg.x, v[j].y * rs * gg.y); w.y = pk2(v[j].z * rs * gg.z, v[j].w * rs * gg.w); o[64 * j] = w; }
}


namespace pg8 {
__device__ __forceinline__ float silu_f(float g) { return g * __builtin_amdgcn_rcpf(1.0f + __builtin_amdgcn_exp2f(g * -1.4426950408889634f)); }
__device__ __forceinline__ float fq_sum(float v) {
    const auto a = __builtin_amdgcn_permlane16_swap(__float_as_uint(v), __float_as_uint(v), false, false);
    v = __uint_as_float(a[0]) + __uint_as_float(a[1]);
    const auto b = __builtin_amdgcn_permlane32_swap(__float_as_uint(v), __float_as_uint(v), false, false);
    return __uint_as_float(b[0]) + __uint_as_float(b[1]);
}
__device__ __forceinline__ float dot4(const f32x4 a) { return (a[0] * a[0] + a[1] * a[1]) + (a[2] * a[2] + a[3] * a[3]); }
__device__ __forceinline__ u32x4 pack8(const f32x4 a, const f32x4 b) { u32x4 w; w.x = cvt_pk_bf16(a[0], a[1]); w.y = cvt_pk_bf16(a[2], a[3]); w.z = cvt_pk_bf16(b[0], b[1]); w.w = cvt_pk_bf16(b[2], b[3]); return w; }
typedef unsigned u32x2 __attribute__((ext_vector_type(2)));
__device__ __forceinline__ u32x2 pack4(const f32x4 a) { u32x2 w; w.x = cvt_pk_bf16(a[0], a[1]); w.y = cvt_pk_bf16(a[2], a[3]); return w; }

struct EpiProj {
    static constexpr bool PERM = true, AFTER_DRAIN = false;
    bf16_t* P; float* ssq; const float* aq_g; const float* ak_g; const float* rc; const float* rs;
    __device__ __forceinline__ void operator()(const f32x4 (&acc)[2][2][4][2], const Unit& u, int wr, int wc, int fr, int fq) const {
        asm volatile("" : "+v"(fr), "+v"(fq));
        const int tile = u.pn; const int row0 = u.pm * BM + wr * 64 + fr;
        if (tile < 4) {
            const bool isk = tile >= 2; const float* g = isk ? ak_g : aq_g; const float sc = isk ? 1.0f : C2A;
            const int colbase = (isk ? C_KA : C_QA) + 64 * (4 * (tile & 1) + wc) + 8 * fq;
            const f32x4 g1a = *(const f32x4*)(g + 8 * fq), g1b = *(const f32x4*)(g + 8 * fq + 4), g2a = *(const f32x4*)(g + 32 + 8 * fq), g2b = *(const f32x4*)(g + 36 + 8 * fq);
#pragma unroll
            for (int ai = 0; ai < 2; ++ai)
#pragma unroll
                for (int m = 0; m < 4; ++m) {
                    const int row = row0 + ai * HALF + m * 16, pos = row & (SEQ - 1);
                    const f32x4 x1a = acc[ai][0][m][0], x1b = acc[ai][0][m][1], x2a = acc[ai][1][m][0], x2b = acc[ai][1][m][1];
                    float ss = (dot4(x1a) + dot4(x1b)) + (dot4(x2a) + dot4(x2b));
                    ss = fq_sum(ss);
                    const float rn = sc * __builtin_amdgcn_rsqf(ss * (1.0f / 64.0f) + RMS_EPS);
                    const float* cp = rc + pos * 32 + 8 * fq; const float* sp = rs + pos * 32 + 8 * fq;
                    const f32x4 ca = *(const f32x4*)cp, cb = *(const f32x4*)(cp + 4), sa = *(const f32x4*)sp, sb = *(const f32x4*)(sp + 4);
                    const f32x4 a0 = x1a * rn * g1a, a1 = x1b * rn * g1b, b0 = x2a * rn * g2a, b1 = x2b * rn * g2b;
                    bf16_t* dst = P + (size_t)row * NP + colbase;
                    *(u32x4*)dst = pack8(a0 * ca - b0 * sa, a1 * cb - b1 * sb);
                    *(u32x4*)(dst + 32) = pack8(b0 * ca + a0 * sa, b1 * cb + a1 * sb);
                }
        } else if (tile == 8 || tile == 9) {
            const int colbase = C_QI + 64 * (4 * (tile - 8) + wc);
#pragma unroll
            for (int ai = 0; ai < 2; ++ai)
#pragma unroll
                for (int m = 0; m < 4; ++m) {
                    const int row = row0 + ai * HALF + m * 16, pos = row & (SEQ - 1);
                    const float* cp = rc + pos * 32 + 8 * fq; const float* sp = rs + pos * 32 + 8 * fq;
                    const f32x4 c0 = *(const f32x4*)cp, c1 = *(const f32x4*)(cp + 4), s0 = *(const f32x4*)sp, s1 = *(const f32x4*)(sp + 4);
                    const f32x4 c = (f32x4){c0[0], c0[2], c1[0], c1[2]}, s = (f32x4){s0[0], s0[2], s1[0], s1[2]};
                    const f32x4 x1 = acc[ai][0][m][0], x2 = acc[ai][0][m][1];
                    bf16_t* dst = P + (size_t)row * NP + colbase;
                    *(u32x2*)(dst + 4 * fq) = pack4(x1 * c - x2 * s);
                    *(u32x2*)(dst + 16 + 4 * fq) = pack4(x2 * c + x1 * s);
                    *(u32x4*)(dst + 32 + 8 * fq) = pack8(acc[ai][1][m][0], acc[ai][1][m][1]);
                }
        } else if (tile == 14) {
#pragma unroll
            for (int ai = 0; ai < 2; ++ai)
#pragma unroll
                for (int m = 0; m < 4; ++m) {
                    const int row = row0 + ai * HALF + m * 16, pos = row & (SEQ - 1);
                    bf16_t* dst = P + (size_t)row * NP + tile * BM;
                    float ss = dot4(acc[ai][0][m][0]) + dot4(acc[ai][0][m][1]);
                    ss = fq_sum(ss);
                    if (fq == 0) ssq[(size_t)row * 24 + 16 + wc] = ss;
                    *(u32x4*)(dst + 32 * wc + 8 * fq) = pack8(acc[ai][0][m][0], acc[ai][0][m][1]);
                    if (wc == 0) {
                        const float* cp = rc + pos * 32 + 8 * fq; const float* sp = rs + pos * 32 + 8 * fq;
                        const f32x4 c0 = *(const f32x4*)cp, c1 = *(const f32x4*)(cp + 4), s0 = *(const f32x4*)sp, s1 = *(const f32x4*)(sp + 4);
                        const f32x4 c = (f32x4){c0[0], c0[2], c1[0], c1[2]}, s = (f32x4){s0[0], s0[2], s1[0], s1[2]};
                        const f32x4 x1 = acc[ai][1][m][0], x2 = acc[ai][1][m][1];
                        *(u32x2*)(dst + HALF + 4 * fq) = pack4(x1 * c - x2 * s);
                        *(u32x2*)(dst + HALF + 16 + 4 * fq) = pack4(x2 * c + x1 * s);
                    } else {
                        *(u32x4*)(dst + HALF + 32 * wc + 8 * fq) = pack8(acc[ai][1][m][0], acc[ai][1][m][1]);
                    }
                }
        } else {
            const bool gate = (tile == 6 || tile == 7 || tile == 10 || tile == 11), lat = (tile >= 12);
#pragma unroll
            for (int ai = 0; ai < 2; ++ai)
#pragma unroll
                for (int m = 0; m < 4; ++m) {
                    const int row = row0 + ai * HALF + m * 16;
                    bf16_t* dst = P + (size_t)row * NP + tile * BM + 32 * wc + 8 * fq;
#pragma unroll
                    for (int bj = 0; bj < 2; ++bj) {
                        f32x4 v0 = acc[ai][bj][m][0], v1 = acc[ai][bj][m][1];
                        if (lat) { float ss = dot4(v0) + dot4(v1); ss = fq_sum(ss);
                            if (fq == 0) ssq[(size_t)row * 24 + (tile == 12 ? 4 * bj : 8 + 4 * bj) + wc] = ss; }
                        if (gate) { v0 = (f32x4){silu_f(v0[0]), silu_f(v0[1]), silu_f(v0[2]), silu_f(v0[3])}; v1 = (f32x4){silu_f(v1[0]), silu_f(v1[1]), silu_f(v1[2]), silu_f(v1[3])}; }
                        *(u32x4*)(dst + bj * HALF) = pack8(v0, v1);
                    }
                }
        }
    }
};

struct EpiKV {
    static constexpr bool PERM = true, AFTER_DRAIN = false;
    bf16_t* KB; bf16_t* VB; const bf16_t* P; const float* ssq; const float* bk_g; const float* rc; const float* rs;
    __device__ __forceinline__ float row_rkv(int row) const {
        const f32x4 q0 = *(const f32x4*)(ssq + (size_t)row * 24 + 12), q1 = *(const f32x4*)(ssq + (size_t)row * 24 + 16);
        return __builtin_amdgcn_rsqf((((q0[0] + q0[1]) + (q0[2] + q0[3])) + ((q1[0] + q1[1]) + (q1[2] + q1[3]))) * (1.0f / 256.0f) + RMS_EPS);
    }
    __device__ __forceinline__ void operator()(const f32x4 (&acc)[2][2][4][2], const Unit& u, int wr, int wc, int fr, int fq) const {
        asm volatile("" : "+v"(fr), "+v"(fq));
        const int head = 2 * u.pn + (wc >> 1); const int row0 = u.pm * BM + wr * 64 + fr;
        if (wc & 1) {
#pragma unroll
            for (int ai = 0; ai < 2; ++ai)
#pragma unroll
                for (int m = 0; m < 4; ++m) {
                    const int row = row0 + ai * HALF + m * 16;
                    const float rkv = row_rkv(row);
                    bf16_t* dst = VB + (size_t)row * 512 + 64 * head + 8 * fq;
#pragma unroll
                    for (int bj = 0; bj < 2; ++bj) *(u32x4*)(dst + 32 * bj) = pack8(acc[ai][bj][m][0] * rkv, acc[ai][bj][m][1] * rkv);
                    asm volatile("" ::: "memory");
                }
        } else {
#pragma unroll
            for (int ai = 0; ai < 2; ++ai)
#pragma unroll
                for (int m = 0; m < 4; ++m) {
                    const int row = row0 + ai * HALF + m * 16, pos = row & (SEQ - 1);
                    const float rkv = row_rkv(row);
                    const u32x2 k1 = *(const u32x2*)(P + (size_t)row * NP + C_KR + 4 * fq), k2 = *(const u32x2*)(P + (size_t)row * NP + C_KR + 16 + 4 * fq);
                    const f32x4 x1 = (f32x4){bflo(k1.x), bfhi(k1.x), bflo(k1.y), bfhi(k1.y)}, x2 = (f32x4){bflo(k2.x), bfhi(k2.x), bflo(k2.y), bfhi(k2.y)};
                    float ssn = (dot4(acc[ai][0][m][0]) + dot4(acc[ai][0][m][1])) + (dot4(acc[ai][1][m][0]) + dot4(acc[ai][1][m][1]));
                    float ssr = dot4(x1) + dot4(x2);
                    ssn = fq_sum(ssn); ssr = fq_sum(ssr);
                    const float rk = __builtin_amdgcn_rsqf((ssn * rkv * rkv + ssr) * (1.0f / 96.0f) + RMS_EPS);
                    bf16_t* dst = KB + (size_t)row * 768 + 96 * head;
                    const float sn = rkv * rk;
#pragma unroll
                    for (int bj = 0; bj < 2; ++bj) { const f32x4 g0 = *(const f32x4*)(bk_g + 32 * bj + 8 * fq), g1 = *(const f32x4*)(bk_g + 32 * bj + 8 * fq + 4);
                        *(u32x4*)(dst + 32 * bj + 8 * fq) = pack8(acc[ai][bj][m][0] * sn * g0, acc[ai][bj][m][1] * sn * g1); }
                    const f32x4 gr1 = *(const f32x4*)(bk_g + 64 + 4 * fq), gr2 = *(const f32x4*)(bk_g + 80 + 4 * fq);
                    const float* cp = rc + pos * 32 + 8 * fq; const float* sp = rs + pos * 32 + 8 * fq;
                    const f32x4 c0 = *(const f32x4*)cp, c1 = *(const f32x4*)(cp + 4), s0 = *(const f32x4*)sp, s1 = *(const f32x4*)(sp + 4);
                    const f32x4 c = (f32x4){c0[0], c0[2], c1[0], c1[2]}, s = (f32x4){s0[0], s0[2], s1[0], s1[2]};
                    const f32x4 a = x1 * rk * gr1, b = x2 * rk * gr2;
                    *(u32x2*)(dst + 64 + 4 * fq) = pack4(a * c - b * s);
                    *(u32x2*)(dst + 80 + 4 * fq) = pack4(b * c + a * s);
                    asm volatile("" ::: "memory");
                }
        }
    }
};
}

constexpr int IDX_KPITCH = 2048 * 4 + 16;
constexpr int IDX_QPITCH = 1040;
constexpr int IDX_KEYS = 0, IDX_QT = 16 * IDX_KPITCH, IDX_W = IDX_QT + 16 * IDX_QPITCH, IDX_M = IDX_W + 16 * 8 * 4, IDX_MP = 65, IDX_END = IDX_M + 32 * IDX_MP * 4;
constexpr int TOPK = 256;
typedef float f32x4i_t __attribute__((ext_vector_type(4)));

__device__ __forceinline__ unsigned wave_sum_u32(unsigned v) {
    v += (unsigned)__builtin_amdgcn_update_dpp(0, (int)v, 0xB1, 0xF, 0xF, false);
    v += (unsigned)__builtin_amdgcn_update_dpp(0, (int)v, 0x4E, 0xF, 0xF, false);
    v += (unsigned)__builtin_amdgcn_update_dpp(0, (int)v, 0x141, 0xF, 0xF, false);
    v += (unsigned)__builtin_amdgcn_update_dpp(0, (int)v, 0x140, 0xF, 0xF, false);
    const auto a = __builtin_amdgcn_permlane16_swap(v, v, false, false); v = a[0] + a[1];
    const auto b = __builtin_amdgcn_permlane32_swap(v, v, false, false); return b[0] + b[1];
}
__device__ __forceinline__ unsigned wave_incl_scan_u32(unsigned v) {
    v += (unsigned)__builtin_amdgcn_update_dpp(0, (int)v, 0x111, 0xF, 0xF, false);
    v += (unsigned)__builtin_amdgcn_update_dpp(0, (int)v, 0x112, 0xF, 0xF, false);
    v += (unsigned)__builtin_amdgcn_update_dpp(0, (int)v, 0x114, 0xF, 0xF, false);
    v += (unsigned)__builtin_amdgcn_update_dpp(0, (int)v, 0x118, 0xF, 0xF, false);
    v += (unsigned)__builtin_amdgcn_update_dpp(0, (int)v, 0x142, 0xA, 0xF, false);
    v += (unsigned)__builtin_amdgcn_update_dpp(0, (int)v, 0x143, 0xC, 0xF, false);
    return v;
}
__device__ __forceinline__ unsigned ge01(unsigned key, unsigned cm1) {
    unsigned t, u;
    asm("v_sub_u32_e64 %0, %1, %2 clamp" : "=v"(t) : "v"(key), "s"(cm1));
    asm("v_min_u32_e32 %0, 1, %1" : "=v"(u) : "v"(t));
    return u;
}
__device__ __forceinline__ unsigned sortable_key(float x) { const unsigned u = __builtin_bit_cast(unsigned, x + 0.0f); return (u & 0x80000000u) ? ~u : (u | 0x80000000u); }

__device__ __forceinline__ void indexer_unit(LAS unsigned char* lds, const bf16* __restrict__ proj, unsigned long long* __restrict__ mask, int b, int qb) {
    const int tid = opaque_tid(), lane = tid & 63, w = __builtin_amdgcn_readfirstlane(tid >> 6);
    const int L = 64 * ((qb >> 1) + 1), nt32 = L >> 5;
    unsigned long long* mbase = mask + ((size_t)(b * 64 + qb) * 64) * 16;
    if (L <= TOPK) {
        for (int j = w; j < nt32; j += 8) if (lane < 16) mbase[(size_t)j * 16 + lane] = ~0ull;
        return;
    }
    const int ni = L >> 6, nt16 = L >> 4;
    LAS unsigned* Mw = (LAS unsigned*)(lds + IDX_M);
    for (int sub = 0; sub < 2; ++sub) {
        const size_t row0 = (size_t)b * SEQ + 32 * qb + 16 * sub;
        __syncthreads();
        for (int c = tid; c < 16 * 64; c += 512) { const int r = c >> 6, ch = c & 63;
            *(LAS u32x4_t*)(lds + IDX_QT + r * IDX_QPITCH + ch * 16) = *(const u32x4_t*)(proj + (row0 + r) * NP + C_QI + ch * 8); }
        if (tid < 128) { const int q = tid & 15, hh = tid >> 4; ((LAS float*)(lds + IDX_W))[hh * 16 + q] = bf2f(proj[(row0 + q) * NP + C_WI + hh]); }
        __syncthreads();
        {
            const int q = lane & 15, g = lane >> 4;
            const LAS unsigned char* qrow = lds + IDX_QT + q * IDX_QPITCH + g * 16;
            const LAS float* wl = (const LAS float*)(lds + IDX_W) + q;
            bf16x8_t qf[8][2]; float wv[8];
#pragma unroll
            for (int h = 0; h < 8; ++h) { qf[h][0] = *(const LAS bf16x8_t*)(qrow + (64 * h) * 2); qf[h][1] = *(const LAS bf16x8_t*)(qrow + (64 * h + 32) * 2); wv[h] = wl[h * 16]; }
            const bf16* kp = proj + ((size_t)b * SEQ + q) * NP + C_KI + 8 * g;
            bf16x8_t kn0 = *(const bf16x8_t*)(kp + (size_t)(16 * w) * NP), kn1 = *(const bf16x8_t*)(kp + (size_t)(16 * w) * NP + 32);
            for (int j = w; j < nt16; j += 8) {
                const bf16x8_t kf0 = kn0, kf1 = kn1;
                if (j + 8 < nt16) { kn0 = *(const bf16x8_t*)(kp + (size_t)(16 * (j + 8)) * NP); kn1 = *(const bf16x8_t*)(kp + (size_t)(16 * (j + 8)) * NP + 32); }
                f32x4i_t tot = (f32x4i_t){0.f, 0.f, 0.f, 0.f};
#pragma unroll
                for (int h = 0; h < 8; ++h) {
                    f32x4i_t acc = (f32x4i_t){0.f, 0.f, 0.f, 0.f};
                    acc = __builtin_amdgcn_mfma_f32_16x16x32_bf16(kf0, qf[h][0], acc, 0, 0, 0);
                    acc = __builtin_amdgcn_mfma_f32_16x16x32_bf16(kf1, qf[h][1], acc, 0, 0, 0);
#pragma unroll
                    for (int r = 0; r < 4; ++r) tot[r] = fmaf(wv[h], fmaxf(acc[r], 0.f), tot[r]);
                }
                u32x4_t kk; kk.x = sortable_key(tot[0]); kk.y = sortable_key(tot[1]); kk.z = sortable_key(tot[2]); kk.w = sortable_key(tot[3]);
                *(LAS u32x4_t*)(lds + IDX_KEYS + q * IDX_KPITCH + (16 * j + 4 * g) * 4) = kk;
            }
            const int Lr = (L + 255) & ~255;
            for (int c = tid; c < 16 * ((Lr - L) >> 2); c += 512) { const int r = c / ((Lr - L) >> 2), ch = c % ((Lr - L) >> 2);
                *(LAS u32x4_t*)(lds + IDX_KEYS + r * IDX_KPITCH + (L + 4 * ch) * 4) = (u32x4_t){0u, 0u, 0u, 0u}; }
        }
        __syncthreads();
#pragma unroll 1
        for (int qi = 0; qi < 2; ++qi) {
            const int q = 2 * w + qi;
            const LAS unsigned* krow = (const LAS unsigned*)(lds + IDX_KEYS + q * IDX_KPITCH) + lane;
            unsigned key[32];
#pragma unroll
            for (int i4 = 0; i4 < 8; ++i4) {
                if (4 * i4 < ni) {
#pragma unroll
                    for (int i = 4 * i4; i < 4 * i4 + 4; ++i) key[i] = krow[64 * i];
                } else {
#pragma unroll
                    for (int i = 4 * i4; i < 4 * i4 + 4; ++i) key[i] = 0u;
                } }
            LAS unsigned* hist = (LAS unsigned*)(lds + IDX_QT) + w * 336;
            unsigned T = 0u; int need = TOPK, ceq = 0; const unsigned dummy = 256u + (unsigned)lane;
            int cgt = 0;
            for (int bit = 31; bit >= 24; --bit) {
                const unsigned cand = T | (1u << bit); const unsigned cm1 = (unsigned)__builtin_amdgcn_readfirstlane(cand - 1u);
                unsigned c0 = 0u, c1 = 0u;
#pragma unroll
                for (int i4 = 0; i4 < 8; ++i4) if (4 * i4 < ni) {
#pragma unroll
                    for (int i = 4 * i4; i < 4 * i4 + 4; i += 2) { c0 += ge01(key[i], cm1); c1 += ge01(key[i + 1], cm1); } }
                const int cnt = (int)__builtin_amdgcn_readfirstlane(wave_sum_u32(c0 + c1));
                if (cnt >= TOPK) T = cand; else cgt = cnt;
            }
            need = TOPK - cgt;
#pragma unroll
            for (int pass = 1; pass < 4; ++pass) {
                const int shift = 24 - 8 * pass;
                ((LAS u32x4_t*)hist)[lane] = (u32x4_t){0u, 0u, 0u, 0u};
                asm volatile("s_waitcnt lgkmcnt(0)" ::: "memory");
#pragma unroll
                for (int i4 = 0; i4 < 8; ++i4) if (4 * i4 < ni) {
#pragma unroll
                    for (int i = 4 * i4; i < 4 * i4 + 4; ++i) {
                        const unsigned k = key[i];
                        const bool mt = (pass == 0) ? true : ((k >> ((shift + 8) & 31)) == (T >> ((shift + 8) & 31)));
                        if (pass < 2 || __ballot(mt) != 0ull)
                            __hip_atomic_fetch_add(hist + (mt ? ((k >> shift) & 255u) : dummy), 1u, __ATOMIC_RELAXED, __HIP_MEMORY_SCOPE_WORKGROUP);
                    } }
                asm volatile("s_waitcnt lgkmcnt(0)" ::: "memory");
                const int base = 4 * (63 - lane);
                const u32x4_t h4 = *(const LAS u32x4_t*)(hist + base);
                const unsigned s = (h4.x + h4.y) + (h4.z + h4.w);
                const unsigned pin = wave_incl_scan_u32(s);
                const unsigned long long bm = __ballot(pin >= (unsigned)need);
                const int ls = __builtin_amdgcn_readfirstlane(__builtin_ctzll(bm | 0x8000000000000000ull));
                unsigned c = pin - s; int dig; unsigned kn, ce;
                if (c + h4.w >= (unsigned)need) { dig = base + 3; kn = (unsigned)need - c; ce = h4.w; }
                else { c += h4.w;
                    if (c + h4.z >= (unsigned)need) { dig = base + 2; kn = (unsigned)need - c; ce = h4.z; }
                    else { c += h4.z;
                        if (c + h4.y >= (unsigned)need) { dig = base + 1; kn = (unsigned)need - c; ce = h4.y; }
                        else { c += h4.y; dig = base; kn = (unsigned)need - c; ce = h4.x; } } }
                const unsigned digit = (unsigned)__builtin_amdgcn_readlane(dig, ls);
                need = __builtin_amdgcn_readlane((int)kn, ls); ceq = __builtin_amdgcn_readlane((int)ce, ls);
                T |= digit << shift;
            }
            const int cge = (ceq == need) ? TOPK : TOPK + 1;
            int taken = 0; unsigned mlo = 0u, mhi = 0u;
#define IDX_SELSTEP(I) { unsigned long long sel; \
                if (cge == TOPK) sel = __ballot(key[I] >= T && key[I] != 0u); \
                else { const bool eq = key[I] == T; const unsigned long long em = __ballot(eq); \
                       const int rank = taken + (int)__builtin_amdgcn_mbcnt_hi((unsigned)(em >> 32), __builtin_amdgcn_mbcnt_lo((unsigned)em, 0u)); \
                       sel = __ballot(key[I] > T || (eq && rank < need)); taken += __popcll(em); } \
                const unsigned slo = (unsigned)sel, shi = (unsigned)(sel >> 32); \
                asm volatile("v_writelane_b32 %0, %1, %2" : "+v"(mlo) : "s"(slo), "n"(I)); asm volatile("v_writelane_b32 %0, %1, %2" : "+v"(mhi) : "s"(shi), "n"(I)); }
#define IDX_SELGRP(G) if (4 * (G) < ni) { IDX_SELSTEP(4 * (G)) IDX_SELSTEP(4 * (G) + 1) IDX_SELSTEP(4 * (G) + 2) IDX_SELSTEP(4 * (G) + 3) }
            IDX_SELGRP(0) IDX_SELGRP(1) IDX_SELGRP(2) IDX_SELGRP(3) IDX_SELGRP(4) IDX_SELGRP(5) IDX_SELGRP(6) IDX_SELGRP(7)
#undef IDX_SELGRP
#undef IDX_SELSTEP
            if (lane < 32) { LAS unsigned* mrow = Mw + (16 * sub + q) * IDX_MP; mrow[2 * lane] = mlo; mrow[2 * lane + 1] = mhi; }
        }
    }
    __syncthreads();
    {
        const int q = lane & 31, hi = lane >> 5;
        for (int j = w; j < nt32; j += 8) {
            const unsigned h2 = Mw[q * IDX_MP + j] >> (4 * hi);
            unsigned long long mine = 0ull;
#pragma unroll
            for (int r = 0; r < 16; ++r) { const unsigned long long bal = __ballot(((h2 >> ((r & 3) + 8 * (r >> 2))) & 1u) != 0u); if (lane == r) mine = bal; }
            if (lane < 16) mbase[(size_t)j * 16 + lane] = mine;
        }
    }
}

struct AttnArgs { const bf16* Q; const bf16* K; const bf16* V; const bf16* G; bf16* O; const unsigned long long* mask; const float* ssq; const float* qg; const float* rc; const float* rs;
                  int qpitch, qhs, kpitch, khs, vpitch, vhs, gpitch, ocol; };
namespace fa {
using bf16x8=__attribute__((ext_vector_type(8)))short;
using s16x4=__attribute__((ext_vector_type(4)))short;
using f32x16=__attribute__((ext_vector_type(16)))float;
using u32x4=__attribute__((ext_vector_type(4)))unsigned;
constexpr int SEQ=2048,D=64;
constexpr int NW=8,QBLK=32,QB=QBLK*NW,KVBLK=64,NQB=SEQ/QB;
__device__ __forceinline__ int crow(int r,int hi){return (r&3)+8*(r>>2)+4*hi;}
#define SBAR() __builtin_amdgcn_sched_barrier(0)
__device__ __forceinline__ void allneg(f32x16&p0,f32x16&p1){
  const float NEG=-INFINITY;
  #pragma unroll
  for(int r=0;r<16;++r){p0[r]=NEG;p1[r]=NEG;}
}

constexpr int NSLOT=3, SLOTB=8192, SLOTKMAX=12288;
constexpr int LDS_K=0, LDS_V=NSLOT*SLOTKMAX, LDS_WS=LDS_V+NSLOT*SLOTB, LDS_OST=LDS_WS+NW*64*4, LDS_BYTES=LDS_OST+NW*4096;
__device__ __forceinline__ void glds16(const void*gsrc,unsigned lds_dst){unsigned keep;
  asm volatile("s_mov_b32 %0, m0\n\ts_mov_b32 m0, %2\n\ts_nop 0\n\tglobal_load_lds_dwordx4 %1, off\n\ts_mov_b32 m0, %0":"=&s"(keep):"v"(gsrc),"s"(lds_dst):"memory");}
__device__ __forceinline__ float max3f(float a,float b,float c){float r;asm("v_max3_f32 %0, %1, %2, %3":"=v"(r):"v"(a),"v"(b),"v"(c));return r;}
__device__ __forceinline__ float max2f(float a,float b){float r;asm("v_max_f32_e32 %0, %1, %2":"=v"(r):"v"(a),"v"(b));return r;}
__device__ __forceinline__ float fadd_s(float a,float b){float r;asm("v_add_f32_e32 %0, %1, %2":"=v"(r):"v"(a),"v"(b));return r;}
__device__ __forceinline__ float fsub_s(float a,float b){float r;asm("v_sub_f32_e32 %0, %1, %2":"=v"(r):"v"(a),"v"(b));return r;}
typedef float f32x2_t __attribute__((ext_vector_type(2))); typedef __bf16 bf16x2_t __attribute__((ext_vector_type(2)));
__device__ __forceinline__ unsigned cvtpk_s(float lo,float hi){f32x2_t v={lo,hi};bf16x2_t b=__builtin_convertvector(v,bf16x2_t);return __builtin_bit_cast(unsigned,b);}
#define WAIT_BAR(N) asm volatile("s_waitcnt vmcnt(" #N ") lgkmcnt(0)\n\ts_barrier":::"memory")

template<int NS> __device__ __forceinline__ void qkt(f32x16&p0,f32x16&p1,const char*Kslot,const bf16x8*qr,int r32,int hi){
  const char*kb=Kslot+hi*1024+r32*16;
  #pragma unroll
  for(int d0=0;d0<NS;++d0){
    const bf16x8 b0=*reinterpret_cast<const bf16x8*>(kb+d0*2048);
    const bf16x8 b1=*reinterpret_cast<const bf16x8*>(kb+d0*2048+512);
    if(d0==0){p0=__builtin_amdgcn_mfma_f32_32x32x16_bf16(b0,qr[0],f32x16{},0,0,0);p1=__builtin_amdgcn_mfma_f32_32x32x16_bf16(b1,qr[0],f32x16{},0,0,0);}
    else{p0=__builtin_amdgcn_mfma_f32_32x32x16_bf16(b0,qr[d0],p0,0,0,0);p1=__builtin_amdgcn_mfma_f32_32x32x16_bf16(b1,qr[d0],p1,0,0,0);}}
}
typedef __attribute__((address_space(3))) const char* lds_cptr;
typedef short v4i16_t __attribute__((ext_vector_type(4)));
template<int NS> __device__ __forceinline__ void kloadN(bf16x8*kf,lds_cptr kp){
  #pragma unroll
  for(int d0=0;d0<NS;++d0){ kf[2*d0]=*(const __attribute__((address_space(3))) bf16x8*)(kp+d0*2048); kf[2*d0+1]=*(const __attribute__((address_space(3))) bf16x8*)(kp+d0*2048+512); }
}
__device__ __forceinline__ void kload2(bf16x8*kf,lds_cptr kp,int j){ kf[2*j]=*(const __attribute__((address_space(3))) bf16x8*)(kp+j*2048); kf[2*j+1]=*(const __attribute__((address_space(3))) bf16x8*)(kp+j*2048+512); }
__device__ __forceinline__ s16x4 vtr(lds_cptr p){ return __builtin_bit_cast(s16x4,__builtin_amdgcn_ds_read_tr16_b64_v4i16((__attribute__((address_space(3))) v4i16_t*)p)); }
__device__ __forceinline__ float rowmax(const f32x16&p0,const f32x16&p1){
  float a=max3f(p0[0],p0[1],p1[0]),b=max3f(p0[2],p0[3],p1[1]);a=max3f(a,p1[2],p1[3]);
  #pragma unroll
  for(int r=4;r<16;r+=4){a=max3f(a,p0[r],p0[r+1]);b=max3f(b,p0[r+2],p0[r+3]);a=max3f(a,p1[r],p1[r+1]);b=max3f(b,p1[r+2],p1[r+3]);}
  const float m=max2f(a,b);
  auto rr=__builtin_amdgcn_permlane32_swap(__float_as_uint(m),__float_as_uint(m),false,false);
  return max2f(__uint_as_float(rr[0]),__uint_as_float(rr[1]));
}
__device__ __forceinline__ void pv(f32x16*o,int vb,bf16x8 pa0,bf16x8 pa1,bf16x8 pa2,bf16x8 pa3){
  #pragma unroll
  for(int d0=0;d0<2;++d0){s16x4 lo[4],hi[4];
    #pragma unroll
    for(int ks=0;ks<4;++ks){
      asm volatile("ds_read_b64_tr_b16 %0,%1 offset:%c2":"=&v"(lo[ks]):"v"(vb),"i"(d0*4096+ks*1024):"memory");
      asm volatile("ds_read_b64_tr_b16 %0,%1 offset:%c2":"=&v"(hi[ks]):"v"(vb),"i"(d0*4096+ks*1024+512):"memory");}
    asm volatile("s_waitcnt lgkmcnt(0)":::"memory");SBAR();
    #define PK(k) (bf16x8){lo[k][0],lo[k][1],lo[k][2],lo[k][3],hi[k][0],hi[k][1],hi[k][2],hi[k][3]}
    o[d0]=__builtin_amdgcn_mfma_f32_32x32x16_bf16(pa0,PK(0),o[d0],0,0,0);
    o[d0]=__builtin_amdgcn_mfma_f32_32x32x16_bf16(pa1,PK(1),o[d0],0,0,0);
    o[d0]=__builtin_amdgcn_mfma_f32_32x32x16_bf16(pa2,PK(2),o[d0],0,0,0);
    o[d0]=__builtin_amdgcn_mfma_f32_32x32x16_bf16(pa3,PK(3),o[d0],0,0,0);
    #undef PK
  }
}

#ifndef ATTN_STORE16
#define ATTN_STORE16(p,v) (*(u32x4*)(p)=(v))
#endif
template<int THRL,bool SEL,int NS,bool QN> __device__ __forceinline__ void attn_unit(int b,int h,int qb,const AttnArgs&a,char*shm){
  const int tid=opaque_tid(),lane=tid&63,r32=lane&31,hi=lane>>5; const int wid=__builtin_amdgcn_readfirstlane(tid>>6);
  const long rowbase=(long)b*SEQ; const int q0=qb*QB;
  const long qpitch=a.qpitch,kpitch=a.kpitch,vpitch=a.vpitch;
  const bf16*Qw=a.Q+(rowbase+q0+wid*QBLK)*qpitch+h*a.qhs;
  const bf16*Kh=a.K+rowbase*kpitch+h*a.khs,*Vh=a.V+rowbase*vpitch+h*a.vhs;
  typedef const __attribute__((address_space(4))) unsigned long long* cmask_t;
  const cmask_t mrow=SEL?(cmask_t)(a.mask+((size_t)(b*64+(q0>>5)+wid)*64)*16):(cmask_t)nullptr;
  unsigned long long mk[32];
  const unsigned lds0=(unsigned)(uintptr_t)shm;
  float*wsf=(float*)(shm+LDS_WS)+wid*64;
  const bf16*ksrc=Kh+(long)lane*kpitch+wid*8;
  const bf16*vsrc=Vh+(long)(16*(wid&3)+(lane>>2))*vpitch+(wid>>2)*32+(lane&3)*8;
  const unsigned kdst=lds0+LDS_K+wid*1024, vdst=lds0+LDS_V+wid*1024;
  const bf16*ksrc2=Kh+(long)lane*kpitch+(8+(wid&3))*8; const unsigned kdst2=lds0+LDS_K+(8+(wid&3))*1024;
  #define KS(sl) (((sl)>>2)*NS)
  #define DMA_K(t,slot) do{ glds16(ksrc+(long)(t)*KVBLK*kpitch,(unsigned)__builtin_amdgcn_readfirstlane(kdst+KS(slot))); if constexpr(NS==6) glds16(ksrc2+(long)(t)*KVBLK*kpitch,(unsigned)__builtin_amdgcn_readfirstlane(kdst2+KS(slot))); }while(0)
  #define WB2() do{ if constexpr(NS==6){WAIT_BAR(3);}else{WAIT_BAR(2);} }while(0)
  #define DMA_V(t,slot) glds16(vsrc+(long)(t)*KVBLK*vpitch,(unsigned)__builtin_amdgcn_readfirstlane(vdst+(slot)))
  const int vb0=(int)(lds0+LDS_V)+((lane>>4)&1)*32+(lane&3)*8+(4*hi+((lane&15)>>2))*64;
  const char*Kbase=shm+LDS_K; bf16x8 kf[2*NS];
  const lds_cptr shm3=(lds_cptr)shm; const lds_cptr kp0=shm3+LDS_K+hi*1024+r32*16; const lds_cptr vp0=shm3+LDS_V+((lane>>4)&1)*32+(lane&3)*8+(4*hi+((lane&15)>>2))*64;
  const int NT=(q0+QB)/KVBLK;
  DMA_K(0,0);DMA_V(0,0);DMA_K(1,SLOTB);
  bf16x8 qr[NS];
  #pragma unroll
  for(int d0=0;d0<NS;++d0)qr[d0]=*reinterpret_cast<const bf16x8*>(&Qw[(long)r32*qpitch+d0*16+hi*8]);
  if constexpr(QN){
    static_assert(NS==6,"QN is the 96-dim head group");
    const long row=rowbase+q0+wid*QBLK+r32; const int pos=q0+wid*QBLK+r32;
    float qv[6][8]; float ss=0.f;
    #pragma unroll
    for(int d0=0;d0<6;++d0){
      #pragma unroll
      for(int j=0;j<8;++j){ qv[d0][j]=bf2f((unsigned short)qr[d0][j]); ss+=qv[d0][j]*qv[d0][j]; } }
    ss+=__shfl_xor(ss,32);
    const float*sq=a.ssq+row*24; float msq=0.f;
    #pragma unroll
    for(int i=0;i<12;++i)msq+=sq[i];
    msq=msq*(1.0f/384.0f)+1e-6f;
    const float rn=C2B*__builtin_amdgcn_rsqf(ss*(1.0f/96.0f)+1e-6f*msq);
    const float*gq=a.qg+8*hi;
    #pragma unroll
    for(int d0=0;d0<4;++d0){
      #pragma unroll
      for(int j=0;j<8;++j)qv[d0][j]*=rn*gq[16*d0+j]; }
    const float*cp=a.rc+pos*32+16*hi,*sp=a.rs+pos*32+16*hi;
    #pragma unroll
    for(int j=0;j<8;++j){ const float x1=qv[4][j]*rn*gq[64+j],x2=qv[5][j]*rn*gq[80+j],c=cp[2*j],s=sp[2*j]; qv[4][j]=x1*c-x2*s; qv[5][j]=x2*c+x1*s; }
    #pragma unroll
    for(int d0=0;d0<6;++d0){ u32x4 w;
      #pragma unroll
      for(int e=0;e<4;++e)w[e]=pk2(qv[d0][2*e],qv[d0][2*e+1]);
      qr[d0]=__builtin_bit_cast(bf16x8,w); }
  }
  float l_reg=0.f;f32x16 o[2];o[0]=f32x16{};o[1]=f32x16{};
  const int qrel=wid*QBLK+r32;
  #define CMASK(P0,P1,t) do{int jb_=(t)-(NT-4); if(jb_>(wid>>1))allneg(P0,P1);}while(0)
  #define MKLOAD(t) do{ if constexpr(SEL){ const cmask_t mw_=mrow+(long)(t)*32; _Pragma("unroll") for(int r=0;r<32;++r)mk[r]=mw_[r]; } }while(0)
  #define MKZ(X,B,WB) do{ if constexpr(SEL){ _Pragma("unroll") for(int r=0;r<4;++r)X[(B)+r]=__builtin_amdgcn_inverse_ballot_w64(mk[(WB)+(B)+r])?X[(B)+r]:0.f; } }while(0)
  #define START(P0,P1) do{ _Pragma("unroll") for(int r=0;r<16;++r)P0[r]=__builtin_amdgcn_exp2f(P0[r]); }while(0)
  #define RESC() do{}while(0)
  f32x16 pA0,pA1,pB0,pB1;
  int sl_prev=0,sl_cur=0,sl_next=SLOTB;
  #define ROT() do{sl_prev=sl_cur;sl_cur=sl_next;sl_next=(sl_next==(NSLOT-1)*SLOTB)?0:sl_next+SLOTB;}while(0)
  MKLOAD(0);
  DMA_K(2,2*SLOTB);
  if constexpr(NS==6){WAIT_BAR(5);}else{WAIT_BAR(3);}
  qkt<NS>(pA0,pA1,Kbase,qr,r32,hi);asm volatile("s_nop 15\n\ts_nop 7":"+v"(pA0),"+v"(pA1));CMASK(pA0,pA1,0);
  START(pA0,pA1);
  _Pragma("unroll") for(int r=0;r<16;++r)pA1[r]=__builtin_amdgcn_exp2f(pA1[r]);
  MKZ(pA0,0,0);MKZ(pA0,4,0);MKZ(pA0,8,0);MKZ(pA0,12,0);MKZ(pA1,0,16);MKZ(pA1,4,16);MKZ(pA1,8,16);MKZ(pA1,12,16);
  WAIT_BAR(0);
  DMA_K(3,0);DMA_V(1,SLOTB);
  ROT();
  kloadN<NS>(kf,kp0+KS(sl_cur));
  WB2();
  s16x4 vlo[8],vhi[8]; u32x4 pw0,pw1,pw2,pw3;
  #define PKW(P,B) cvtpk_s(P[B],P[B+1])
  #define PAF(k) __builtin_bit_cast(bf16x8,pw##k)
  #define VFR(i) (bf16x8){vlo[i][0],vlo[i][1],vlo[i][2],vlo[i][3],vhi[i][0],vhi[i][1],vhi[i][2],vhi[i][3]}
  #define PIN(x) asm volatile("":"+v"(x))
  #define MX3(a,b,c) __builtin_fmaxf(__builtin_fmaxf((a),(b)),(c))
  #define GAPA(MF,A0,A1,A2,A3,W0,W1,PW) do{ MF; sacc+=A0; sacc+=A1; sacc+=A2; sacc+=A3; PIN(sacc); W0; W1; PIN(PW); SBAR(); }while(0)
  #define EX(v) __builtin_amdgcn_exp2f(v)
  #define GAPB(MF,X,B,WB) do{ MF; X[B]=EX(X[B]); X[B+1]=EX(X[B+1]); X[B+2]=EX(X[B+2]); X[B+3]=EX(X[B+3]); MKZ(X,B,WB); PIN(X); SBAR(); }while(0)
  #define VRD(i) do{ vlo[i]=vtr(vp_+(((i)>>2)*4096+((i)&3)*1024)); vhi[i]=vtr(vp_+(((i)>>2)*4096+((i)&3)*1024+512)); }while(0)
  #define KRD(G,j) do{ if(G){ kload2(kf,kp0+KS(sl_next),j); SBAR(); } }while(0)
  #define KRD6(G,j) do{ if constexpr(NS==6){ KRD(G,j); } }while(0)
  #define STEP(C0,C1,P0,P1,t,GK,GV,GL) do{ SBAR(); MKLOAD(t); \
    const lds_cptr vp_=vp0+sl_prev; \
    VRD(0); SBAR(); float sacc=(P0[0]+P0[1]); \
    GAPA(C0=__builtin_amdgcn_mfma_f32_32x32x16_bf16(kf[0],qr[0],f32x16{},0,0,0), P0[2],P0[3],P0[4],P0[5],     pw0[0]=PKW(P0,0), pw0[1]=PKW(P0,2), pw0); \
    VRD(4); SBAR(); GAPA(C1=__builtin_amdgcn_mfma_f32_32x32x16_bf16(kf[1],qr[0],f32x16{},0,0,0), P0[6],P0[7],P0[8],P0[9],     pw0[2]=PKW(P0,4), pw0[3]=PKW(P0,6), pw0); \
    VRD(1); SBAR(); GAPA(C0=__builtin_amdgcn_mfma_f32_32x32x16_bf16(kf[2],qr[1],C0,0,0,0),   P0[10],P0[11],P0[12],P0[13], pw1[0]=PKW(P0,8), pw1[1]=PKW(P0,10), pw1); \
    VRD(5); SBAR(); GAPA(C1=__builtin_amdgcn_mfma_f32_32x32x16_bf16(kf[3],qr[1],C1,0,0,0),   P0[14],P0[15],P1[0],P1[1],   pw1[2]=PKW(P0,12),pw1[3]=PKW(P0,14), pw1); \
    VRD(2); SBAR(); GAPA(C0=__builtin_amdgcn_mfma_f32_32x32x16_bf16(kf[4],qr[2],C0,0,0,0),   P1[2],P1[3],P1[4],P1[5],     pw2[0]=PKW(P1,0), pw2[1]=PKW(P1,2), pw2); \
    VRD(6); SBAR(); GAPA(C1=__builtin_amdgcn_mfma_f32_32x32x16_bf16(kf[5],qr[2],C1,0,0,0),   P1[6],P1[7],P1[8],P1[9],     pw2[2]=PKW(P1,4), pw2[3]=PKW(P1,6), pw2); \
    VRD(3); SBAR(); GAPA(C0=__builtin_amdgcn_mfma_f32_32x32x16_bf16(kf[6],qr[3],C0,0,0,0),   P1[10],P1[11],P1[12],P1[13], pw3[0]=PKW(P1,8), pw3[1]=PKW(P1,10), pw3); \
    VRD(7); SBAR(); GAPA(C1=__builtin_amdgcn_mfma_f32_32x32x16_bf16(kf[7],qr[3],C1,0,0,0),   P1[14],P1[15],0.f,0.f,       pw3[2]=PKW(P1,12),pw3[3]=PKW(P1,14), pw3); \
    if constexpr(NS==6){ C0=__builtin_amdgcn_mfma_f32_32x32x16_bf16(kf[8],qr[4],C0,0,0,0); C1=__builtin_amdgcn_mfma_f32_32x32x16_bf16(kf[9],qr[4],C1,0,0,0); \
      C0=__builtin_amdgcn_mfma_f32_32x32x16_bf16(kf[10],qr[5],C0,0,0,0); C1=__builtin_amdgcn_mfma_f32_32x32x16_bf16(kf[11],qr[5],C1,0,0,0); SBAR(); } \
    l_reg+=sacc; \
    if(GK){DMA_K((t)+3,sl_cur);} if(GV){DMA_V((t)+1,sl_next);} \
    CMASK(C0,C1,t); \
    SBAR(); \
    GAPB(o[0]=__builtin_amdgcn_mfma_f32_32x32x16_bf16(PAF(0),VFR(0),o[0],0,0,0), C0,0,0); \
    GAPB(o[1]=__builtin_amdgcn_mfma_f32_32x32x16_bf16(PAF(0),VFR(4),o[1],0,0,0), C0,4,0); \
    KRD(GL,0); GAPB(o[0]=__builtin_amdgcn_mfma_f32_32x32x16_bf16(PAF(1),VFR(1),o[0],0,0,0), C0,8,0); \
    KRD(GL,1); GAPB(o[1]=__builtin_amdgcn_mfma_f32_32x32x16_bf16(PAF(1),VFR(5),o[1],0,0,0), C0,12,0); \
    KRD(GL,2); GAPB(o[0]=__builtin_amdgcn_mfma_f32_32x32x16_bf16(PAF(2),VFR(2),o[0],0,0,0), C1,0,16); \
    KRD(GL,3); GAPB(o[1]=__builtin_amdgcn_mfma_f32_32x32x16_bf16(PAF(2),VFR(6),o[1],0,0,0), C1,4,16); \
    KRD6(GL,4); GAPB(o[0]=__builtin_amdgcn_mfma_f32_32x32x16_bf16(PAF(3),VFR(3),o[0],0,0,0), C1,8,16); \
    KRD6(GL,5); GAPB(o[1]=__builtin_amdgcn_mfma_f32_32x32x16_bf16(PAF(3),VFR(7),o[1],0,0,0), C1,12,16); \
    }while(0)
  int t=1;
  #undef CMASK
  #define CMASK(P0,P1,t) do{}while(0)
  for(;t+5<NT;t+=2){
    STEP(pB0,pB1,pA0,pA1,t,true,true,true);     WB2(); RESC(); ROT();
    STEP(pA0,pA1,pB0,pB1,t+1,true,true,true);   WB2(); RESC(); ROT();
  }
  #undef CMASK
  #define CMASK(P0,P1,t) do{int jb_=(t)-(NT-4); if(jb_>(wid>>1))allneg(P0,P1);}while(0)
  #define ENDW(tt) do{ if((tt)+3<NT){WB2();} else if((tt)+2<NT){WAIT_BAR(1);} else {WAIT_BAR(0);} }while(0)
  for(;t+1<NT;t+=2){
    STEP(pB0,pB1,pA0,pA1,t,(t+3<NT),(t+1<NT),(t+1<NT));       ENDW(t);   RESC(); ROT();
    STEP(pA0,pA1,pB0,pB1,t+1,(t+4<NT),(t+2<NT),(t+2<NT));     ENDW(t+1); RESC(); ROT();
  }
  STEP(pB0,pB1,pA0,pA1,NT-1,false,false,false); RESC();
  { float sacc=pB0[0]+pB0[1]; _Pragma("unroll") for(int r=2;r<16;++r)sacc+=pB0[r]; _Pragma("unroll") for(int r=0;r<16;++r)sacc+=pB1[r]; l_reg+=sacc;
    pw0=(u32x4){PKW(pB0,0),PKW(pB0,2),PKW(pB0,4),PKW(pB0,6)};pw1=(u32x4){PKW(pB0,8),PKW(pB0,10),PKW(pB0,12),PKW(pB0,14)};pw2=(u32x4){PKW(pB1,0),PKW(pB1,2),PKW(pB1,4),PKW(pB1,6)};pw3=(u32x4){PKW(pB1,8),PKW(pB1,10),PKW(pB1,12),PKW(pB1,14)};
    SBAR(); pv(o,vb0+sl_cur,PAF(0),PAF(1),PAF(2),PAF(3)); }
  #undef PKW
  #undef PAF
  #undef VFR
  #undef PIN
  #undef MX3
  #undef GAPA
  #undef GAPB
  #undef EX
  #undef VRD
  #undef KRD
  #undef KRD6
  #undef STEP
  #undef ENDW
  {auto rr=__builtin_amdgcn_permlane32_swap(__float_as_uint(l_reg),__float_as_uint(l_reg),false,false);l_reg=__uint_as_float(rr[0])+__uint_as_float(rr[1]);}
  if(hi==0)wsf[32+r32]=l_reg;asm volatile("s_waitcnt lgkmcnt(0)":::"memory");
  float rli[16];
  #pragma unroll
  for(int r=0;r<16;++r)rli[r]=__builtin_amdgcn_rcpf(wsf[32+crow(r,hi)]);
  bf16*Ow=a.O+(rowbase+q0+wid*QBLK)*1024+a.ocol+h*D;
  const bf16*Gw=a.G+(rowbase+q0+wid*QBLK)*(long)a.gpitch+h*D;
  { bf16*stg=(bf16*)(shm+LDS_OST)+wid*2048;
    #pragma unroll
    for(int r=0;r<16;++r){const int orow=crow(r,hi);
      #pragma unroll
      for(int d0=0;d0<2;++d0)stg[orow*64+d0*32+r32]=(bf16)f2bf(o[d0][r]*rli[r]);}
    asm volatile("s_waitcnt lgkmcnt(0)":::"memory");
    #pragma unroll
    for(int i=0;i<4;++i){const int row=i*8+(lane>>3),ch=lane&7; const u32x4 v=*(const u32x4*)(stg+row*64+ch*8);
      const u32x4 g=*(const u32x4*)(Gw+(long)row*a.gpitch+ch*8); u32x4 w;
      #pragma unroll
      for(int e=0;e<4;++e) w[e]=pk2(bflo(v[e])*bflo(g[e]),bfhi(v[e])*bfhi(g[e]));
      ATTN_STORE16(Ow+(long)row*1024+ch*8,w);} }
  asm volatile("s_waitcnt lgkmcnt(0)\n\ts_barrier":::"memory");
  #undef DMA_K
  #undef KS
  #undef WB2
  #undef DMA_V
  #undef CMASK
  #undef MKLOAD
  #undef MKZ
  #undef START
  #undef RESC
  #undef ROT
}
constexpr int ATTN_LDS_BYTES=LDS_BYTES;
#undef SBAR
#undef WAIT_BAR
}
#define XB_TMO      128
#define XB_XCNT(j)  (256  + 64 * (j))
#define XB_XSUB(j)  (1280 + 64 * (j))
#define XB_XGEN(j)  (2304 + 64 * (j))
#define XB_TOP      3328
#define XB_TOPGEN   3392
#define XCD_BAR_WORDS 3456
#define XB_SPIN_CAP (1u << 18)

__device__ __forceinline__ unsigned xb_ld(unsigned* p)              { return __hip_atomic_load(p, __ATOMIC_RELAXED, __HIP_MEMORY_SCOPE_AGENT); }
__device__ __forceinline__ unsigned xb_add(unsigned* p, unsigned v) { return __hip_atomic_fetch_add(p, v, __ATOMIC_RELAXED, __HIP_MEMORY_SCOPE_AGENT); }
__device__ __forceinline__ unsigned xb_xcc_id() { return (unsigned)__builtin_amdgcn_s_getreg((3 << 11) | 20) & 0xFu; }
#define XB_SPIN(cond, bar) do { unsigned _sp = 0; while (cond) { __builtin_amdgcn_s_sleep(1); \
    if ((++_sp & 255u) == 0u) { if (xb_ld(&(bar)[XB_TMO])) break; if (_sp > XB_SPIN_CAP) { atomicAdd(&(bar)[XB_TMO], 1u); break; } } } } while (0)

struct XcdBarrier {
    unsigned* bar; unsigned x;
    volatile LAS unsigned* st;
};

__device__ __forceinline__ XcdBarrier xcd_barrier_post(unsigned* bar, volatile LAS unsigned* st) {
    XcdBarrier b; b.bar = bar; b.x = xb_xcc_id(); b.st = st;
    if (threadIdx.x == 0) (void)xb_add(&bar[XB_XCNT(b.x)], 1u);
    return b;
}
__device__ __forceinline__ void xcd_barrier_complete(unsigned* bar, unsigned x, unsigned& nloc, unsigned& nx) {
    const unsigned G = gridDim.x * gridDim.y * gridDim.z;
    unsigned sum, cnt, mine, sp = 0u;
    for (;;) {
        sum = 0u; cnt = 0u; mine = 0u;
#pragma unroll
        for (unsigned j = 0; j < 16; ++j) { const unsigned c = xb_ld(&bar[XB_XCNT(j)]); sum += c; cnt += (c > 0u) ? 1u : 0u; mine = (j == x) ? c : mine; }
        if (sum == G) break;
        __builtin_amdgcn_s_sleep(1);
        if ((++sp & 255u) == 0u) { if (xb_ld(&bar[XB_TMO])) break; if (sp > XB_SPIN_CAP) { atomicAdd(&bar[XB_TMO], 1u); break; } }
    }
    nloc = mine > 0u ? mine : 1u; nx = cnt > 0u ? cnt : 1u;
}

__device__ __forceinline__ void xcd_barrier(const XcdBarrier& b) {
    asm volatile("s_waitcnt vmcnt(0)" ::: "memory");
    __syncthreads();
    if (threadIdx.x == 0) {
        unsigned* bar = b.bar;
        __builtin_amdgcn_s_waitcnt(0);
        unsigned nloc = b.st[0], nx = b.st[1];
        if (nloc == 0u) { xcd_barrier_complete(bar, b.x, nloc, nx); b.st[0] = nloc; b.st[1] = nx; }
        const unsigned old = xb_add(&bar[XB_XSUB(b.x)], 1u);
        const unsigned gen = old / nloc;
        if (old + 1u == (gen + 1u) * nloc) {
            __builtin_amdgcn_fence(__ATOMIC_RELEASE, "agent");
            asm volatile("s_waitcnt vmcnt(0)" ::: "memory");
            const unsigned og = xb_add(&bar[XB_TOP], 1u);
            const unsigned tg = og / nx;
            if (og + 1u == (tg + 1u) * nx) xb_add(&bar[XB_TOPGEN], 1u);
            else XB_SPIN(xb_ld(&bar[XB_TOPGEN]) == tg, bar);
            __builtin_amdgcn_fence(__ATOMIC_ACQUIRE, "agent");
            xb_add(&bar[XB_XGEN(b.x)], 1u);
            asm volatile("s_waitcnt vmcnt(0)" ::: "memory");
        } else {
            XB_SPIN(xb_ld(&bar[XB_XGEN(b.x)]) == gen, bar);
            __builtin_amdgcn_fence(__ATOMIC_ACQUIRE, "agent");
            asm volatile("s_waitcnt vmcnt(0)" ::: "memory");
        }
    }
    __syncthreads();
}

constexpr int NWAVES = 8;
constexpr int RING_BYTES = 157696;
constexpr int LDSCTL_OFF = RING_BYTES, MISC_OFF = LDSCTL_OFF + 320;
constexpr int LDS_BYTES = 158720;
static_assert(IDX_END <= RING_BYTES && fa::ATTN_LDS_BYTES <= RING_BYTES && pg8::STAGE_BYTES <= RING_BYTES, "phase scratch fits");
constexpr int CW_BAR = 4096;
constexpr size_t CTL_ZERO_BYTES = 64 * 1024;
static_assert((CW_BAR + XCD_BAR_WORDS) * 4 <= (int)CTL_ZERO_BYTES, "barrier words inside the memset region");

struct MegaArgs { const float* in[12]; float* out; unsigned char* ws; };

__global__ void __launch_bounds__(NWAVES * 64, 2) mega_fwd(MegaArgs args) {
    extern __shared__ __attribute__((aligned(16))) unsigned char lds_raw[];
    LAS unsigned char* lds = (LAS unsigned char*)lds_raw;
    const int tid = opaque_tid(), lane = tid & 63; const int wave = __builtin_amdgcn_readfirstlane(tid >> 6);
    const int G = gridDim.x, bx = blockIdx.x, vcu = (G % 8 == 0) ? (bx % 8) * (G / 8) + bx / 8 : bx;
    unsigned char* const ws = args.ws;
#define WSP(T, off) ((T*)(ws + (off)))
    float* const GAINS = WSP(float, WS_GAINS);

    for (int u = tid; u < (LDS_BYTES - LDSCTL_OFF) / 4; u += NWAVES * 64) ((LAS unsigned*)(lds + LDSCTL_OFF))[u] = 0u;
    __syncthreads();
    XcdBarrier bar = xcd_barrier_post((unsigned*)(ws + WS_CTL) + CW_BAR, (volatile LAS unsigned*)(lds + MISC_OFF) + 8);

    const int gw = vcu * NWAVES + wave, NGW = G * NWAVES;

    {
        float* RC = WSP(float, WS_ROPE); float* RS = RC + SEQ * 32;
        for (int i = vcu * 512 + tid; i < SEQ * 32; i += G * 512) rope_table_elem(RC, RS, i);
        if (vcu == 0 && tid < 320) { const int i = tid; GAINS[i] = (i < 64) ? args.in[3][i] : (i < 128) ? args.in[4][i - 64] : (i < 224) ? args.in[9][i - 128] : args.in[10][i - 224]; }
        constexpr int T_IN = (NP / 64) * 16, T_UQ = 12 * 6, T_UKV = 16 * 4, T_OUT = 16 * 16;
        LAS float* tile = (LAS float*)lds;
        for (int it = vcu; it < T_IN + T_UQ + T_UKV + T_OUT; it += G) {
            int r = it;
            if (r < T_IN) { wtrans_tile(tile, args.in[2], 1024, D_IN_OLD, WSP(bf16, WS_WIN), (r % (NP / 64)) * 64, (r / (NP / 64)) * 64, 1, nullptr, tid); continue; } r -= T_IN;
            if (r < T_UQ) { wtrans_tile(tile, args.in[7], 384, 768, WSP(bf16, WS_WUQ), (r % 12) * 64, (r / 12) * 64, 0, args.in[5], tid); continue; } r -= T_UQ;
            if (r < T_UKV) { wtrans_tile(tile, args.in[8], 256, 1024, WSP(bf16, WS_WUKV), (r % 16) * 64, (r / 16) * 64, 2, args.in[6], tid); continue; } r -= T_UKV;
            wtrans_tile(tile, args.in[11], 1024, 1024, WSP(bf16, WS_WOUT), (r % 16) * 64, (r / 16) * 64, 0, nullptr, tid);
        }
        for (int m = gw; m < MTOK; m += NGW) rmsnorm_x_row(args.in[0], args.in[1], WSP(bf16, WS_XN), m, lane);
    }
    xcd_barrier(bar);

    {
        pg8::Gemm g{WSP(bf16, WS_XN), WSP(bf16, WS_WIN), MTOK, NP, 1024, 1024}; pg8::StaticOrder S; S.init(MTOK, NP, G, bx);
        pg8::EpiProj E{WSP(bf16, WS_PROJ), WSP(float, WS_SSQ), GAINS, GAINS + 64, WSP(float, WS_ROPE), WSP(float, WS_ROPE) + SEQ * 32};
        pg8::gemm_phase<pg8::EpiProj, pg8::StaticOrder, true, true>(lds, g, S, E);
    }
    xcd_barrier(bar);

    {
        pg8::Gemm g{WSP(bf16, WS_PROJ) + C_CQ, WSP(bf16, WS_WUQ), MTOK, 768, 384, NP}; pg8::StaticOrder S; S.init(MTOK, 768, G, bx);
        pg8::EpiBf16<0> E{WSP(bf16, WS_QB), 768, nullptr, 0, 0, 1.f};
        pg8::gemm_phase<pg8::EpiBf16<0>, pg8::StaticOrder, true, true>(lds, g, S, E);
    }
    {
        pg8::Gemm g{WSP(bf16, WS_PROJ) + C_CKV, WSP(bf16, WS_WUKV), MTOK, 1024, 256, NP}; pg8::StaticOrder S; S.init(MTOK, 1024, G, bx);
        pg8::EpiKV E{WSP(bf16, WS_KB), WSP(bf16, WS_VB), WSP(bf16, WS_PROJ), WSP(float, WS_SSQ), GAINS + 224, WSP(float, WS_ROPE), WSP(float, WS_ROPE) + SEQ * 32};
        pg8::gemm_phase<pg8::EpiKV, pg8::StaticOrder, true, true>(lds, g, S, E);
    }
    for (int p = vcu; p < 512; p += G) {
        const int b = p & 15, qq = p >> 4;
        indexer_unit(lds, WSP(bf16, WS_PROJ), WSP(unsigned long long, WS_MASK), b, 63 - qq);
        indexer_unit(lds, WSP(bf16, WS_PROJ), WSP(unsigned long long, WS_MASK), b, qq);
    }
    xcd_barrier(bar);

    {
        bf16* PROJ = WSP(bf16, WS_PROJ); bf16* MIXED = WSP(bf16, WS_MIXED);
        const AttnArgs aA{PROJ + C_QA, PROJ + C_KA, PROJ + C_VA, PROJ + C_GA, MIXED, WSP(unsigned long long, WS_MASK), nullptr, nullptr, nullptr, nullptr, NP, 64, NP, 64, NP, 64, NP, 0};
        const AttnArgs aB{WSP(bf16, WS_QB), WSP(bf16, WS_KB), WSP(bf16, WS_VB), PROJ + C_GB, MIXED, nullptr, WSP(float, WS_SSQ), GAINS + 128, WSP(float, WS_ROPE), WSP(float, WS_ROPE) + SEQ * 32, 768, 96, 768, 96, 512, 64, NP, 512};
        for (int p = vcu; p < 512; p += G) {
            const int s = p & 3, h = (p >> 2) & 7, b = p >> 5;
            fa::attn_unit<8, true, 4, false>(b, h, 7 - s, aA, (char*)lds_raw);
            fa::attn_unit<8, true, 4, false>(b, h, s, aA, (char*)lds_raw);
            fa::attn_unit<8, false, 6, true>(b, h, 7 - s, aB, (char*)lds_raw);
            fa::attn_unit<8, false, 6, true>(b, h, s, aB, (char*)lds_raw);
        }
    }
    xcd_barrier(bar);

    {
        pg8::Gemm g{WSP(bf16, WS_MIXED), WSP(bf16, WS_WOUT), MTOK, 1024, 1024, 1024}; pg8::StaticOrder S; S.init(MTOK, 1024, G, bx);
        pg8::EpiResF32 E{args.in[0], args.out, 1024};
        pg8::gemm_phase<pg8::EpiResF32, pg8::StaticOrder, true, true>(lds, g, S, E);
    }
}

extern "C" void kernel_launch(void* const* d_in, const int* in_sizes, int n_in, void* d_out, int out_size, void* d_ws, size_t ws_size, hipStream_t stream) {
    static int grid = 0;
    if (grid == 0) {
        if (n_in != 12 || in_sizes[0] != MTOK * DMODEL || out_size != MTOK * DMODEL || ws_size < WS_END) {
            fprintf(stderr, "kernel_launch: unexpected shapes / workspace (n_in %d, in0 %d, out %d, ws %zu)\n", n_in, n_in > 0 ? in_sizes[0] : -1, out_size, ws_size); grid = -1; return; }
        int dev = 0, cus = 0, per_cu = 0;
        if (hipGetDevice(&dev) != hipSuccess || hipDeviceGetAttribute(&cus, hipDeviceAttributeMultiprocessorCount, dev) != hipSuccess) { grid = -1; return; }
        if (hipFuncSetAttribute((const void*)mega_fwd, hipFuncAttributeMaxDynamicSharedMemorySize, LDS_BYTES) != hipSuccess) { fprintf(stderr, "kernel_launch: hipFuncSetAttribute failed\n"); grid = -1; return; }
        if (hipOccupancyMaxActiveBlocksPerMultiprocessor(&per_cu, (const void*)mega_fwd, NWAVES * 64, LDS_BYTES) != hipSuccess || per_cu < 1) {
            fprintf(stderr, "kernel_launch: occupancy query says %d workgroups per CU\n", per_cu); (void)hipGetLastError(); grid = -1; return; }
        grid = cus;
    }
    if (grid < 0) return;
    (void)hipMemsetAsync((char*)d_ws + WS_CTL, 0, CTL_ZERO_BYTES, stream);
    MegaArgs a{};
    for (int i = 0; i < 12; ++i) a.in[i] = (const float*)d_in[i];
    a.out = (float*)d_out; a.ws = (unsigned char*)d_ws;
    hipLaunchKernelGGL(mega_fwd, dim3(grid), dim3(NWAVES * 64), LDS_BYTES, stream, a);
}
```

```cpp
#include <hip/hip_runtime.h>
#include <cstdint>
#include <cstdio>

constexpr int BATCH = 16, SEQ = 2048, DMODEL = 1024, MTOK = BATCH * SEQ;
constexpr int NP = 3840;
constexpr int C_QA = 0, C_KA = 512, C_VA = 1024, C_GA = 1536, C_QI = 2048, C_GB = 2560, C_CQ = 3072, C_CKV = 3456, C_KI = 3712, C_KR = 3776, C_WI = 3808;
constexpr int D_IN_OLD = 3816;
constexpr float RMS_EPS = 1e-6f;
constexpr float LOG2E = 1.4426950408889634f;
constexpr float C2A = 0.125f * LOG2E;
constexpr float C2B = 0.10206207261596575f * LOG2E;

constexpr size_t MiB = 1u << 20;
constexpr size_t WS_CTL = 0;
constexpr size_t WS_WIN = 2 * MiB;
constexpr size_t WS_WUQ = 10 * MiB;
constexpr size_t WS_WUKV = 11 * MiB;
constexpr size_t WS_WOUT = 12 * MiB;
constexpr size_t WS_ROPE = 14 * MiB;
constexpr size_t WS_GAINS = 15 * MiB;
constexpr size_t WS_XN = 16 * MiB;
constexpr size_t WS_MIXED = WS_XN;
constexpr size_t WS_PROJ = 80 * MiB;
constexpr size_t WS_QB = 320 * MiB;
constexpr size_t WS_VB = 368 * MiB;
constexpr size_t WS_SSQ = 400 * MiB;
constexpr size_t WS_KB = 432 * MiB;
constexpr size_t WS_MASK = 480 * MiB;
constexpr size_t WS_END = 488 * MiB;

typedef unsigned short bf16;
typedef short bf16x8_t __attribute__((ext_vector_type(8)));
typedef short s16x4_t __attribute__((ext_vector_type(4)));
typedef float f32x16_t __attribute__((ext_vector_type(16)));
typedef float f32x4_t __attribute__((ext_vector_type(4)));
typedef unsigned u32x4_t __attribute__((ext_vector_type(4)));
typedef unsigned u32x2_t __attribute__((ext_vector_type(2)));
#define LAS __attribute__((address_space(3)))

__device__ __forceinline__ unsigned f2bf(float f) { unsigned u = __builtin_bit_cast(unsigned, f); return (u + 0x7fffu + ((u >> 16) & 1u)) >> 16; }
__device__ __forceinline__ unsigned pk2(float lo, float hi) { return f2bf(lo) | (f2bf(hi) << 16); }
__device__ __forceinline__ float bflo(unsigned u) { return __builtin_bit_cast(float, u << 16); }
__device__ __forceinline__ float bfhi(unsigned u) { return __builtin_bit_cast(float, u & 0xffff0000u); }
__device__ __forceinline__ float bf2f(bf16 b) { return __builtin_bit_cast(float, (unsigned)b << 16); }
__device__ __forceinline__ int crow(int r, int hi) { return (r & 3) + 8 * (r >> 2) + 4 * hi; }

__device__ __forceinline__ int opaque_tid() { int t = (int)threadIdx.x; asm volatile("" : "+v"(t)); return t; }

#define SPIN_DUP_BEGIN(t) const unsigned long long t = __builtin_amdgcn_s_memrealtime()
#define SPIN_DUP_END(t) do { const unsigned long long e_ = __builtin_amdgcn_s_memrealtime(); const unsigned long long d_ = e_ - t; while (__builtin_amdgcn_s_memrealtime() - e_ < d_) __builtin_amdgcn_s_sleep(1); } while (0)

namespace pg8 {
#define PG8_LAS __attribute__((address_space(3)))
typedef unsigned short bf16_t;
typedef short bf16x8 __attribute__((ext_vector_type(8)));
typedef float f32x4 __attribute__((ext_vector_type(4)));
typedef unsigned u32x4 __attribute__((ext_vector_type(4)));
constexpr int BM = 256, BK = 64, HALF = 128, HTB = HALF * BK * 2  , STAGE_BYTES = 8 * HTB, NXCD = 8, WGM = 8;

__host__ __device__ __forceinline__ int lds_byte(int r, int c) { const int st = (r >> 4) * 2 + (c >> 5), rr = r & 15, cc = c & 31, ob = rr * 64 + cc * 2; return st * 1024 + (ob ^ (((ob >> 9) & 1) << 5)); }
__host__ __device__ __forceinline__ void stage_rc(int b, int& R, int& C) { const int st = b / 1024, sb = b % 1024, swz = sb ^ (((sb >> 9) & 1) << 5); R = (st >> 1) * 16 + swz / 64; C = (st & 1) * 32 + (swz % 64) / 2; }
__host__ __device__ __forceinline__ int perm32(int rho) { const int n = rho >> 4, i = rho & 15; return 8 * (i >> 2) + 4 * n + (i & 3); }

struct Unit { int pm, pn; };
struct Gemm { const bf16_t* A; const bf16_t* Bt; int M, N, K, lda; };

struct StaticOrder {
    int nM, nN, nwg, G, c;
    __host__ __device__ void init(int M, int N, int G_, int c_) { nM = M / BM; nN = N / BM; nwg = nM * nN; G = G_; c = c_; }
    __host__ __device__ bool next(int i, Unit& u) const {
        const long L = (long)i * G + c; if (L >= nwg) return false;
        int wgid = (int)L; { const int q = nwg / NXCD, r = nwg % NXCD, xcd = wgid % NXCD, off = wgid / NXCD; wgid = (xcd < r ? xcd * (q + 1) : r * (q + 1) + (xcd - r) * q) + off; }
        const int nig = WGM * nN, gid = wgid / nig, fm = gid * WGM, gsz = (nM - fm) < WGM ? (nM - fm) : WGM;
        u.pm = fm + ((wgid % nig) % gsz); u.pn = (wgid % nig) / gsz; return true;
    }
    __device__ __forceinline__ void a_ready(const Unit&) const {}
    __device__ __forceinline__ void done(const Unit&) const {}
};

__device__ __forceinline__ unsigned cvt_pk_bf16(float lo, float hi) { unsigned r; asm volatile("v_cvt_pk_bf16_f32 %0, %1, %2" : "=v"(r) : "v"(lo), "v"(hi)); return r; }
typedef float f32x2 __attribute__((ext_vector_type(2)));
__device__ __forceinline__ f32x2 gelu_pk(f32x2 v) {
    const f32x2 av = __builtin_elementwise_abs(v), d = av * 0.2316418882f + 1.0f;
    f32x2 t; t.x = __builtin_amdgcn_rcpf(d.x); t.y = __builtin_amdgcn_rcpf(d.y);
    f32x2 q = t * 0.5307027145f + (-0.7265760135f); q = q * t + 0.7107068705f; q = q * t + (-0.142248368f); q = q * t + 0.127414796f; q = q * t;
    const f32x2 s = (v * v) * (-0.72134752044f);
    f32x2 e; e.x = __builtin_amdgcn_exp2f(s.x); e.y = __builtin_amdgcn_exp2f(s.y);
    const f32x2 m = v * (q * e), r = v - m;
    f32x2 o; o.x = v.x < 0.f ? m.x : r.x; o.y = v.y < 0.f ? m.y : r.y; return o;
}

template <int ACT  > struct EpiBf16 {
    static constexpr bool PERM = true, AFTER_DRAIN = false; static_assert(ACT == 0 || ACT == 1, "EpiBf16: ACT is 0 (none) or 1 (gelu_pk)");
    bf16_t* O; int ldc; const float* bias; int split_cols; size_t split_stride; float scale0;
    __device__ __forceinline__ void operator()(const f32x4 (&acc)[2][2][4][2], const Unit& u, int wr, int wc, int fr, int fq) const {
        const int row0 = u.pm * BM + wr * 64 + fr; int colt = u.pn * BM; bf16_t* base = O;
        float sc = 1.f; if (split_cols) { const int t = colt / split_cols; base += (size_t)t * split_stride; colt -= t * split_cols; if (t == 0) sc = scale0; }
        const int col0 = colt + wc * 32 + 8 * fq, bcol0 = u.pn * BM + wc * 32 + 8 * fq;
        f32x4 bv[2][2];
#pragma unroll
        for (int bj = 0; bj < 2; ++bj)
#pragma unroll
            for (int n = 0; n < 2; ++n) bv[bj][n] = bias ? *(const f32x4*)(bias + bcol0 + bj * HALF + 4 * n) : (f32x4){0.f, 0.f, 0.f, 0.f};
#pragma unroll
        for (int ai = 0; ai < 2; ++ai)
#pragma unroll
            for (int m = 0; m < 4; ++m) { bf16_t* rowp = base + (size_t)(row0 + ai * HALF + m * 16) * ldc + col0;
#pragma unroll
                for (int bj = 0; bj < 2; ++bj) { f32x4 v0 = acc[ai][bj][m][0] + bv[bj][0], v1 = acc[ai][bj][m][1] + bv[bj][1];
                    if (ACT == 1) { f32x2 a = gelu_pk((f32x2){v0[0], v0[1]}), b = gelu_pk((f32x2){v0[2], v0[3]}), c = gelu_pk((f32x2){v1[0], v1[1]}), d = gelu_pk((f32x2){v1[2], v1[3]});
                        v0 = (f32x4){a.x, a.y, b.x, b.y}; v1 = (f32x4){c.x, c.y, d.x, d.y}; }
                    v0 = v0 * sc; v1 = v1 * sc; u32x4 w; w.x = cvt_pk_bf16(v0[0], v0[1]); w.y = cvt_pk_bf16(v0[2], v0[3]); w.z = cvt_pk_bf16(v1[0], v1[1]); w.w = cvt_pk_bf16(v1[2], v1[3]);
                    *(u32x4*)(rowp + bj * HALF) = w; } }
    }
};
template <class Epi, class Sched, bool ALIGN_EPI = false, bool SP2 = false>
__device__ __forceinline__ void gemm_phase(PG8_LAS unsigned char* lds, const Gemm g, const Sched& S, const Epi& E) {
    const int tid = opaque_tid(), wid = __builtin_amdgcn_readfirstlane(tid >> 6), lane = tid & 63, wr = wid >> 2, wc = wid & 3, fr = lane & 15, fq = lane >> 4;
    int Kq = g.K, ldq = g.lda; asm volatile("" : "+s"(Kq), "+s"(ldq));
    const int K = Kq, nt = K / BK, lda = ldq;
    unsigned voffA[2], voffB[2];
#pragma unroll
    for (int i = 0; i < 2; ++i) { int R, C; stage_rc(tid * 16 + i * 8192, R, C); const int Rb = Epi::PERM ? ((R & ~31) + perm32(R & 31)) : R;
        voffA[i] = (unsigned)(R * lda + C) * 2u; voffB[i] = (unsigned)(Rb * K + C) * 2u; }
    const size_t kstep = (size_t)(BK * 2);
    const size_t hstepA = (size_t)HALF * lda * 2, hstepB = (size_t)HALF * K * 2;
    const size_t tstepA = 2 * hstepA, tstepB = 2 * hstepB;
    const unsigned ldsw = (unsigned)wid * 1024u;
    const int aoff = lds_byte(wr * 64 + fr, fq * 8), boff = lds_byte(wc * 32 + fr, fq * 8);
#define PG8_SA(b, h) (((b) * 2 + (h)) * HTB)
#define PG8_SB(b, h) ((4 + (b) * 2 + (h)) * HTB)
#define PG8_STAGE(bufoff, gbase, voff) do { _Pragma("unroll") for (int _i = 0; _i < 2; ++_i) \
        __builtin_amdgcn_global_load_lds((const unsigned*)((const char*)(gbase) + (voff)[_i]), (PG8_LAS unsigned*)(lds + (bufoff) + ldsw + _i * 8192), 16, 0, 0); } while (0)
#define PG8_LDA(dst, b, h) do { _Pragma("unroll") for (int m = 0; m < 4; ++m) _Pragma("unroll") for (int k = 0; k < 2; ++k) dst[m][k] = *(const PG8_LAS bf16x8*)(lds + PG8_SA(b, h) + aoff + m * 2048 + k * 1024); } while (0)
#define PG8_LDB(dst, b, h) do { _Pragma("unroll") for (int n = 0; n < 2; ++n) _Pragma("unroll") for (int k = 0; k < 2; ++k) dst[n][k] = *(const PG8_LAS bf16x8*)(lds + PG8_SB(b, h) + boff + n * 2048 + k * 1024); } while (0)
#define PG8_MMA(ai, bj, At, Bt) do { __builtin_amdgcn_s_setprio(1); _Pragma("unroll") for (int m = 0; m < 4; ++m) _Pragma("unroll") for (int n = 0; n < 2; ++n) _Pragma("unroll") for (int k = 0; k < 2; ++k) \
        acc[ai][bj][m][n] = __builtin_amdgcn_mfma_f32_16x16x32_bf16(Bt[n][k], At[m][k], acc[ai][bj][m][n], 0, 0, 0); __builtin_amdgcn_s_setprio(0); } while (0)
#define PG8_WAIT_V(n) asm volatile("s_waitcnt vmcnt(" #n ")" ::: "memory")
#define PG8_WAIT_L(n) asm volatile("s_waitcnt lgkmcnt(" #n ")" ::: "memory")
#define PG8_BAR __builtin_amdgcn_s_barrier()
#define PG8_SCHED __builtin_amdgcn_sched_barrier(0)
    Unit cur, nxt; int ui = 0;
    if (!S.next(0, cur)) return;
    f32x4 acc[2][2][4][2];
#pragma unroll
    for (int a = 0; a < 2; ++a)
#pragma unroll
        for (int b = 0; b < 2; ++b)
#pragma unroll
            for (int m = 0; m < 4; ++m)
#pragma unroll
                for (int n = 0; n < 2; ++n) acc[a][b][m][n] = (f32x4){0.f, 0.f, 0.f, 0.f};
    bf16x8 At[4][2], B0[2][2], B1[2][2];
    const char* cA = (const char*)g.A + (size_t)cur.pm * tstepA; const char* cB = (const char*)g.Bt + (size_t)cur.pn * tstepB;
    S.a_ready(cur);
    if constexpr (SP2) {
        PG8_STAGE(PG8_SB(0, 0), cB, voffB); PG8_STAGE(PG8_SB(0, 1), cB + hstepB, voffB); PG8_STAGE(PG8_SA(0, 0), cA, voffA); PG8_STAGE(PG8_SA(0, 1), cA + hstepA, voffA);
        if (wr == 1) PG8_BAR;
        PG8_WAIT_V(2); PG8_BAR;
        PG8_STAGE(PG8_SB(1, 0), cB + kstep, voffB); PG8_STAGE(PG8_SA(1, 0), cA + kstep, voffA); PG8_STAGE(PG8_SB(1, 1), cB + hstepB + kstep, voffB);
        PG8_WAIT_V(6); PG8_BAR;
    } else {
        PG8_STAGE(PG8_SB(0, 0), cB, voffB); PG8_STAGE(PG8_SA(0, 0), cA, voffA); PG8_STAGE(PG8_SB(0, 1), cB + hstepB, voffB); PG8_STAGE(PG8_SA(0, 1), cA + hstepA, voffA);
        if (wr == 1) PG8_BAR;
        PG8_WAIT_V(4); PG8_BAR;
        PG8_STAGE(PG8_SB(1, 0), cB + kstep, voffB); PG8_STAGE(PG8_SA(1, 0), cA + kstep, voffA); PG8_STAGE(PG8_SB(1, 1), cB + hstepB + kstep, voffB);
        PG8_WAIT_V(6); PG8_BAR;
    }
    for (;;) {
        const bool has_next = S.next(ui + 1, nxt);
        const char* nA = has_next ? (const char*)g.A + (size_t)nxt.pm * tstepA : cA; const char* nB = has_next ? (const char*)g.Bt + (size_t)nxt.pn * tstepB : cB;
        for (int t = 0; t < nt; t += 2) {
            const bool last = (t == nt - 2);
            const char* a1 = cA + (size_t)(t + 1) * kstep;
            const char* a2 = last ? nA : cA + (size_t)(t + 2) * kstep; const char* b2 = last ? nB : cB + (size_t)(t + 2) * kstep;
            const char* a3 = a2 + kstep; const char* b3 = b2 + kstep;
            if (last && has_next) S.a_ready(nxt);
            if constexpr (SP2) {
            PG8_LDB(B0, 0, 0); PG8_LDB(B1, 0, 1); PG8_SCHED; PG8_LDA(At, 0, 0); PG8_STAGE(PG8_SA(1, 1), a1 + hstepA, voffA);
            PG8_WAIT_V(8); PG8_WAIT_L(0); PG8_BAR; PG8_MMA(0, 0, At, B0); PG8_MMA(0, 1, At, B1); PG8_BAR; PG8_SCHED;
            PG8_LDA(At, 0, 1); PG8_STAGE(PG8_SB(0, 0), b2, voffB); PG8_STAGE(PG8_SB(0, 1), b2 + hstepB, voffB); PG8_STAGE(PG8_SA(0, 0), a2, voffA);
            PG8_WAIT_V(8); PG8_WAIT_L(0); PG8_BAR; PG8_MMA(1, 0, At, B0); PG8_MMA(1, 1, At, B1); PG8_BAR; PG8_SCHED;
            PG8_LDB(B0, 1, 0); PG8_LDB(B1, 1, 1); PG8_SCHED; PG8_LDA(At, 1, 0); PG8_STAGE(PG8_SA(0, 1), a2 + hstepA, voffA);
            PG8_WAIT_V(8); PG8_WAIT_L(0); PG8_BAR; PG8_MMA(0, 0, At, B0); PG8_MMA(0, 1, At, B1); PG8_BAR; PG8_SCHED;
            PG8_LDA(At, 1, 1); PG8_STAGE(PG8_SB(1, 0), b3, voffB); PG8_STAGE(PG8_SB(1, 1), b3 + hstepB, voffB); PG8_STAGE(PG8_SA(1, 0), a3, voffA);
            PG8_WAIT_V(8); PG8_WAIT_L(0); PG8_BAR; PG8_MMA(1, 0, At, B0); PG8_MMA(1, 1, At, B1); PG8_BAR; PG8_SCHED;
            } else {
            PG8_LDB(B0, 0, 0); PG8_SCHED; PG8_LDA(At, 0, 0); PG8_STAGE(PG8_SA(1, 1), a1 + hstepA, voffA);
            PG8_WAIT_L(8); PG8_BAR; PG8_WAIT_L(0); PG8_MMA(0, 0, At, B0); PG8_BAR; PG8_SCHED;
            PG8_LDB(B1, 0, 1); PG8_STAGE(PG8_SB(0, 0), b2, voffB);
            PG8_BAR; PG8_WAIT_L(0); PG8_MMA(0, 1, At, B1); PG8_BAR;
            PG8_LDA(At, 0, 1); PG8_STAGE(PG8_SA(0, 0), a2, voffA);
            PG8_BAR; PG8_WAIT_L(0); PG8_MMA(1, 0, At, B0); PG8_BAR; PG8_SCHED;
            PG8_STAGE(PG8_SB(0, 1), b2 + hstepB, voffB);
            PG8_WAIT_V(6); PG8_BAR; PG8_MMA(1, 1, At, B1); PG8_BAR;
            PG8_LDB(B0, 1, 0); PG8_SCHED; PG8_LDA(At, 1, 0); PG8_STAGE(PG8_SA(0, 1), a2 + hstepA, voffA);
            PG8_WAIT_L(8); PG8_BAR; PG8_WAIT_L(0); PG8_MMA(0, 0, At, B0); PG8_BAR; PG8_SCHED;
            PG8_LDB(B1, 1, 1); PG8_STAGE(PG8_SB(1, 0), b3, voffB);
            PG8_BAR; PG8_WAIT_L(0); PG8_MMA(0, 1, At, B1); PG8_BAR;
            PG8_LDA(At, 1, 1); PG8_STAGE(PG8_SA(1, 0), a3, voffA);
            PG8_BAR; PG8_WAIT_L(0); PG8_MMA(1, 0, At, B0); PG8_BAR; PG8_SCHED;
            PG8_STAGE(PG8_SB(1, 1), b3 + hstepB, voffB);
            PG8_WAIT_V(6); PG8_BAR; PG8_MMA(1, 1, At, B1); PG8_BAR;
            }
        }
        if constexpr (ALIGN_EPI) { if (wr == 0) PG8_BAR; }
        if constexpr (!Epi::AFTER_DRAIN) { E(acc, cur, wr, wc, fr, fq); S.done(cur); }
        if (!has_next) break;
#pragma unroll
        for (int a = 0; a < 2; ++a)
#pragma unroll
            for (int b = 0; b < 2; ++b)
#pragma unroll
                for (int m = 0; m < 4; ++m)
#pragma unroll
                    for (int n = 0; n < 2; ++n) acc[a][b][m][n] = (f32x4){0.f, 0.f, 0.f, 0.f};
        cur = nxt; cA = nA; cB = nB; ++ui;
        if constexpr (ALIGN_EPI) { if (wr == 1) PG8_BAR; }
    }
    PG8_WAIT_V(0);
    if constexpr (!ALIGN_EPI) { if (wr == 0) PG8_BAR; }
    PG8_BAR;
    if constexpr (Epi::AFTER_DRAIN) { E.fused(acc, cur, wr, wc, fr, fq, lds, wid, lane); S.done(cur); }
#undef PG8_SA
#undef PG8_SB
#undef PG8_STAGE
#undef PG8_LDA
#undef PG8_LDB
#undef PG8_MMA
#undef PG8_WAIT_V
#undef PG8_WAIT_L
#undef PG8_BAR
#undef PG8_SCHED
}
}

#ifndef PG8_SP2
#define PG8_SP2 true
#endif
#ifndef PG8_ALIGN
#define PG8_ALIGN true
#endif

namespace pg8 {
struct EpiResF32 {
    static constexpr bool PERM = false, AFTER_DRAIN = false;
    const float* base; float* out; int ldc;
    __device__ __forceinline__ void operator()(const f32x4 (&acc)[2][2][4][2], const Unit& u, int wr, int wc, int fr, int fq) const {
        const int col0 = u.pn * BM + wc * 32 + 4 * fq;
#pragma unroll
        for (int ai = 0; ai < 2; ++ai)
#pragma unroll
            for (int m = 0; m < 4; ++m) { const size_t off = (size_t)(u.pm * BM + ai * HALF + wr * 64 + m * 16 + fr) * ldc + col0;
#pragma unroll
                for (int bj = 0; bj < 2; ++bj)
#pragma unroll
                    for (int n = 0; n < 2; ++n) { const f32x4 b = *(const f32x4*)(base + off + bj * HALF + n * 16); *(f32x4*)(out + off + bj * HALF + n * 16) = b + acc[ai][bj][m][n]; } }
    }
};
}

constexpr int GEMM_LDS = pg8::STAGE_BYTES;

__device__ __forceinline__ void rope_table_elem(float* ct, float* st, int idx) {
    const int pos = idx >> 5, j = idx & 31;
    const float freq = exp2f(-(float)j * (13.287712379549449f / 32.0f));
    const float ang = (float)pos * freq;
    double rev = (double)ang * 0.15915494309189535;
    rev -= floor(rev);
    const float fr = (float)rev;
    ct[idx] = __builtin_amdgcn_cosf(fr);
    st[idx] = __builtin_amdgcn_sinf(fr);
}

__device__ __forceinline__ int win_src_col(int n) {
    if (n < 2560) return n;
    if (n < 3072) return n - 2560 + 3304;
    if (n < 3456) return n - 3072 + 2632;
    if (n < 3712) return n - 3456 + 3016;
    if (n < 3776) return n - 3712 + 2560;
    if (n < 3808) return n - 3776 + 3272;
    if (n < 3816) return n - 3808 + 2624;
    return -1;
}
__device__ __forceinline__ int win_phys2src(int n) {
    const int tile = n >> 8, p = n & 255, bj = p >> 7, wcc = (p >> 5) & 3, i = p & 31;
    const int pairdim = 16 * ((i >> 2) & 1) + 4 * (i >> 3) + (i & 3);
    int logical = n;
    if (tile < 4) logical = ((tile < 2) ? C_QA : C_KA) + 64 * (4 * (tile & 1) + wcc) + 32 * bj + i;
    else if (tile == 8 || tile == 9) logical = C_QI + 64 * (4 * (tile - 8) + wcc) + (bj ? 32 + i : pairdim);
    else if (tile == 14 && bj == 1 && wcc == 0) logical = C_KI + pairdim;
    return win_src_col(logical);
}
__device__ __forceinline__ int wukv_phys2src(int n) {
    const int t = n >> 8, p = n & 255, bj = p >> 7, wcc = (p >> 5) & 3, i = p & 31;
    return 128 * (2 * t + (wcc >> 1)) + 64 * (wcc & 1) + 32 * bj + i;
}
__device__ __forceinline__ void wtrans_tile(LAS float* t, const float* __restrict__ W, int K, int Nold, bf16* __restrict__ WT, int n0, int k0, int mode, const float* __restrict__ gain, int tid) {
    __syncthreads();
    for (int i = tid; i < 4096; i += 512) { const int kk = i >> 6, nn = i & 63; const int n = n0 + nn; const int src = (mode == 1) ? win_phys2src(n) : (mode == 2) ? wukv_phys2src(n) : n;
        float v = (src >= 0) ? W[(size_t)(k0 + kk) * Nold + src] : 0.f; if (gain) v *= gain[k0 + kk];
        t[kk * 65 + nn] = v; }
    __syncthreads();
    for (int i = tid; i < 4096; i += 512) { const int nn = i >> 6, kk = i & 63; WT[(size_t)(n0 + nn) * K + k0 + kk] = (bf16)f2bf(t[kk * 65 + nn]); }
}

__device__ __forceinline__ float wave_sum(float v) {
#pragma unroll
    for (int o = 1; o < 64; o <<= 1) v += __shfl_xor(v, o);
    return v;
}
__device__ __forceinline__ float wave_sum_f32(float v) {
    v += __builtin_bit_cast(float, __builtin_amdgcn_update_dpp(0, __builtin_bit_cast(int, v), 0xB1, 0xF, 0xF, false));
    v += __builtin_bit_cast(float, __builtin_amdgcn_update_dpp(0, __builtin_bit_cast(int, v), 0x4E, 0xF, 0xF, false));
    v += __builtin_bit_cast(float, __builtin_amdgcn_update_dpp(0, __builtin_bit_cast(int, v), 0x141, 0xF, 0xF, false));
    v += __builtin_bit_cast(float, __builtin_amdgcn_update_dpp(0, __builtin_bit_cast(int, v), 0x140, 0xF, 0xF, false));
    { const auto a = __builtin_amdgcn_permlane16_swap(__float_as_uint(v), __float_as_uint(v), false, false); v = __uint_as_float(a[0]) + __uint_as_float(a[1]); }
    { const auto b = __builtin_amdgcn_permlane32_swap(__float_as_uint(v), __float_as_uint(v), false, false); v = __uint_as_float(b[0]) + __uint_as_float(b[1]); }
    return v;
}
__device__ __forceinline__ void rmsnorm_x_rows4(const float* __restrict__ x, const float* __restrict__ g, bf16* __restrict__ xn, int row0, int stride, int lane) {
    const f32x4_t* gr = (const f32x4_t*)g + lane;
    f32x4_t v[4][4]; float s[4];
#pragma unroll
    for (int r = 0; r < 4; ++r) { const f32x4_t* xr = (const f32x4_t*)(x + (size_t)(row0 + r * stride) * DMODEL) + lane;
#pragma unroll
        for (int j = 0; j < 4; ++j) v[r][j] = __builtin_nontemporal_load(xr + 64 * j); }
#pragma unroll
    for (int r = 0; r < 4; ++r) { float t = 0.f;
#pragma unroll
        for (int j = 0; j < 4; ++j) t += (v[r][j].x * v[r][j].x + v[r][j].y * v[r][j].y) + (v[r][j].z * v[r][j].z + v[r][j].w * v[r][j].w);
        s[r] = __builtin_amdgcn_rsqf(wave_sum_f32(t) * (1.0f / DMODEL) + RMS_EPS); }
#pragma unroll
    for (int j = 0; j < 4; ++j) { const f32x4_t gg = gr[64 * j];
#pragma unroll
        for (int r = 0; r < 4; ++r) { u32x2_t w; const float q = s[r];
            w.x = pk2(v[r][j].x * q * gg.x, v[r][j].y * q * gg.y); w.y = pk2(v[r][j].z * q * gg.z, v[r][j].w * q * gg.w);
            ((u32x2_t*)(xn + (size_t)(row0 + r * stride) * DMODEL) + lane)[64 * j] = w; } }
}
__device__ __forceinline__ void wtrans_item(LAS float* scr, const float* __restrict__ W, int K, int Nold, bf16* __restrict__ WT, int Nnew, int item, int mode, const float* __restrict__ gain, int lane) {
    const int nblk = Nnew / 32, kb = item / nblk, nb = item - kb * nblk, k0 = 64 * kb, n0 = 32 * nb;
    const int n = n0 + (lane & 31);
    const int src = (mode == 1) ? win_phys2src(n) : (mode == 2) ? wukv_phys2src(n) : n;
    float tv[32];
    const float* wp = W + (size_t)(k0 + (lane >> 5)) * Nold + (src >= 0 ? src : 0);
#pragma unroll
    for (int i = 0; i < 32; ++i) tv[i] = wp[(size_t)(2 * i) * Nold];
#pragma unroll
    for (int i = 0; i < 32; ++i) { const int kk = 2 * i + (lane >> 5); float v = (src >= 0) ? tv[i] : 0.f; if (gain) v *= gain[k0 + kk]; scr[kk * 33 + (lane & 31)] = v; }
    asm volatile("s_waitcnt lgkmcnt(0)" ::: "memory");
    const int c = lane & 7;
#pragma unroll
    for (int j = 0; j < 4; ++j) { const int nn = (lane >> 3) + 8 * j; const LAS float* s = scr + (8 * c) * 33 + nn;
        u32x4_t o; o.x = pk2(s[0 * 33], s[1 * 33]); o.y = pk2(s[2 * 33], s[3 * 33]); o.z = pk2(s[4 * 33], s[5 * 33]); o.w = pk2(s[6 * 33], s[7 * 33]);
        *(u32x4_t*)(WT + (size_t)(n0 + nn) * K + k0 + 8 * c) = o; }
    asm volatile("s_waitcnt lgkmcnt(0)" ::: "memory");
}


namespace pg8 {
__device__ __forceinline__ float silu_f(float g) { return g * __builtin_amdgcn_rcpf(1.0f + __builtin_amdgcn_exp2f(g * -1.4426950408889634f)); }
__device__ __forceinline__ float fq_sum(float v) {
    const auto a = __builtin_amdgcn_permlane16_swap(__float_as_uint(v), __float_as_uint(v), false, false);
    v = __uint_as_float(a[0]) + __uint_as_float(a[1]);
    const auto b = __builtin_amdgcn_permlane32_swap(__float_as_uint(v), __float_as_uint(v), false, false);
    return __uint_as_float(b[0]) + __uint_as_float(b[1]);
}
__device__ __forceinline__ float dot4(const f32x4 a) { return (a[0] * a[0] + a[1] * a[1]) + (a[2] * a[2] + a[3] * a[3]); }
__device__ __forceinline__ u32x4 pack8(const f32x4 a, const f32x4 b) { u32x4 w; w.x = cvt_pk_bf16(a[0], a[1]); w.y = cvt_pk_bf16(a[2], a[3]); w.z = cvt_pk_bf16(b[0], b[1]); w.w = cvt_pk_bf16(b[2], b[3]); return w; }
typedef unsigned u32x2 __attribute__((ext_vector_type(2)));
__device__ __forceinline__ u32x2 pack4(const f32x4 a) { u32x2 w; w.x = cvt_pk_bf16(a[0], a[1]); w.y = cvt_pk_bf16(a[2], a[3]); return w; }

struct EpiProj {
    static constexpr bool PERM = true, AFTER_DRAIN = false;
    bf16_t* P; float* ssq; const float* aq_g; const float* ak_g; const float* rc; const float* rs;
    __device__ __forceinline__ void operator()(const f32x4 (&acc)[2][2][4][2], const Unit& u, int wr, int wc, int fr, int fq) const {
        asm volatile("" : "+v"(fr), "+v"(fq));
        const int tile = u.pn; const int row0 = u.pm * BM + wr * 64 + fr;
        if (tile < 4) {
            const bool isk = tile >= 2; const float* g = isk ? ak_g : aq_g; const float sc = isk ? 1.0f : C2A;
            const int colbase = (isk ? C_KA : C_QA) + 64 * (4 * (tile & 1) + wc) + 8 * fq;
            const f32x4 g1a = *(const f32x4*)(g + 8 * fq), g1b = *(const f32x4*)(g + 8 * fq + 4), g2a = *(const f32x4*)(g + 32 + 8 * fq), g2b = *(const f32x4*)(g + 36 + 8 * fq);
#pragma unroll
            for (int ai = 0; ai < 2; ++ai)
#pragma unroll
                for (int m = 0; m < 4; ++m) {
                    const int row = row0 + ai * HALF + m * 16, pos = row & (SEQ - 1);
                    const f32x4 x1a = acc[ai][0][m][0], x1b = acc[ai][0][m][1], x2a = acc[ai][1][m][0], x2b = acc[ai][1][m][1];
                    float ss = (dot4(x1a) + dot4(x1b)) + (dot4(x2a) + dot4(x2b));
                    ss = fq_sum(ss);
                    const float rn = sc * __builtin_amdgcn_rsqf(ss * (1.0f / 64.0f) + RMS_EPS);
                    const float* cp = rc + pos * 32 + 8 * fq; const float* sp = rs + pos * 32 + 8 * fq;
                    const f32x4 ca = *(const f32x4*)cp, cb = *(const f32x4*)(cp + 4), sa = *(const f32x4*)sp, sb = *(const f32x4*)(sp + 4);
                    const f32x4 a0 = x1a * rn * g1a, a1 = x1b * rn * g1b, b0 = x2a * rn * g2a, b1 = x2b * rn * g2b;
                    bf16_t* dst = P + (size_t)row * NP + colbase;
                    *(u32x4*)dst = pack8(a0 * ca - b0 * sa, a1 * cb - b1 * sb);
                    *(u32x4*)(dst + 32) = pack8(b0 * ca + a0 * sa, b1 * cb + a1 * sb);
                }
        } else if (tile == 8 || tile == 9) {
            const int colbase = C_QI + 64 * (4 * (tile - 8) + wc);
#pragma unroll
            for (int ai = 0; ai < 2; ++ai)
#pragma unroll
                for (int m = 0; m < 4; ++m) {
                    const int row = row0 + ai * HALF + m * 16, pos = row & (SEQ - 1);
                    const float* cp = rc + pos * 32 + 8 * fq; const float* sp = rs + pos * 32 + 8 * fq;
                    const f32x4 c0 = *(const f32x4*)cp, c1 = *(const f32x4*)(cp + 4), s0 = *(const f32x4*)sp, s1 = *(const f32x4*)(sp + 4);
                    const f32x4 c = (f32x4){c0[0], c0[2], c1[0], c1[2]}, s = (f32x4){s0[0], s0[2], s1[0], s1[2]};
                    const f32x4 x1 = acc[ai][0][m][0], x2 = acc[ai][0][m][1];
                    bf16_t* dst = P + (size_t)row * NP + colbase;
                    *(u32x2*)(dst + 4 * fq) = pack4(x1 * c - x2 * s);
                    *(u32x2*)(dst + 16 + 4 * fq) = pack4(x2 * c + x1 * s);
                    *(u32x4*)(dst + 32 + 8 * fq) = pack8(acc[ai][1][m][0], acc[ai][1][m][1]);
                }
        } else if (tile == 14) {
#pragma unroll
            for (int ai = 0; ai < 2; ++ai)
#pragma unroll
                for (int m = 0; m < 4; ++m) {
                    const int row = row0 + ai * HALF + m * 16, pos = row & (SEQ - 1);
                    bf16_t* dst = P + (size_t)row * NP + tile * BM;
                    float ss = dot4(acc[ai][0][m][0]) + dot4(acc[ai][0][m][1]);
                    ss = fq_sum(ss);
                    if (fq == 0) ssq[(size_t)row * 24 + 16 + wc] = ss;
                    *(u32x4*)(dst + 32 * wc + 8 * fq) = pack8(acc[ai][0][m][0], acc[ai][0][m][1]);
                    if (wc == 0) {
                        const float* cp = rc + pos * 32 + 8 * fq; const float* sp = rs + pos * 32 + 8 * fq;
                        const f32x4 c0 = *(const f32x4*)cp, c1 = *(const f32x4*)(cp + 4), s0 = *(const f32x4*)sp, s1 = *(const f32x4*)(sp + 4);
                        const f32x4 c = (f32x4){c0[0], c0[2], c1[0], c1[2]}, s = (f32x4){s0[0], s0[2], s1[0], s1[2]};
                        const f32x4 x1 = acc[ai][1][m][0], x2 = acc[ai][1][m][1];
                        *(u32x2*)(dst + HALF + 4 * fq) = pack4(x1 * c - x2 * s);
                        *(u32x2*)(dst + HALF + 16 + 4 * fq) = pack4(x2 * c + x1 * s);
                    } else {
                        *(u32x4*)(dst + HALF + 32 * wc + 8 * fq) = pack8(acc[ai][1][m][0], acc[ai][1][m][1]);
                    }
                }
        } else {
            const bool gate = (tile == 6 || tile == 7 || tile == 10 || tile == 11), lat = (tile >= 12);
#pragma unroll
            for (int ai = 0; ai < 2; ++ai)
#pragma unroll
                for (int m = 0; m < 4; ++m) {
                    const int row = row0 + ai * HALF + m * 16;
                    bf16_t* dst = P + (size_t)row * NP + tile * BM + 32 * wc + 8 * fq;
#pragma unroll
                    for (int bj = 0; bj < 2; ++bj) {
                        f32x4 v0 = acc[ai][bj][m][0], v1 = acc[ai][bj][m][1];
                        if (lat) { float ss = dot4(v0) + dot4(v1); ss = fq_sum(ss);
                            if (fq == 0) ssq[(size_t)row * 24 + (tile == 12 ? 4 * bj : 8 + 4 * bj) + wc] = ss; }
                        if (gate) { v0 = (f32x4){silu_f(v0[0]), silu_f(v0[1]), silu_f(v0[2]), silu_f(v0[3])}; v1 = (f32x4){silu_f(v1[0]), silu_f(v1[1]), silu_f(v1[2]), silu_f(v1[3])}; }
                        *(u32x4*)(dst + bj * HALF) = pack8(v0, v1);
                    }
                }
        }
    }
};

struct EpiKV {
    static constexpr bool PERM = true, AFTER_DRAIN = false;
    bf16_t* KB; bf16_t* VB; const bf16_t* P; const float* ssq; const float* bk_g; const float* rc; const float* rs;
    __device__ __forceinline__ float row_rkv(int row) const {
        const f32x4 q0 = *(const f32x4*)(ssq + (size_t)row * 24 + 12), q1 = *(const f32x4*)(ssq + (size_t)row * 24 + 16);
        return __builtin_amdgcn_rsqf((((q0[0] + q0[1]) + (q0[2] + q0[3])) + ((q1[0] + q1[1]) + (q1[2] + q1[3]))) * (1.0f / 256.0f) + RMS_EPS);
    }
    __device__ __forceinline__ void operator()(const f32x4 (&acc)[2][2][4][2], const Unit& u, int wr, int wc, int fr, int fq) const {
        asm volatile("" : "+v"(fr), "+v"(fq));
        const int head = 2 * u.pn + (wc >> 1); const int row0 = u.pm * BM + wr * 64 + fr;
        if (wc & 1) {
#pragma unroll
            for (int ai = 0; ai < 2; ++ai)
#pragma unroll
                for (int m = 0; m < 4; ++m) {
                    const int row = row0 + ai * HALF + m * 16;
                    const float rkv = row_rkv(row);
                    bf16_t* dst = VB + (size_t)row * 512 + 64 * head + 8 * fq;
#pragma unroll
                    for (int bj = 0; bj < 2; ++bj) *(u32x4*)(dst + 32 * bj) = pack8(acc[ai][bj][m][0] * rkv, acc[ai][bj][m][1] * rkv);
                    asm volatile("" ::: "memory");
                }
        } else {
#pragma unroll
            for (int ai = 0; ai < 2; ++ai)
#pragma unroll
                for (int m = 0; m < 4; ++m) {
                    const int row = row0 + ai * HALF + m * 16, pos = row & (SEQ - 1);
                    const float rkv = row_rkv(row);
                    const u32x2 k1 = *(const u32x2*)(P + (size_t)row * NP + C_KR + 4 * fq), k2 = *(const u32x2*)(P + (size_t)row * NP + C_KR + 16 + 4 * fq);
                    const f32x4 x1 = (f32x4){bflo(k1.x), bfhi(k1.x), bflo(k1.y), bfhi(k1.y)}, x2 = (f32x4){bflo(k2.x), bfhi(k2.x), bflo(k2.y), bfhi(k2.y)};
                    float ssn = (dot4(acc[ai][0][m][0]) + dot4(acc[ai][0][m][1])) + (dot4(acc[ai][1][m][0]) + dot4(acc[ai][1][m][1]));
                    float ssr = dot4(x1) + dot4(x2);
                    ssn = fq_sum(ssn); ssr = fq_sum(ssr);
                    const float rk = __builtin_amdgcn_rsqf((ssn * rkv * rkv + ssr) * (1.0f / 96.0f) + RMS_EPS);
                    bf16_t* dst = KB + (size_t)row * 768 + 96 * head;
                    const float sn = rkv * rk;
#pragma unroll
                    for (int bj = 0; bj < 2; ++bj) { const f32x4 g0 = *(const f32x4*)(bk_g + 32 * bj + 8 * fq), g1 = *(const f32x4*)(bk_g + 32 * bj + 8 * fq + 4);
                        *(u32x4*)(dst + 32 * bj + 8 * fq) = pack8(acc[ai][bj][m][0] * sn * g0, acc[ai][bj][m][1] * sn * g1); }
                    const f32x4 gr1 = *(const f32x4*)(bk_g + 64 + 4 * fq), gr2 = *(const f32x4*)(bk_g + 80 + 4 * fq);
                    const float* cp = rc + pos * 32 + 8 * fq; const float* sp = rs + pos * 32 + 8 * fq;
                    const f32x4 c0 = *(const f32x4*)cp, c1 = *(const f32x4*)(cp + 4), s0 = *(const f32x4*)sp, s1 = *(const f32x4*)(sp + 4);
                    const f32x4 c = (f32x4){c0[0], c0[2], c1[0], c1[2]}, s = (f32x4){s0[0], s0[2], s1[0], s1[2]};
                    const f32x4 a = x1 * rk * gr1, b = x2 * rk * gr2;
                    *(u32x2*)(dst + 64 + 4 * fq) = pack4(a * c - b * s);
                    *(u32x2*)(dst + 80 + 4 * fq) = pack4(b * c + a * s);
                    asm volatile("" ::: "memory");
                }
        }
    }
};
}

constexpr int IDX_KPITCH = 2048 * 4 + 16;
constexpr int IDX_QPITCH = 1040;
constexpr int IDX_KEYS = 0, IDX_QT = 16 * IDX_KPITCH, IDX_W = IDX_QT + 16 * IDX_QPITCH, IDX_M = IDX_W + 16 * 8 * 4, IDX_MP = 65, IDX_END = IDX_M + 32 * IDX_MP * 4;
constexpr int TOPK = 256;
typedef float f32x4i_t __attribute__((ext_vector_type(4)));

__device__ __forceinline__ unsigned wave_sum_u32(unsigned v) {
    v += (unsigned)__builtin_amdgcn_update_dpp(0, (int)v, 0xB1, 0xF, 0xF, false);
    v += (unsigned)__builtin_amdgcn_update_dpp(0, (int)v, 0x4E, 0xF, 0xF, false);
    v += (unsigned)__builtin_amdgcn_update_dpp(0, (int)v, 0x141, 0xF, 0xF, false);
    v += (unsigned)__builtin_amdgcn_update_dpp(0, (int)v, 0x140, 0xF, 0xF, false);
    const auto a = __builtin_amdgcn_permlane16_swap(v, v, false, false); v = a[0] + a[1];
    const auto b = __builtin_amdgcn_permlane32_swap(v, v, false, false); return b[0] + b[1];
}
__device__ __forceinline__ unsigned wave_incl_scan_u32(unsigned v) {
    v += (unsigned)__builtin_amdgcn_update_dpp(0, (int)v, 0x111, 0xF, 0xF, false);
    v += (unsigned)__builtin_amdgcn_update_dpp(0, (int)v, 0x112, 0xF, 0xF, false);
    v += (unsigned)__builtin_amdgcn_update_dpp(0, (int)v, 0x114, 0xF, 0xF, false);
    v += (unsigned)__builtin_amdgcn_update_dpp(0, (int)v, 0x118, 0xF, 0xF, false);
    v += (unsigned)__builtin_amdgcn_update_dpp(0, (int)v, 0x142, 0xA, 0xF, false);
    v += (unsigned)__builtin_amdgcn_update_dpp(0, (int)v, 0x143, 0xC, 0xF, false);
    return v;
}
__device__ __forceinline__ unsigned ge01(unsigned key, unsigned cm1) {
    unsigned t, u;
    asm("v_sub_u32_e64 %0, %1, %2 clamp" : "=v"(t) : "v"(key), "s"(cm1));
    asm("v_min_u32_e32 %0, 1, %1" : "=v"(u) : "v"(t));
    return u;
}
__device__ __forceinline__ unsigned sortable_key(float x) { const unsigned u = __builtin_bit_cast(unsigned, x + 0.0f); return (u & 0x80000000u) ? ~u : (u | 0x80000000u); }

__device__ __forceinline__ void indexer_unit(LAS unsigned char* lds, const bf16* __restrict__ proj, unsigned long long* __restrict__ mask, int b, int qb) {
    const int tid = opaque_tid(), lane = tid & 63, w = __builtin_amdgcn_readfirstlane(tid >> 6);
    const int L = 64 * ((qb >> 1) + 1), nt32 = L >> 5;
    unsigned long long* mbase = mask + ((size_t)(b * 64 + qb) * 64) * 16;
    if (L <= TOPK) {
        for (int j = w; j < nt32; j += 8) if (lane < 16) mbase[(size_t)j * 16 + lane] = ~0ull;
        return;
    }
    const int ni = L >> 6, nt16 = L >> 4;
    LAS unsigned* Mw = (LAS unsigned*)(lds + IDX_M);
    for (int sub = 0; sub < 2; ++sub) {
        const size_t row0 = (size_t)b * SEQ + 32 * qb + 16 * sub;
        __syncthreads();
        for (int c = tid; c < 16 * 64; c += 512) { const int r = c >> 6, ch = c & 63;
            *(LAS u32x4_t*)(lds + IDX_QT + r * IDX_QPITCH + ch * 16) = *(const u32x4_t*)(proj + (row0 + r) * NP + C_QI + ch * 8); }
        if (tid < 128) { const int q = tid & 15, hh = tid >> 4; ((LAS float*)(lds + IDX_W))[hh * 16 + q] = bf2f(proj[(row0 + q) * NP + C_WI + hh]); }
        __syncthreads();
        {
            const int q = lane & 15, g = lane >> 4;
            const LAS unsigned char* qrow = lds + IDX_QT + q * IDX_QPITCH + g * 16;
            const LAS float* wl = (const LAS float*)(lds + IDX_W) + q;
            bf16x8_t qf[8][2]; float wv[8];
#pragma unroll
            for (int h = 0; h < 8; ++h) { qf[h][0] = *(const LAS bf16x8_t*)(qrow + (64 * h) * 2); qf[h][1] = *(const LAS bf16x8_t*)(qrow + (64 * h + 32) * 2); wv[h] = wl[h * 16]; }
            const bf16* kp = proj + ((size_t)b * SEQ + q) * NP + C_KI + 8 * g;
            bf16x8_t kn0 = *(const bf16x8_t*)(kp + (size_t)(16 * w) * NP), kn1 = *(const bf16x8_t*)(kp + (size_t)(16 * w) * NP + 32);
            for (int j = w; j < nt16; j += 8) {
                const bf16x8_t kf0 = kn0, kf1 = kn1;
                if (j + 8 < nt16) { kn0 = *(const bf16x8_t*)(kp + (size_t)(16 * (j + 8)) * NP); kn1 = *(const bf16x8_t*)(kp + (size_t)(16 * (j + 8)) * NP + 32); }
                f32x4i_t tot = (f32x4i_t){0.f, 0.f, 0.f, 0.f};
#pragma unroll
                for (int h = 0; h < 8; ++h) {
                    f32x4i_t acc = (f32x4i_t){0.f, 0.f, 0.f, 0.f};
                    acc = __builtin_amdgcn_mfma_f32_16x16x32_bf16(kf0, qf[h][0], acc, 0, 0, 0);
                    acc = __builtin_amdgcn_mfma_f32_16x16x32_bf16(kf1, qf[h][1], acc, 0, 0, 0);
#pragma unroll
                    for (int r = 0; r < 4; ++r) tot[r] = fmaf(wv[h], fmaxf(acc[r], 0.f), tot[r]);
                }
                u32x4_t kk; kk.x = sortable_key(tot[0]); kk.y = sortable_key(tot[1]); kk.z = sortable_key(tot[2]); kk.w = sortable_key(tot[3]);
                *(LAS u32x4_t*)(lds + IDX_KEYS + q * IDX_KPITCH + (16 * j + 4 * g) * 4) = kk;
            }
            const int Lr = (L + 255) & ~255;
            for (int c = tid; c < 16 * ((Lr - L) >> 2); c += 512) { const int r = c / ((Lr - L) >> 2), ch = c % ((Lr - L) >> 2);
                *(LAS u32x4_t*)(lds + IDX_KEYS + r * IDX_KPITCH + (L + 4 * ch) * 4) = (u32x4_t){0u, 0u, 0u, 0u}; }
        }
        __syncthreads();
#pragma unroll 1
        for (int qi = 0; qi < 2; ++qi) {
            const int q = 2 * w + qi;
            const LAS unsigned* krow = (const LAS unsigned*)(lds + IDX_KEYS + q * IDX_KPITCH) + lane;
            unsigned key[32];
#pragma unroll
            for (int i4 = 0; i4 < 8; ++i4) {
                if (4 * i4 < ni) {
#pragma unroll
                    for (int i = 4 * i4; i < 4 * i4 + 4; ++i) key[i] = krow[64 * i];
                } else {
#pragma unroll
                    for (int i = 4 * i4; i < 4 * i4 + 4; ++i) key[i] = 0u;
                } }
            LAS unsigned* hist = (LAS unsigned*)(lds + IDX_QT) + w * 336;
            unsigned T = 0u; int need = TOPK, ceq = 0; const unsigned dummy = 256u + (unsigned)lane;
            int cgt = 0;
            for (int bit = 31; bit >= 24; --bit) {
                const unsigned cand = T | (1u << bit); const unsigned cm1 = (unsigned)__builtin_amdgcn_readfirstlane(cand - 1u);
                unsigned c0 = 0u, c1 = 0u;
#pragma unroll
                for (int i4 = 0; i4 < 8; ++i4) if (4 * i4 < ni) {
#pragma unroll
                    for (int i = 4 * i4; i < 4 * i4 + 4; i += 2) { c0 += ge01(key[i], cm1); c1 += ge01(key[i + 1], cm1); } }
                const int cnt = (int)__builtin_amdgcn_readfirstlane(wave_sum_u32(c0 + c1));
                if (cnt >= TOPK) T = cand; else cgt = cnt;
            }
            need = TOPK - cgt;
#pragma unroll
            for (int pass = 1; pass < 4; ++pass) {
                const int shift = 24 - 8 * pass;
                ((LAS u32x4_t*)hist)[lane] = (u32x4_t){0u, 0u, 0u, 0u};
                asm volatile("s_waitcnt lgkmcnt(0)" ::: "memory");
#pragma unroll
                for (int i4 = 0; i4 < 8; ++i4) if (4 * i4 < ni) {
#pragma unroll
                    for (int i = 4 * i4; i < 4 * i4 + 4; ++i) {
                        const unsigned k = key[i];
                        const bool mt = (pass == 0) ? true : ((k >> ((shift + 8) & 31)) == (T >> ((shift + 8) & 31)));
                        if (pass < 2 || __ballot(mt) != 0ull)
                            __hip_atomic_fetch_add(hist + (mt ? ((k >> shift) & 255u) : dummy), 1u, __ATOMIC_RELAXED, __HIP_MEMORY_SCOPE_WORKGROUP);
                    } }
                asm volatile("s_waitcnt lgkmcnt(0)" ::: "memory");
                const int base = 4 * (63 - lane);
                const u32x4_t h4 = *(const LAS u32x4_t*)(hist + base);
                const unsigned s = (h4.x + h4.y) + (h4.z + h4.w);
                const unsigned pin = wave_incl_scan_u32(s);
                const unsigned long long bm = __ballot(pin >= (unsigned)need);
                const int ls = __builtin_amdgcn_readfirstlane(__builtin_ctzll(bm | 0x8000000000000000ull));
                unsigned c = pin - s; int dig; unsigned kn, ce;
                if (c + h4.w >= (unsigned)need) { dig = base + 3; kn = (unsigned)need - c; ce = h4.w; }
                else { c += h4.w;
                    if (c + h4.z >= (unsigned)need) { dig = base + 2; kn = (unsigned)need - c; ce = h4.z; }
                    else { c += h4.z;
                        if (c + h4.y >= (unsigned)need) { dig = base + 1; kn = (unsigned)need - c; ce = h4.y; }
                        else { c += h4.y; dig = base; kn = (unsigned)need - c; ce = h4.x; } } }
                const unsigned digit = (unsigned)__builtin_amdgcn_readlane(dig, ls);
                need = __builtin_amdgcn_readlane((int)kn, ls); ceq = __builtin_amdgcn_readlane((int)ce, ls);
                T |= digit << shift;
            }
            const int cge = (ceq == need) ? TOPK : TOPK + 1;
            int taken = 0; unsigned mlo = 0u, mhi = 0u;
#define IDX_SELSTEP(I) { unsigned long long sel; \
                if (cge == TOPK) sel = __ballot(key[I] >= T && key[I] != 0u); \
                else { const bool eq = key[I] == T; const unsigned long long em = __ballot(eq); \
                       const int rank = taken + (int)__builtin_amdgcn_mbcnt_hi((unsigned)(em >> 32), __builtin_amdgcn_mbcnt_lo((unsigned)em, 0u)); \
                       sel = __ballot(key[I] > T || (eq && rank < need)); taken += __popcll(em); } \
                const unsigned slo = (unsigned)sel, shi = (unsigned)(sel >> 32); \
                asm volatile("v_writelane_b32 %0, %1, %2" : "+v"(mlo) : "s"(slo), "n"(I)); asm volatile("v_writelane_b32 %0, %1, %2" : "+v"(mhi) : "s"(shi), "n"(I)); }
#define IDX_SELGRP(G) if (4 * (G) < ni) { IDX_SELSTEP(4 * (G)) IDX_SELSTEP(4 * (G) + 1) IDX_SELSTEP(4 * (G) + 2) IDX_SELSTEP(4 * (G) + 3) }
            IDX_SELGRP(0) IDX_SELGRP(1) IDX_SELGRP(2) IDX_SELGRP(3) IDX_SELGRP(4) IDX_SELGRP(5) IDX_SELGRP(6) IDX_SELGRP(7)
#undef IDX_SELGRP
#undef IDX_SELSTEP
            if (lane < 32) { LAS unsigned* mrow = Mw + (16 * sub + q) * IDX_MP; mrow[2 * lane] = mlo; mrow[2 * lane + 1] = mhi; }
        }
    }
    __syncthreads();
    {
        const int q = lane & 31, hi = lane >> 5;
        for (int j = w; j < nt32; j += 8) {
            const unsigned h2 = Mw[q * IDX_MP + j] >> (4 * hi);
            unsigned long long mine = 0ull;
#pragma unroll
            for (int r = 0; r < 16; ++r) { const unsigned long long bal = __ballot(((h2 >> ((r & 3) + 8 * (r >> 2))) & 1u) != 0u); if (lane == r) mine = bal; }
            if (lane < 16) mbase[(size_t)j * 16 + lane] = mine;
        }
    }
}

struct AttnArgs { const bf16* Q; const bf16* K; const bf16* V; const bf16* G; bf16* O; const unsigned long long* mask; const float* ssq; const float* qg; const float* rc; const float* rs;
                  int qpitch, qhs, kpitch, khs, vpitch, vhs, gpitch, ocol; };
namespace fa {
using bf16x8=__attribute__((ext_vector_type(8)))short;
using s16x4=__attribute__((ext_vector_type(4)))short;
using f32x16=__attribute__((ext_vector_type(16)))float;
using u32x4=__attribute__((ext_vector_type(4)))unsigned;
constexpr int SEQ=2048,D=64;
constexpr int NW=8,QBLK=32,QB=QBLK*NW,KVBLK=64,NQB=SEQ/QB;
__device__ __forceinline__ int crow(int r,int hi){return (r&3)+8*(r>>2)+4*hi;}
#define SBAR() __builtin_amdgcn_sched_barrier(0)
__device__ __forceinline__ void allneg(f32x16&p0,f32x16&p1){
  const float NEG=-INFINITY;
  #pragma unroll
  for(int r=0;r<16;++r){p0[r]=NEG;p1[r]=NEG;}
}

constexpr int NSLOT=3, SLOTB=8192, SLOTKMAX=12288;
constexpr int LDS_K=0, LDS_V=NSLOT*SLOTKMAX, LDS_WS=LDS_V+NSLOT*SLOTB, LDS_OST=LDS_WS+NW*64*4, LDS_BYTES=LDS_OST+NW*4096;
__device__ __forceinline__ void glds16(const void*gsrc,unsigned lds_dst){unsigned keep;
  asm volatile("s_mov_b32 %0, m0\n\ts_mov_b32 m0, %2\n\ts_nop 0\n\tglobal_load_lds_dwordx4 %1, off\n\ts_mov_b32 m0, %0":"=&s"(keep):"v"(gsrc),"s"(lds_dst):"memory");}
__device__ __forceinline__ float max3f(float a,float b,float c){float r;asm("v_max3_f32 %0, %1, %2, %3":"=v"(r):"v"(a),"v"(b),"v"(c));return r;}
__device__ __forceinline__ float max2f(float a,float b){float r;asm("v_max_f32_e32 %0, %1, %2":"=v"(r):"v"(a),"v"(b));return r;}
__device__ __forceinline__ float fadd_s(float a,float b){float r;asm("v_add_f32_e32 %0, %1, %2":"=v"(r):"v"(a),"v"(b));return r;}
__device__ __forceinline__ float fsub_s(float a,float b){float r;asm("v_sub_f32_e32 %0, %1, %2":"=v"(r):"v"(a),"v"(b));return r;}
typedef float f32x2_t __attribute__((ext_vector_type(2))); typedef __bf16 bf16x2_t __attribute__((ext_vector_type(2)));
__device__ __forceinline__ unsigned cvtpk_s(float lo,float hi){f32x2_t v={lo,hi};bf16x2_t b=__builtin_convertvector(v,bf16x2_t);return __builtin_bit_cast(unsigned,b);}
#define WAIT_BAR(N) asm volatile("s_waitcnt vmcnt(" #N ") lgkmcnt(0)\n\ts_barrier":::"memory")

template<int NS> __device__ __forceinline__ void qkt(f32x16&p0,f32x16&p1,const char*Kslot,const bf16x8*qr,int r32,int hi){
  const char*kb=Kslot+hi*1024+r32*16;
  #pragma unroll
  for(int d0=0;d0<NS;++d0){
    const bf16x8 b0=*reinterpret_cast<const bf16x8*>(kb+d0*2048);
    const bf16x8 b1=*reinterpret_cast<const bf16x8*>(kb+d0*2048+512);
    if(d0==0){p0=__builtin_amdgcn_mfma_f32_32x32x16_bf16(b0,qr[0],f32x16{},0,0,0);p1=__builtin_amdgcn_mfma_f32_32x32x16_bf16(b1,qr[0],f32x16{},0,0,0);}
    else{p0=__builtin_amdgcn_mfma_f32_32x32x16_bf16(b0,qr[d0],p0,0,0,0);p1=__builtin_amdgcn_mfma_f32_32x32x16_bf16(b1,qr[d0],p1,0,0,0);}}
}
typedef __attribute__((address_space(3))) const char* lds_cptr;
typedef short v4i16_t __attribute__((ext_vector_type(4)));
template<int NS> __device__ __forceinline__ void kloadN(bf16x8*kf,lds_cptr kp){
  #pragma unroll
  for(int d0=0;d0<NS;++d0){ kf[2*d0]=*(const __attribute__((address_space(3))) bf16x8*)(kp+d0*2048); kf[2*d0+1]=*(const __attribute__((address_space(3))) bf16x8*)(kp+d0*2048+512); }
}
__device__ __forceinline__ void kload2(bf16x8*kf,lds_cptr kp,int j){ kf[2*j]=*(const __attribute__((address_space(3))) bf16x8*)(kp+j*2048); kf[2*j+1]=*(const __attribute__((address_space(3))) bf16x8*)(kp+j*2048+512); }
__device__ __forceinline__ s16x4 vtr(lds_cptr p){ return __builtin_bit_cast(s16x4,__builtin_amdgcn_ds_read_tr16_b64_v4i16((__attribute__((address_space(3))) v4i16_t*)p)); }
__device__ __forceinline__ float rowmax(const f32x16&p0,const f32x16&p1){
  float a=max3f(p0[0],p0[1],p1[0]),b=max3f(p0[2],p0[3],p1[1]);a=max3f(a,p1[2],p1[3]);
  #pragma unroll
  for(int r=4;r<16;r+=4){a=max3f(a,p0[r],p0[r+1]);b=max3f(b,p0[r+2],p0[r+3]);a=max3f(a,p1[r],p1[r+1]);b=max3f(b,p1[r+2],p1[r+3]);}
  const float m=max2f(a,b);
  auto rr=__builtin_amdgcn_permlane32_swap(__float_as_uint(m),__float_as_uint(m),false,false);
  return max2f(__uint_as_float(rr[0]),__uint_as_float(rr[1]));
}
__device__ __forceinline__ void pv(f32x16*o,int vb,bf16x8 pa0,bf16x8 pa1,bf16x8 pa2,bf16x8 pa3){
  #pragma unroll
  for(int d0=0;d0<2;++d0){s16x4 lo[4],hi[4];
    #pragma unroll
    for(int ks=0;ks<4;++ks){
      asm volatile("ds_read_b64_tr_b16 %0,%1 offset:%c2":"=&v"(lo[ks]):"v"(vb),"i"(d0*4096+ks*1024):"memory");
      asm volatile("ds_read_b64_tr_b16 %0,%1 offset:%c2":"=&v"(hi[ks]):"v"(vb),"i"(d0*4096+ks*1024+512):"memory");}
    asm volatile("s_waitcnt lgkmcnt(0)":::"memory");SBAR();
    #define PK(k) (bf16x8){lo[k][0],lo[k][1],lo[k][2],lo[k][3],hi[k][0],hi[k][1],hi[k][2],hi[k][3]}
    o[d0]=__builtin_amdgcn_mfma_f32_32x32x16_bf16(pa0,PK(0),o[d0],0,0,0);
    o[d0]=__builtin_amdgcn_mfma_f32_32x32x16_bf16(pa1,PK(1),o[d0],0,0,0);
    o[d0]=__builtin_amdgcn_mfma_f32_32x32x16_bf16(pa2,PK(2),o[d0],0,0,0);
    o[d0]=__builtin_amdgcn_mfma_f32_32x32x16_bf16(pa3,PK(3),o[d0],0,0,0);
    #undef PK
  }
}

#ifndef ATTN_STORE16
#define ATTN_STORE16(p,v) (*(u32x4*)(p)=(v))
#endif
template<int THRL,bool SEL,int NS,bool QN> __device__ __forceinline__ void attn_unit(int b,int h,int qb,const AttnArgs&a,char*shm){
  const int tid=opaque_tid(),lane=tid&63,r32=lane&31,hi=lane>>5; const int wid=__builtin_amdgcn_readfirstlane(tid>>6);
  const long rowbase=(long)b*SEQ; const int q0=qb*QB;
  const long qpitch=a.qpitch,kpitch=a.kpitch,vpitch=a.vpitch;
  const bf16*Qw=a.Q+(rowbase+q0+wid*QBLK)*qpitch+h*a.qhs;
  const bf16*Kh=a.K+rowbase*kpitch+h*a.khs,*Vh=a.V+rowbase*vpitch+h*a.vhs;
  typedef const __attribute__((address_space(4))) unsigned long long* cmask_t;
  const cmask_t mrow=SEL?(cmask_t)(a.mask+((size_t)(b*64+(q0>>5)+wid)*64)*16):(cmask_t)nullptr;
  unsigned long long mk[32];
  const unsigned lds0=(unsigned)(uintptr_t)shm;
  float*wsf=(float*)(shm+LDS_WS)+wid*64;
  const bf16*ksrc=Kh+(long)lane*kpitch+wid*8;
  const bf16*vsrc=Vh+(long)(16*(wid&3)+(lane>>2))*vpitch+(wid>>2)*32+(lane&3)*8;
  const unsigned kdst=lds0+LDS_K+wid*1024, vdst=lds0+LDS_V+wid*1024;
  const bf16*ksrc2=Kh+(long)lane*kpitch+(8+(wid&3))*8; const unsigned kdst2=lds0+LDS_K+(8+(wid&3))*1024;
  #define KS(sl) (((sl)>>2)*NS)
  #define DMA_K(t,slot) do{ glds16(ksrc+(long)(t)*KVBLK*kpitch,(unsigned)__builtin_amdgcn_readfirstlane(kdst+KS(slot))); if constexpr(NS==6) glds16(ksrc2+(long)(t)*KVBLK*kpitch,(unsigned)__builtin_amdgcn_readfirstlane(kdst2+KS(slot))); }while(0)
  #define WB2() do{ if constexpr(NS==6){WAIT_BAR(3);}else{WAIT_BAR(2);} }while(0)
  #define DMA_V(t,slot) glds16(vsrc+(long)(t)*KVBLK*vpitch,(unsigned)__builtin_amdgcn_readfirstlane(vdst+(slot)))
  const int vb0=(int)(lds0+LDS_V)+((lane>>4)&1)*32+(lane&3)*8+(4*hi+((lane&15)>>2))*64;
  const char*Kbase=shm+LDS_K; bf16x8 kf[2*NS];
  const lds_cptr shm3=(lds_cptr)shm; const lds_cptr kp0=shm3+LDS_K+hi*1024+r32*16; const lds_cptr vp0=shm3+LDS_V+((lane>>4)&1)*32+(lane&3)*8+(4*hi+((lane&15)>>2))*64;
  const int NT=(q0+QB)/KVBLK;
  DMA_K(0,0);DMA_V(0,0);DMA_K(1,SLOTB);
  bf16x8 qr[NS];
  #pragma unroll
  for(int d0=0;d0<NS;++d0)qr[d0]=*reinterpret_cast<const bf16x8*>(&Qw[(long)r32*qpitch+d0*16+hi*8]);
  if constexpr(QN){
    static_assert(NS==6,"QN is the 96-dim head group");
    const long row=rowbase+q0+wid*QBLK+r32; const int pos=q0+wid*QBLK+r32;
    float qv[6][8]; float ss=0.f;
    #pragma unroll
    for(int d0=0;d0<6;++d0){
      #pragma unroll
      for(int j=0;j<8;++j){ qv[d0][j]=bf2f((unsigned short)qr[d0][j]); ss+=qv[d0][j]*qv[d0][j]; } }
    ss+=__shfl_xor(ss,32);
    const float*sq=a.ssq+row*24; float msq=0.f;
    #pragma unroll
    for(int i=0;i<12;++i)msq+=sq[i];
    msq=msq*(1.0f/384.0f)+1e-6f;
    const float rn=C2B*__builtin_amdgcn_rsqf(ss*(1.0f/96.0f)+1e-6f*msq);
    const float*gq=a.qg+8*hi;
    #pragma unroll
    for(int d0=0;d0<4;++d0){
      #pragma unroll
      for(int j=0;j<8;++j)qv[d0][j]*=rn*gq[16*d0+j]; }
    const float*cp=a.rc+pos*32+16*hi,*sp=a.rs+pos*32+16*hi;
    #pragma unroll
    for(int j=0;j<8;++j){ const float x1=qv[4][j]*rn*gq[64+j],x2=qv[5][j]*rn*gq[80+j],c=cp[2*j],s=sp[2*j]; qv[4][j]=x1*c-x2*s; qv[5][j]=x2*c+x1*s; }
    #pragma unroll
    for(int d0=0;d0<6;++d0){ u32x4 w;
      #pragma unroll
      for(int e=0;e<4;++e)w[e]=pk2(qv[d0][2*e],qv[d0][2*e+1]);
      qr[d0]=__builtin_bit_cast(bf16x8,w); }
  }
  float l_reg=0.f;f32x16 o[2];o[0]=f32x16{};o[1]=f32x16{};
  const int qrel=wid*QBLK+r32;
  #define CMASK(P0,P1,t) do{int jb_=(t)-(NT-4); if(jb_>(wid>>1))allneg(P0,P1);}while(0)
  #define MKLOAD(t) do{ if constexpr(SEL){ const cmask_t mw_=mrow+(long)(t)*32; _Pragma("unroll") for(int r=0;r<32;++r)mk[r]=mw_[r]; } }while(0)
  #define MKZ(X,B,WB) do{ if constexpr(SEL){ _Pragma("unroll") for(int r=0;r<4;++r)X[(B)+r]=__builtin_amdgcn_inverse_ballot_w64(mk[(WB)+(B)+r])?X[(B)+r]:0.f; } }while(0)
  #define START(P0,P1) do{ _Pragma("unroll") for(int r=0;r<16;++r)P0[r]=__builtin_amdgcn_exp2f(P0[r]); }while(0)
  #define RESC() do{}while(0)
  f32x16 pA0,pA1,pB0,pB1;
  int sl_prev=0,sl_cur=0,sl_next=SLOTB;
  #define ROT() do{sl_prev=sl_cur;sl_cur=sl_next;sl_next=(sl_next==(NSLOT-1)*SLOTB)?0:sl_next+SLOTB;}while(0)
  MKLOAD(0);
  DMA_K(2,2*SLOTB);
  if constexpr(NS==6){WAIT_BAR(5);}else{WAIT_BAR(3);}
  qkt<NS>(pA0,pA1,Kbase,qr,r32,hi);asm volatile("s_nop 15\n\ts_nop 7":"+v"(pA0),"+v"(pA1));CMASK(pA0,pA1,0);
  START(pA0,pA1);
  _Pragma("unroll") for(int r=0;r<16;++r)pA1[r]=__builtin_amdgcn_exp2f(pA1[r]);
  MKZ(pA0,0,0);MKZ(pA0,4,0);MKZ(pA0,8,0);MKZ(pA0,12,0);MKZ(pA1,0,16);MKZ(pA1,4,16);MKZ(pA1,8,16);MKZ(pA1,12,16);
  WAIT_BAR(0);
  DMA_K(3,0);DMA_V(1,SLOTB);
  ROT();
  kloadN<NS>(kf,kp0+KS(sl_cur));
  WB2();
  s16x4 vlo[8],vhi[8]; u32x4 pw0,pw1,pw2,pw3;
  #define PKW(P,B) cvtpk_s(P[B],P[B+1])
  #define PAF(k) __builtin_bit_cast(bf16x8,pw##k)
  #define VFR(i) (bf16x8){vlo[i][0],vlo[i][1],vlo[i][2],vlo[i][3],vhi[i][0],vhi[i][1],vhi[i][2],vhi[i][3]}
  #define PIN(x) asm volatile("":"+v"(x))
  #define MX3(a,b,c) __builtin_fmaxf(__builtin_fmaxf((a),(b)),(c))
  #define GAPA(MF,A0,A1,A2,A3,W0,W1,PW) do{ MF; sacc+=A0; sacc+=A1; sacc+=A2; sacc+=A3; PIN(sacc); W0; W1; PIN(PW); SBAR(); }while(0)
  #define EX(v) __builtin_amdgcn_exp2f(v)
  #define GAPB(MF,X,B,WB) do{ MF; X[B]=EX(X[B]); X[B+1]=EX(X[B+1]); X[B+2]=EX(X[B+2]); X[B+3]=EX(X[B+3]); MKZ(X,B,WB); PIN(X); SBAR(); }while(0)
  #define VRD(i) do{ vlo[i]=vtr(vp_+(((i)>>2)*4096+((i)&3)*1024)); vhi[i]=vtr(vp_+(((i)>>2)*4096+((i)&3)*1024+512)); }while(0)
  #define KRD(G,j) do{ if(G){ kload2(kf,kp0+KS(sl_next),j); SBAR(); } }while(0)
  #define KRD6(G,j) do{ if constexpr(NS==6){ KRD(G,j); } }while(0)
  #define STEP(C0,C1,P0,P1,t,GK,GV,GL) do{ SBAR(); MKLOAD(t); \
    const lds_cptr vp_=vp0+sl_prev; \
    VRD(0); SBAR(); float sacc=(P0[0]+P0[1]); \
    GAPA(C0=__builtin_amdgcn_mfma_f32_32x32x16_bf16(kf[0],qr[0],f32x16{},0,0,0), P0[2],P0[3],P0[4],P0[5],     pw0[0]=PKW(P0,0), pw0[1]=PKW(P0,2), pw0); \
    VRD(4); SBAR(); GAPA(C1=__builtin_amdgcn_mfma_f32_32x32x16_bf16(kf[1],qr[0],f32x16{},0,0,0), P0[6],P0[7],P0[8],P0[9],     pw0[2]=PKW(P0,4), pw0[3]=PKW(P0,6), pw0); \
    VRD(1); SBAR(); GAPA(C0=__builtin_amdgcn_mfma_f32_32x32x16_bf16(kf[2],qr[1],C0,0,0,0),   P0[10],P0[11],P0[12],P0[13], pw1[0]=PKW(P0,8), pw1[1]=PKW(P0,10), pw1); \
    VRD(5); SBAR(); GAPA(C1=__builtin_amdgcn_mfma_f32_32x32x16_bf16(kf[3],qr[1],C1,0,0,0),   P0[14],P0[15],P1[0],P1[1],   pw1[2]=PKW(P0,12),pw1[3]=PKW(P0,14), pw1); \
    VRD(2); SBAR(); GAPA(C0=__builtin_amdgcn_mfma_f32_32x32x16_bf16(kf[4],qr[2],C0,0,0,0),   P1[2],P1[3],P1[4],P1[5],     pw2[0]=PKW(P1,0), pw2[1]=PKW(P1,2), pw2); \
    VRD(6); SBAR(); GAPA(C1=__builtin_amdgcn_mfma_f32_32x32x16_bf16(kf[5],qr[2],C1,0,0,0),   P1[6],P1[7],P1[8],P1[9],     pw2[2]=PKW(P1,4), pw2[3]=PKW(P1,6), pw2); \
    VRD(3); SBAR(); GAPA(C0=__builtin_amdgcn_mfma_f32_32x32x16_bf16(kf[6],qr[3],C0,0,0,0),   P1[10],P1[11],P1[12],P1[13], pw3[0]=PKW(P1,8), pw3[1]=PKW(P1,10), pw3); \
    VRD(7); SBAR(); GAPA(C1=__builtin_amdgcn_mfma_f32_32x32x16_bf16(kf[7],qr[3],C1,0,0,0),   P1[14],P1[15],0.f,0.f,       pw3[2]=PKW(P1,12),pw3[3]=PKW(P1,14), pw3); \
    if constexpr(NS==6){ C0=__builtin_amdgcn_mfma_f32_32x32x16_bf16(kf[8],qr[4],C0,0,0,0); C1=__builtin_amdgcn_mfma_f32_32x32x16_bf16(kf[9],qr[4],C1,0,0,0); \
      C0=__builtin_amdgcn_mfma_f32_32x32x16_bf16(kf[10],qr[5],C0,0,0,0); C1=__builtin_amdgcn_mfma_f32_32x32x16_bf16(kf[11],qr[5],C1,0,0,0); SBAR(); } \
    l_reg+=sacc; \
    if(GK){DMA_K((t)+3,sl_cur);} if(GV){DMA_V((t)+1,sl_next);} \
    CMASK(C0,C1,t); \
    SBAR(); \
    GAPB(o[0]=__builtin_amdgcn_mfma_f32_32x32x16_bf16(PAF(0),VFR(0),o[0],0,0,0), C0,0,0); \
    GAPB(o[1]=__builtin_amdgcn_mfma_f32_32x32x16_bf16(PAF(0),VFR(4),o[1],0,0,0), C0,4,0); \
    KRD(GL,0); GAPB(o[0]=__builtin_amdgcn_mfma_f32_32x32x16_bf16(PAF(1),VFR(1),o[0],0,0,0), C0,8,0); \
    KRD(GL,1); GAPB(o[1]=__builtin_amdgcn_mfma_f32_32x32x16_bf16(PAF(1),VFR(5),o[1],0,0,0), C0,12,0); \
    KRD(GL,2); GAPB(o[0]=__builtin_amdgcn_mfma_f32_32x32x16_bf16(PAF(2),VFR(2),o[0],0,0,0), C1,0,16); \
    KRD(GL,3); GAPB(o[1]=__builtin_amdgcn_mfma_f32_32x32x16_bf16(PAF(2),VFR(6),o[1],0,0,0), C1,4,16); \
    KRD6(GL,4); GAPB(o[0]=__builtin_amdgcn_mfma_f32_32x32x16_bf16(PAF(3),VFR(3),o[0],0,0,0), C1,8,16); \
    KRD6(GL,5); GAPB(o[1]=__builtin_amdgcn_mfma_f32_32x32x16_bf16(PAF(3),VFR(7),o[1],0,0,0), C1,12,16); \
    }while(0)
  int t=1;
  #undef CMASK
  #define CMASK(P0,P1,t) do{}while(0)
  for(;t+5<NT;t+=2){
    STEP(pB0,pB1,pA0,pA1,t,true,true,true);     WB2(); RESC(); ROT();
    STEP(pA0,pA1,pB0,pB1,t+1,true,true,true);   WB2(); RESC(); ROT();
  }
  #undef CMASK
  #define CMASK(P0,P1,t) do{int jb_=(t)-(NT-4); if(jb_>(wid>>1))allneg(P0,P1);}while(0)
  #define ENDW(tt) do{ if((tt)+3<NT){WB2();} else if((tt)+2<NT){WAIT_BAR(1);} else {WAIT_BAR(0);} }while(0)
  for(;t+1<NT;t+=2){
    STEP(pB0,pB1,pA0,pA1,t,(t+3<NT),(t+1<NT),(t+1<NT));       ENDW(t);   RESC(); ROT();
    STEP(pA0,pA1,pB0,pB1,t+1,(t+4<NT),(t+2<NT),(t+2<NT));     ENDW(t+1); RESC(); ROT();
  }
  STEP(pB0,pB1,pA0,pA1,NT-1,false,false,false); RESC();
  { float sacc=pB0[0]+pB0[1]; _Pragma("unroll") for(int r=2;r<16;++r)sacc+=pB0[r]; _Pragma("unroll") for(int r=0;r<16;++r)sacc+=pB1[r]; l_reg+=sacc;
    pw0=(u32x4){PKW(pB0,0),PKW(pB0,2),PKW(pB0,4),PKW(pB0,6)};pw1=(u32x4){PKW(pB0,8),PKW(pB0,10),PKW(pB0,12),PKW(pB0,14)};pw2=(u32x4){PKW(pB1,0),PKW(pB1,2),PKW(pB1,4),PKW(pB1,6)};pw3=(u32x4){PKW(pB1,8),PKW(pB1,10),PKW(pB1,12),PKW(pB1,14)};
    SBAR(); pv(o,vb0+sl_cur,PAF(0),PAF(1),PAF(2),PAF(3)); }
  #undef PKW
  #undef PAF
  #undef VFR
  #undef PIN
  #undef MX3
  #undef GAPA
  #undef GAPB
  #undef EX
  #undef VRD
  #undef KRD
  #undef KRD6
  #undef STEP
  #undef ENDW
  {auto rr=__builtin_amdgcn_permlane32_swap(__float_as_uint(l_reg),__float_as_uint(l_reg),false,false);l_reg=__uint_as_float(rr[0])+__uint_as_float(rr[1]);}
  if(hi==0)wsf[32+r32]=l_reg;asm volatile("s_waitcnt lgkmcnt(0)":::"memory");
  float rli[16];
  #pragma unroll
  for(int r=0;r<16;++r)rli[r]=__builtin_amdgcn_rcpf(wsf[32+crow(r,hi)]);
  bf16*Ow=a.O+(rowbase+q0+wid*QBLK)*1024+a.ocol+h*D;
  const bf16*Gw=a.G+(rowbase+q0+wid*QBLK)*(long)a.gpitch+h*D;
  { bf16*stg=(bf16*)(shm+LDS_OST)+wid*2048;
    #pragma unroll
    for(int r=0;r<16;++r){const int orow=crow(r,hi);
      #pragma unroll
      for(int d0=0;d0<2;++d0)stg[orow*64+d0*32+r32]=(bf16)f2bf(o[d0][r]*rli[r]);}
    asm volatile("s_waitcnt lgkmcnt(0)":::"memory");
    #pragma unroll
    for(int i=0;i<4;++i){const int row=i*8+(lane>>3),ch=lane&7; const u32x4 v=*(const u32x4*)(stg+row*64+ch*8);
      const u32x4 g=*(const u32x4*)(Gw+(long)row*a.gpitch+ch*8); u32x4 w;
      #pragma unroll
      for(int e=0;e<4;++e) w[e]=pk2(bflo(v[e])*bflo(g[e]),bfhi(v[e])*bfhi(g[e]));
      ATTN_STORE16(Ow+(long)row*1024+ch*8,w);} }
  asm volatile("s_waitcnt lgkmcnt(0)\n\ts_barrier":::"memory");
  #undef DMA_K
  #undef KS
  #undef WB2
  #undef DMA_V
  #undef CMASK
  #undef MKLOAD
  #undef MKZ
  #undef START
  #undef RESC
  #undef ROT
}
constexpr int ATTN_LDS_BYTES=LDS_BYTES;
#undef SBAR
#undef WAIT_BAR
}
#define XB_TMO      128
#define XB_XCNT(j)  (256  + 64 * (j))
#define XB_XSUB(j)  (1280 + 64 * (j))
#define XB_XGEN(j)  (2304 + 64 * (j))
#define XB_TOP      3328
#define XB_TOPGEN   3392
#define XCD_BAR_WORDS 3456
#define XB_SPIN_CAP (1u << 18)

__device__ __forceinline__ unsigned xb_ld(unsigned* p)              { return __hip_atomic_load(p, __ATOMIC_RELAXED, __HIP_MEMORY_SCOPE_AGENT); }
__device__ __forceinline__ unsigned xb_add(unsigned* p, unsigned v) { return __hip_atomic_fetch_add(p, v, __ATOMIC_RELAXED, __HIP_MEMORY_SCOPE_AGENT); }
__device__ __forceinline__ unsigned xb_xcc_id() { return (unsigned)__builtin_amdgcn_s_getreg((3 << 11) | 20) & 0xFu; }
#define XB_SPIN(cond, bar) do { unsigned _sp = 0; while (cond) { __builtin_amdgcn_s_sleep(1); \
    if ((++_sp & 255u) == 0u) { if (xb_ld(&(bar)[XB_TMO])) break; if (_sp > XB_SPIN_CAP) { atomicAdd(&(bar)[XB_TMO], 1u); break; } } } } while (0)

struct XcdBarrier {
    unsigned* bar; unsigned x;
    volatile LAS unsigned* st;
};

__device__ __forceinline__ XcdBarrier xcd_barrier_post(unsigned* bar, volatile LAS unsigned* st) {
    XcdBarrier b; b.bar = bar; b.x = xb_xcc_id(); b.st = st;
    if (threadIdx.x == 0) (void)xb_add(&bar[XB_XCNT(b.x)], 1u);
    return b;
}
__device__ __forceinline__ void xcd_barrier_complete(unsigned* bar, unsigned x, unsigned& nloc, unsigned& nx) {
    const unsigned G = gridDim.x * gridDim.y * gridDim.z;
    unsigned sum, cnt, mine, sp = 0u;
    for (;;) {
        sum = 0u; cnt = 0u; mine = 0u;
#pragma unroll
        for (unsigned j = 0; j < 16; ++j) { const unsigned c = xb_ld(&bar[XB_XCNT(j)]); sum += c; cnt += (c > 0u) ? 1u : 0u; mine = (j == x) ? c : mine; }
        if (sum == G) break;
        __builtin_amdgcn_s_sleep(1);
        if ((++sp & 255u) == 0u) { if (xb_ld(&bar[XB_TMO])) break; if (sp > XB_SPIN_CAP) { atomicAdd(&bar[XB_TMO], 1u); break; } }
    }
    nloc = mine > 0u ? mine : 1u; nx = cnt > 0u ? cnt : 1u;
}

__device__ __forceinline__ void xcd_barrier(const XcdBarrier& b) {
    asm volatile("s_waitcnt vmcnt(0)" ::: "memory");
    __syncthreads();
    if (threadIdx.x == 0) {
        unsigned* bar = b.bar;
        __builtin_amdgcn_s_waitcnt(0);
        unsigned nloc = b.st[0], nx = b.st[1];
        if (nloc == 0u) { xcd_barrier_complete(bar, b.x, nloc, nx); b.st[0] = nloc; b.st[1] = nx; }
        const unsigned old = xb_add(&bar[XB_XSUB(b.x)], 1u);
        const unsigned gen = old / nloc;
        if (old + 1u == (gen + 1u) * nloc) {
            __builtin_amdgcn_fence(__ATOMIC_RELEASE, "agent");
            asm volatile("s_waitcnt vmcnt(0)" ::: "memory");
            const unsigned og = xb_add(&bar[XB_TOP], 1u);
            const unsigned tg = og / nx;
            if (og + 1u == (tg + 1u) * nx) xb_add(&bar[XB_TOPGEN], 1u);
            else XB_SPIN(xb_ld(&bar[XB_TOPGEN]) == tg, bar);
            __builtin_amdgcn_fence(__ATOMIC_ACQUIRE, "agent");
            xb_add(&bar[XB_XGEN(b.x)], 1u);
            asm volatile("s_waitcnt vmcnt(0)" ::: "memory");
        } else {
            XB_SPIN(xb_ld(&bar[XB_XGEN(b.x)]) == gen, bar);
            __builtin_amdgcn_fence(__ATOMIC_ACQUIRE, "agent");
            asm volatile("s_waitcnt vmcnt(0)" ::: "memory");
        }
    }
    __syncthreads();
}

constexpr int NWAVES = 8;
constexpr int RING_BYTES = 157696;
constexpr int LDSCTL_OFF = RING_BYTES, MISC_OFF = LDSCTL_OFF + 320;
constexpr int LDS_BYTES = 158720;
static_assert(IDX_END <= RING_BYTES && fa::ATTN_LDS_BYTES <= RING_BYTES && pg8::STAGE_BYTES <= RING_BYTES, "phase scratch fits");
constexpr int CW_BAR = 4096;
constexpr size_t CTL_ZERO_BYTES = 64 * 1024;
static_assert((CW_BAR + XCD_BAR_WORDS) * 4 <= (int)CTL_ZERO_BYTES, "barrier words inside the memset region");

struct MegaArgs { const float* in[12]; float* out; unsigned char* ws; };

__global__ void __launch_bounds__(NWAVES * 64, 2) mega_fwd(MegaArgs args) {
    extern __shared__ __attribute__((aligned(16))) unsigned char lds_raw[];
    LAS unsigned char* lds = (LAS unsigned char*)lds_raw;
    const int tid = opaque_tid(), lane = tid & 63; const int wave = __builtin_amdgcn_readfirstlane(tid >> 6);
    const int G = gridDim.x, bx = blockIdx.x, vcu = (G % 8 == 0) ? (bx % 8) * (G / 8) + bx / 8 : bx;
    unsigned char* const ws = args.ws;
#define WSP(T, off) ((T*)(ws + (off)))
    float* const GAINS = WSP(float, WS_GAINS);

    for (int u = tid; u < (LDS_BYTES - LDSCTL_OFF) / 4; u += NWAVES * 64) ((LAS unsigned*)(lds + LDSCTL_OFF))[u] = 0u;
    __syncthreads();
    XcdBarrier bar = xcd_barrier_post((unsigned*)(ws + WS_CTL) + CW_BAR, (volatile LAS unsigned*)(lds + MISC_OFF) + 8);

    const int gw = vcu * NWAVES + wave, NGW = G * NWAVES;

    {
        float* RC = WSP(float, WS_ROPE); float* RS = RC + SEQ * 32;
        for (int i = vcu * 512 + tid; i < SEQ * 32; i += G * 512) rope_table_elem(RC, RS, i);
        if (vcu == 0 && tid < 320) { const int i = tid; GAINS[i] = (i < 64) ? args.in[3][i] : (i < 128) ? args.in[4][i - 64] : (i < 224) ? args.in[9][i - 128] : args.in[10][i - 224]; }
        constexpr int I_IN = 16 * (NP / 32), I_UQ = 6 * 24, I_UKV = 4 * 32, I_OUT = 16 * 32;
        LAS float* scr = (LAS float*)(lds + wave * 8448);
        for (int it = gw; it < I_IN + I_UQ + I_UKV + I_OUT; it += NGW) {
            int r = it;
            if (r < I_IN) { wtrans_item(scr, args.in[2], 1024, D_IN_OLD, WSP(bf16, WS_WIN), NP, r, 1, nullptr, lane); continue; } r -= I_IN;
            if (r < I_UQ) { wtrans_item(scr, args.in[7], 384, 768, WSP(bf16, WS_WUQ), 768, r, 0, args.in[5], lane); continue; } r -= I_UQ;
            if (r < I_UKV) { wtrans_item(scr, args.in[8], 256, 1024, WSP(bf16, WS_WUKV), 1024, r, 2, args.in[6], lane); continue; } r -= I_UKV;
            wtrans_item(scr, args.in[11], 1024, 1024, WSP(bf16, WS_WOUT), 1024, r, 0, nullptr, lane);
        }
        for (int m = gw; m < MTOK; m += 4 * NGW) rmsnorm_x_rows4(args.in[0], args.in[1], WSP(bf16, WS_XN), m, NGW, lane);
    }
    xcd_barrier(bar);

    {
        pg8::Gemm g{WSP(bf16, WS_XN), WSP(bf16, WS_WIN), MTOK, NP, 1024, 1024}; pg8::StaticOrder S; S.init(MTOK, NP, G, bx);
        pg8::EpiProj E{WSP(bf16, WS_PROJ), WSP(float, WS_SSQ), GAINS, GAINS + 64, WSP(float, WS_ROPE), WSP(float, WS_ROPE) + SEQ * 32};
        pg8::gemm_phase<pg8::EpiProj, pg8::StaticOrder, true, true>(lds, g, S, E);
    }
    xcd_barrier(bar);

    {
        pg8::Gemm g{WSP(bf16, WS_PROJ) + C_CQ, WSP(bf16, WS_WUQ), MTOK, 768, 384, NP}; pg8::StaticOrder S; S.init(MTOK, 768, G, bx);
        pg8::EpiBf16<0> E{WSP(bf16, WS_QB), 768, nullptr, 0, 0, 1.f};
        pg8::gemm_phase<pg8::EpiBf16<0>, pg8::StaticOrder, true, true>(lds, g, S, E);
    }
    {
        pg8::Gemm g{WSP(bf16, WS_PROJ) + C_CKV, WSP(bf16, WS_WUKV), MTOK, 1024, 256, NP}; pg8::StaticOrder S; S.init(MTOK, 1024, G, bx);
        pg8::EpiKV E{WSP(bf16, WS_KB), WSP(bf16, WS_VB), WSP(bf16, WS_PROJ), WSP(float, WS_SSQ), GAINS + 224, WSP(float, WS_ROPE), WSP(float, WS_ROPE) + SEQ * 32};
        pg8::gemm_phase<pg8::EpiKV, pg8::StaticOrder, true, true>(lds, g, S, E);
    }
    for (int p = vcu; p < 512; p += G) {
        const int b = p & 15, qq = p >> 4;
        indexer_unit(lds, WSP(bf16, WS_PROJ), WSP(unsigned long long, WS_MASK), b, 63 - qq);
        indexer_unit(lds, WSP(bf16, WS_PROJ), WSP(unsigned long long, WS_MASK), b, qq);
    }
    xcd_barrier(bar);

    {
        bf16* PROJ = WSP(bf16, WS_PROJ); bf16* MIXED = WSP(bf16, WS_MIXED);
        const AttnArgs aA{PROJ + C_QA, PROJ + C_KA, PROJ + C_VA, PROJ + C_GA, MIXED, WSP(unsigned long long, WS_MASK), nullptr, nullptr, nullptr, nullptr, NP, 64, NP, 64, NP, 64, NP, 0};
        const AttnArgs aB{WSP(bf16, WS_QB), WSP(bf16, WS_KB), WSP(bf16, WS_VB), PROJ + C_GB, MIXED, nullptr, WSP(float, WS_SSQ), GAINS + 128, WSP(float, WS_ROPE), WSP(float, WS_ROPE) + SEQ * 32, 768, 96, 768, 96, 512, 64, NP, 512};
        for (int p = vcu; p < 512; p += G) {
            const int s = p & 3, h = (p >> 2) & 7, b = p >> 5;
            fa::attn_unit<8, true, 4, false>(b, h, 7 - s, aA, (char*)lds_raw);
            fa::attn_unit<8, true, 4, false>(b, h, s, aA, (char*)lds_raw);
            fa::attn_unit<8, false, 6, true>(b, h, 7 - s, aB, (char*)lds_raw);
            fa::attn_unit<8, false, 6, true>(b, h, s, aB, (char*)lds_raw);
        }
    }
    xcd_barrier(bar);

    {
        pg8::Gemm g{WSP(bf16, WS_MIXED), WSP(bf16, WS_WOUT), MTOK, 1024, 1024, 1024}; pg8::StaticOrder S; S.init(MTOK, 1024, G, bx);
        pg8::EpiResF32 E{args.in[0], args.out, 1024};
        pg8::gemm_phase<pg8::EpiResF32, pg8::StaticOrder, true, true>(lds, g, S, E);
    }
}

extern "C" void kernel_launch(void* const* d_in, const int* in_sizes, int n_in, void* d_out, int out_size, void* d_ws, size_t ws_size, hipStream_t stream) {
    static int grid = 0;
    if (grid == 0) {
        if (n_in != 12 || in_sizes[0] != MTOK * DMODEL || out_size != MTOK * DMODEL || ws_size < WS_END) {
            fprintf(stderr, "kernel_launch: unexpected shapes / workspace (n_in %d, in0 %d, out %d, ws %zu)\n", n_in, n_in > 0 ? in_sizes[0] : -1, out_size, ws_size); grid = -1; return; }
        int dev = 0, cus = 0, per_cu = 0;
        if (hipGetDevice(&dev) != hipSuccess || hipDeviceGetAttribute(&cus, hipDeviceAttributeMultiprocessorCount, dev) != hipSuccess) { grid = -1; return; }
        if (hipFuncSetAttribute((const void*)mega_fwd, hipFuncAttributeMaxDynamicSharedMemorySize, LDS_BYTES) != hipSuccess) { fprintf(stderr, "kernel_launch: hipFuncSetAttribute failed\n"); grid = -1; return; }
        if (hipOccupancyMaxActiveBlocksPerMultiprocessor(&per_cu, (const void*)mega_fwd, NWAVES * 64, LDS_BYTES) != hipSuccess || per_cu < 1) {
            fprintf(stderr, "kernel_launch: occupancy query says %d workgroups per CU\n", per_cu); (void)hipGetLastError(); grid = -1; return; }
        grid = cus;
    }
    if (grid < 0) return;
    (void)hipMemsetAsync((char*)d_ws + WS_CTL, 0, CTL_ZERO_BYTES, stream);
    MegaArgs a{};
    for (int i = 0; i < 12; ++i) a.in[i] = (const float*)d_in[i];
    a.out = (float*)d_out; a.ws = (unsigned char*)d_ws;
    hipLaunchKernelGGL(mega_fwd, dim3(grid), dim3(NWAVES * 64), LDS_BYTES, stream, a);
}
```
